# Optimizing an MI355X kernel written in HIP

```python
import jax, jax.numpy as jnp
from jax import lax
import numpy as np

D_MODEL = 4096
BATCH = 1
SEQ = 8192
DEPTH = 1
DEC_BATCH = 8
DEC_SEQ = 2048
PAST_LEN = 128

LRU_WIDTH = D_MODEL
LRU_HEADS = 16
LRU_BLOCK = LRU_WIDTH // LRU_HEADS
CONV_WIDTH = 4
CONV_LEFT = 2
LRU_C = 8.0
MLA_HEADS = 32
Q_LORA = 1024
KV_LORA = 512
QK_NOPE = 128
QK_ROPE = 64
V_HEAD = 128
QK_HEAD = QK_NOPE + QK_ROPE
MLA_WIDTH = MLA_HEADS * V_HEAD
ROPE_THETA = 10000.0
Q_BLOCK = 128
D_FF = 4 * D_MODEL
N_BRANCH = 2
EPS = 1e-6
IN_COLS = 2 * LRU_WIDTH + Q_LORA + KV_LORA + QK_ROPE + N_BRANCH * D_MODEL
IN_SPLITS = (LRU_WIDTH,
             2 * LRU_WIDTH,
             2 * LRU_WIDTH + Q_LORA,
             2 * LRU_WIDTH + Q_LORA + KV_LORA,
             2 * LRU_WIDTH + Q_LORA + KV_LORA + QK_ROPE)

kernel_name = "hybrid_rglru_mla_encoder"


def rmsnorm(x, g):
    xf = x.astype(jnp.float32)
    y = xf * lax.rsqrt(jnp.mean(jnp.square(xf), axis=-1, keepdims=True) + EPS)
    return (y * g.astype(jnp.float32)).astype(x.dtype)


def rope_tables(seq):
    inv = 1.0 / (ROPE_THETA ** (jnp.arange(0, QK_ROPE, 2, dtype=jnp.float32) / QK_ROPE))
    ang = jnp.arange(seq, dtype=jnp.float32)[:, None] * inv[None, :]
    return jnp.cos(ang), jnp.sin(ang)


def apply_rope(x, cos, sin):
    xf = x.astype(jnp.float32)
    x1, x2 = xf[..., :QK_ROPE // 2], xf[..., QK_ROPE // 2:]
    return jnp.concatenate([x1 * cos - x2 * sin, x1 * sin + x2 * cos], axis=-1).astype(x.dtype)


def centred_depthwise_conv(x, w, b):
    s = x.shape[1]
    xp = jnp.pad(x, ((0, 0), (CONV_LEFT, CONV_WIDTH - 1 - CONV_LEFT), (0, 0)))
    out = b
    for k in range(CONV_WIDTH):
        out = out + xp[:, k:k + s] * w[k]
    return out


def block_diag_linear(x, w, b):
    xb = x.reshape(x.shape[:-1] + (LRU_HEADS, LRU_BLOCK))
    y = jnp.einsum('bshi,hij->bshj', xb, w) + b
    return y.reshape(x.shape)


def rglru_scan(x, w_a, b_a, w_x, b_x, lam, reverse):
    r = jax.nn.sigmoid(block_diag_linear(x, w_a, b_a).astype(jnp.float32))
    i = jax.nn.sigmoid(block_diag_linear(x, w_x, b_x).astype(jnp.float32))
    log_a = -LRU_C * r * jax.nn.softplus(-lam.astype(jnp.float32))
    a = jnp.exp(log_a)
    u = jnp.sqrt(-jnp.expm1(2.0 * log_a)) * (i * x.astype(jnp.float32))

    def combine(left, right):
        a1, b1 = left
        a2, b2 = right
        return a1 * a2, a2 * b1 + b2

    _, h = lax.associative_scan(combine, (a, u), reverse=reverse, axis=1)
    return h


def mla_attention(q_nope, q_pe, k_nope, k_pe, v):
    b, s, h, _ = q_nope.shape
    nb = s // Q_BLOCK
    scale = QK_HEAD ** -0.5

    def to_blocks(t):
        return jnp.moveaxis(t.reshape((b, nb, Q_BLOCK) + t.shape[2:]), 1, 0)

    def one_block(args):
        qn, qp = args
        sc = (jnp.einsum('bqhd,bkhd->bhqk', qn, k_nope, preferred_element_type=jnp.float32)
              + jnp.einsum('bqhr,bkr->bhqk', qp, k_pe, preferred_element_type=jnp.float32)) * scale
        p = jax.nn.softmax(sc, axis=-1).astype(v.dtype)
        return jnp.einsum('bhqk,bkhd->bqhd', p, v)

    o = lax.map(one_block, (to_blocks(q_nope), to_blocks(q_pe)))
    return jnp.moveaxis(o, 0, 1).reshape(b, s, h * V_HEAD)


def hybrid_mixer(xn, w_in, conv_w, conv_b, lru_wa, lru_ba, lru_wx, lru_bx, lru_lam,
                 q_norm, w_q_up, kv_norm, w_kv_up, w_lru_proj, w_mla_proj, w_out):
    b, s, _ = xn.shape
    dt = xn.dtype
    z = xn @ w_in
    x_lru, y_lru, c_q, c_kv, k_rope, gate_logits = jnp.split(z, IN_SPLITS, axis=-1)

    xc = centred_depthwise_conv(x_lru, conv_w, conv_b)
    h = (rglru_scan(xc, lru_wa[0], lru_ba[0], lru_wx[0], lru_bx[0], lru_lam[0], False)
         + rglru_scan(xc, lru_wa[1], lru_ba[1], lru_wx[1], lru_bx[1], lru_lam[1], True))
    o_lru = (h.astype(dt) * jax.nn.gelu(y_lru)) @ w_lru_proj

    cos, sin = rope_tables(s)
    q = (rmsnorm(c_q, q_norm) @ w_q_up).reshape(b, s, MLA_HEADS, QK_HEAD)
    q_nope = q[..., :QK_NOPE]
    q_pe = apply_rope(q[..., QK_NOPE:], cos[None, :, None, :], sin[None, :, None, :])
    kv = (rmsnorm(c_kv, kv_norm) @ w_kv_up).reshape(b, s, MLA_HEADS, QK_NOPE + V_HEAD)
    k_nope = kv[..., :QK_NOPE]
    v = kv[..., QK_NOPE:]
    k_pe = apply_rope(k_rope, cos[None], sin[None])
    o_mla = mla_attention(q_nope, q_pe, k_nope, k_pe, v) @ w_mla_proj

    g = jax.nn.sigmoid(gate_logits.astype(jnp.float32))
    g_a, g_b = g[..., :D_MODEL], g[..., D_MODEL:]
    merged = (g_a * o_lru.astype(jnp.float32) + g_b * o_mla.astype(jnp.float32)).astype(dt)
    return merged @ w_out


def trunk(x, norm1, w_in, conv_w, conv_b, lru_wa, lru_ba, lru_wx, lru_bx, lru_lam,
          q_norm, w_q_up, kv_norm, w_kv_up, w_lru_proj, w_mla_proj, w_out,
          norm2, w_up, w_down, norm_f):
    for l in range(DEPTH):
        x = x + hybrid_mixer(rmsnorm(x, norm1[l]), w_in[l], conv_w[l], conv_b[l],
                             lru_wa[l], lru_ba[l], lru_wx[l], lru_bx[l], lru_lam[l],
                             q_norm[l], w_q_up[l], kv_norm[l], w_kv_up[l],
                             w_lru_proj[l], w_mla_proj[l], w_out[l])
        u = jnp.square(jax.nn.relu(rmsnorm(x, norm2[l]) @ w_up[l]))
        x = x + u @ w_down[l]
    return rmsnorm(x, norm_f)


def setup_inputs(seed: int = 0) -> dict:
    key = jax.random.key(seed)
    ks = jax.random.split(key, 24)
    f32 = jnp.float32

    def nrm(k, shape, fan_in):
        return jax.random.normal(k, shape, f32) * (fan_in ** -0.5)

    def gain(k, shape):
        return 1.0 + 0.01 * jax.random.normal(k, shape, f32)

    def bias(k, shape):
        return 0.01 * jax.random.normal(k, shape, f32)

    u = jax.random.uniform(ks[10], (DEPTH, 2, LRU_WIDTH), f32, 0.9, 0.999)
    s = u ** (1.0 / LRU_C)
    lru_lam = jnp.log(s) - jnp.log1p(-s)

    return {
        "x_prompt": jax.random.normal(ks[0], (BATCH, SEQ, D_MODEL), f32),
        "x_sample": jax.random.normal(ks[1], (DEC_BATCH, DEC_SEQ, D_MODEL), f32),
        "norm1": gain(ks[2], (DEPTH, D_MODEL)),
        "w_in": nrm(ks[3], (DEPTH, D_MODEL, IN_COLS), D_MODEL),
        "conv_w": nrm(ks[4], (DEPTH, CONV_WIDTH, LRU_WIDTH), CONV_WIDTH),
        "conv_b": bias(ks[5], (DEPTH, LRU_WIDTH)),
        "lru_wa": nrm(ks[6], (DEPTH, 2, LRU_HEADS, LRU_BLOCK, LRU_BLOCK), LRU_BLOCK),
        "lru_ba": bias(ks[7], (DEPTH, 2, LRU_HEADS, LRU_BLOCK)),
        "lru_wx": nrm(ks[8], (DEPTH, 2, LRU_HEADS, LRU_BLOCK, LRU_BLOCK), LRU_BLOCK),
        "lru_bx": bias(ks[9], (DEPTH, 2, LRU_HEADS, LRU_BLOCK)),
        "lru_lam": lru_lam,
        "q_norm": gain(ks[11], (DEPTH, Q_LORA)),
        "w_q_up": nrm(ks[12], (DEPTH, Q_LORA, MLA_HEADS * QK_HEAD), Q_LORA),
        "kv_norm": gain(ks[13], (DEPTH, KV_LORA)),
        "w_kv_up": nrm(ks[14], (DEPTH, KV_LORA, MLA_HEADS * (QK_NOPE + V_HEAD)), KV_LORA),
        "w_lru_proj": nrm(ks[15], (DEPTH, LRU_WIDTH, D_MODEL), LRU_WIDTH),
        "w_mla_proj": nrm(ks[16], (DEPTH, MLA_WIDTH, D_MODEL), MLA_WIDTH),
        "w_out": nrm(ks[17], (DEPTH, D_MODEL, D_MODEL), D_MODEL),
        "norm2": gain(ks[18], (DEPTH, D_MODEL)),
        "w_up": nrm(ks[19], (DEPTH, D_MODEL, D_FF), D_MODEL),
        "w_down": nrm(ks[20], (DEPTH, D_FF, D_MODEL), D_FF),
        "norm_f": gain(ks[21], (D_MODEL,)),
    }


def reference(x_prompt, x_sample, norm1, w_in, conv_w, conv_b, lru_wa, lru_ba, lru_wx, lru_bx,
              lru_lam, q_norm, w_q_up, kv_norm, w_kv_up, w_lru_proj, w_mla_proj, w_out,
              norm2, w_up, w_down, norm_f):
    y_prompt = trunk(x_prompt, norm1, w_in, conv_w, conv_b, lru_wa, lru_ba, lru_wx, lru_bx,
                     lru_lam, q_norm, w_q_up, kv_norm, w_kv_up, w_lru_proj, w_mla_proj, w_out,
                     norm2, w_up, w_down, norm_f)
    y_sample = trunk(x_sample, norm1, w_in, conv_w, conv_b, lru_wa, lru_ba, lru_wx, lru_bx,
                     lru_lam, q_norm, w_q_up, kv_norm, w_kv_up, w_lru_proj, w_mla_proj, w_out,
                     norm2, w_up, w_down, norm_f)
    return (y_prompt, y_sample)
```

```cpp
#include <hip/hip_runtime.h>
#include <cstdio>
#include <cstdint>

#ifndef MK_N_LAUNCHES
#define MK_N_LAUNCHES 0
#endif
#ifndef NAIVE_GEMM
#define NAIVE_GEMM 0
#endif

#define GAS __attribute__((address_space(1)))
#define LAS __attribute__((address_space(3)))
typedef unsigned short bf16_t;
typedef short bf16x8 __attribute__((ext_vector_type(8)));
typedef short s16x4 __attribute__((ext_vector_type(4)));
typedef float f32x2 __attribute__((ext_vector_type(2)));
typedef float f32x4 __attribute__((ext_vector_type(4)));
typedef float f32x16 __attribute__((ext_vector_type(16)));
typedef unsigned u32x2 __attribute__((ext_vector_type(2)));
typedef unsigned u32x4 __attribute__((ext_vector_type(4)));

__device__ __forceinline__ unsigned cvt_pk_bf16(float lo, float hi) { unsigned r; asm volatile("v_cvt_pk_bf16_f32 %0, %1, %2" : "=v"(r) : "v"(lo), "v"(hi)); return r; }
__device__ __forceinline__ unsigned pk4_fp8(float a, float b, float c, float d) { unsigned w;
    asm("v_cvt_pk_fp8_f32 %0, %1, %2" : "=v"(w) : "v"(a), "v"(b)); asm("v_cvt_pk_fp8_f32 %0, %1, %2 op_sel:[0,0,1]" : "+v"(w) : "v"(c), "v"(d)); return w; }
constexpr float XN_QS = 127.0f / 4.0f;
constexpr float WIN_QS = 127.0f * 64.0f / 4.0f;
constexpr float WSQ_QS = 127.0f * 64.0f / 4.0f;
constexpr float MERGED_QS = 127.0f / 1.2f;
__device__ __forceinline__ unsigned pk4_i8(float a, float b, float c, float d, float qs) {
    const int q0 = (int)__builtin_rintf(fminf(fmaxf(a * qs, -127.f), 127.f)), q1 = (int)__builtin_rintf(fminf(fmaxf(b * qs, -127.f), 127.f));
    const int q2 = (int)__builtin_rintf(fminf(fmaxf(c * qs, -127.f), 127.f)), q3 = (int)__builtin_rintf(fminf(fmaxf(d * qs, -127.f), 127.f));
    return ((unsigned)q0 & 0xffu) | (((unsigned)q1 & 0xffu) << 8) | (((unsigned)q2 & 0xffu) << 16) | ((unsigned)q3 << 24);
}
__device__ __forceinline__ float bf_lo(unsigned w) { return __uint_as_float(w << 16); }
__device__ __forceinline__ float bf_hi(unsigned w) { return __uint_as_float(w & 0xffff0000u); }
__device__ __forceinline__ float fast_sigmoid(float v) { return __builtin_amdgcn_rcpf(1.0f + __builtin_amdgcn_exp2f(-1.4426950408889634f * v)); }
__device__ __forceinline__ float gelu_tanh(float v) {
    const float y = 1.5957691216057308f * (v + 0.044715f * v * v * v);
    return v * fast_sigmoid(y);
}

constexpr int D = 4096, MG = 8192, NGROUP = 3, MTOT = 24576;
constexpr int SEQ_P = 8192, SEQ_S = 2048;
constexpr int NZ = 18176, NZ_BF = 8192, NZ_F8 = 9984;
constexpr int ZC_Y = 4096, ZC_CQ = 8192, ZC_CKV = 9216, ZC_KR = 9728, ZC_GATE = 9984;
constexpr int IN_COLS = 17984, SRC_GATE = 9792;
constexpr int NQ = 6144, NKV = 8192, DFF = 16384, NG = 16384;
constexpr float EPS = 1e-6f;
constexpr int CHUNK = 128, NCHUNK = MG / CHUNK;

constexpr size_t MiB = 1u << 20;
constexpr size_t WS_CTL = 0, CTL_ZERO_BYTES = 1 * MiB;
constexpr size_t WS_ROPE = 1 * MiB;
constexpr size_t WS_TAB = 3 * MiB;
constexpr int NUP8 = 8192;
constexpr size_t WS_WUP = 4 * MiB;
constexpr size_t WS_WUPB = WS_WUP + (size_t)NUP8 * 4096;
constexpr size_t WS_WDN = WS_WUP + 128 * MiB;
constexpr size_t WS_WIN = WS_WDN + 128 * MiB;
constexpr size_t WS_XN8 = WS_WIN + 78 * MiB;
constexpr size_t WS_WG = WS_XN8 + 64 * MiB;
constexpr size_t WS_WQ = WS_WG + 8 * MiB;
constexpr size_t WS_WKV = WS_WQ + 12 * MiB;
constexpr size_t WS_WLP = WS_WKV + 8 * MiB;
constexpr size_t WS_WMP = WS_WLP + 32 * MiB;
constexpr size_t WS_WO = WS_WMP + 32 * MiB;
constexpr size_t WS_XN = WS_WO + 32 * MiB;
constexpr size_t WS_Z = WS_XN + 64 * MiB;
constexpr size_t WS_XC = WS_Z + 284 * MiB;
constexpr size_t WS_CQN = WS_XC + 64 * MiB;
constexpr size_t WS_CKVN = WS_CQN + 16 * MiB;
constexpr size_t WS_KPE = WS_CKVN + 8 * MiB;
constexpr size_t WS_SUM = WS_KPE + 1 * MiB;
constexpr size_t WS_G = WS_SUM + 4 * MiB;
constexpr size_t WS_Q = WS_G + 256 * MiB;
constexpr size_t WS_O = WS_Q + 96 * MiB;
constexpr size_t WS_END = WS_O + 64 * MiB;
constexpr size_t WS_N2ALL = WS_WIN;
constexpr size_t WS_HALL = WS_N2ALL + 192 * MiB;
constexpr size_t WS_N2I8 = WS_HALL + 768 * MiB;
static_assert(WS_N2I8 + 96 * MiB <= WS_END, "MLP-stage overlay");

constexpr int CW_TMO = 0, CW_CODE = 1, CW_DIAG = 2, CW_BAR = 4096;

namespace pg8 {
constexpr int BM = 256, BK = 64, HALF = 128, HTB = HALF * BK * 2, STAGE_BYTES = 8 * HTB, NXCD = 8, WGM = 8;
__host__ __device__ __forceinline__ int lds_byte(int r, int c) { const int st = (r >> 4) * 2 + (c >> 5), rr = r & 15, cc = c & 31, ob = rr * 64 + cc * 2; return st * 1024 + (ob ^ (((ob >> 9) & 1) << 5)); }
__host__ __device__ __forceinline__ void stage_rc(int b, int& R, int& C) { const int st = b / 1024, sb = b % 1024, swz = sb ^ (((sb >> 9) & 1) << 5); R = (st >> 1) * 16 + swz / 64; C = (st & 1) * 32 + (swz % 64) / 2; }
__host__ __device__ __forceinline__ int perm32(int rho) { const int n = rho >> 4, i = rho & 15; return 8 * (i >> 2) + 4 * n + (i & 3); }

struct Unit { int pm, pn; };
struct Gemm { const bf16_t* A; const bf16_t* Bt; int M, N, K, lda, ldb, a_pn_shift, a_pn_stride; int a_gp; size_t a_gs; };

struct StaticOrder {
    int nM, nN, nwg, G, c;
    __host__ __device__ void init(int M, int N, int G_, int c_) { nM = M / BM; nN = N / BM; nwg = nM * nN; G = G_; c = c_; }
    __host__ __device__ bool next(int i, Unit& u) const {
        const long L = (long)i * G + c; if (L >= nwg) return false;
        int wgid = (int)L; { const int q = nwg / NXCD, r = nwg % NXCD, xcd = wgid % NXCD, off = wgid / NXCD; wgid = (xcd < r ? xcd * (q + 1) : r * (q + 1) + (xcd - r) * q) + off; }
        const int nig = WGM * nN, gid = wgid / nig, fm = gid * WGM, gsz = (nM - fm) < WGM ? (nM - fm) : WGM;
        u.pm = fm + ((wgid % nig) % gsz); u.pn = (wgid % nig) / gsz; return true;
    }
};

__device__ __forceinline__ u32x4 pack8(const f32x4 v0, const f32x4 v1) { u32x4 w; w.x = cvt_pk_bf16(v0[0], v0[1]); w.y = cvt_pk_bf16(v0[2], v0[3]); w.z = cvt_pk_bf16(v1[0], v1[1]); w.w = cvt_pk_bf16(v1[2], v1[3]); return w; }
__device__ __forceinline__ void unpack8(const u32x4 w, f32x4& v0, f32x4& v1) { v0 = (f32x4){bf_lo(w.x), bf_hi(w.x), bf_lo(w.y), bf_hi(w.y)}; v1 = (f32x4){bf_lo(w.z), bf_hi(w.z), bf_lo(w.w), bf_hi(w.w)}; }

struct EpiZ {
    static constexpr bool PERM = true;
    bf16_t* O; int ldc; int pn_off; float scale;
    __device__ __forceinline__ void operator()(const f32x4 (&acc)[2][2][4][2], const Unit& u, int wr, int wc, int fr, int fq) const {
        const int pn = u.pn + pn_off;
        const int row0 = u.pm * BM + wr * 64 + fr, col0 = pn * BM + wc * 32 + 8 * fq;
        const int act = (pn >= 16 && pn < 32) ? 1 : (pn >= 39 ? 2 : 0);
#pragma unroll
        for (int ai = 0; ai < 2; ++ai)
#pragma unroll
            for (int m = 0; m < 4; ++m) { bf16_t* rowp = O + (size_t)(row0 + ai * HALF + m * 16) * ldc + col0;
#pragma unroll
                for (int bj = 0; bj < 2; ++bj) { f32x4 v0 = acc[ai][bj][m][0] * scale, v1 = acc[ai][bj][m][1] * scale;
                    if (act == 1) {
#pragma unroll
                        for (int j = 0; j < 4; ++j) { v0[j] = gelu_tanh(v0[j]); v1[j] = gelu_tanh(v1[j]); } }
                    else if (act == 2) {
#pragma unroll
                        for (int j = 0; j < 4; ++j) { v0[j] = fast_sigmoid(v0[j]); v1[j] = fast_sigmoid(v1[j]); } }
                    *(u32x4*)(rowp + bj * HALF) = pack8(v0, v1); } }
    }
};
template <int ACT> struct EpiBf16 {
    static constexpr bool PERM = true;
    bf16_t* O; int ldc; float scale; const float* rs2 = nullptr;
    __device__ __forceinline__ void operator()(const f32x4 (&acc)[2][2][4][2], const Unit& u, int wr, int wc, int fr, int fq) const {
        const int row0 = u.pm * BM + wr * 64 + fr, col0 = u.pn * BM + wc * 32 + 8 * fq;
        float rr[2][4];
#pragma unroll
        for (int ai = 0; ai < 2; ++ai)
#pragma unroll
            for (int m = 0; m < 4; ++m) rr[ai][m] = rs2 ? rs2[row0 + ai * HALF + m * 16] : 1.0f;
#pragma unroll
        for (int ai = 0; ai < 2; ++ai)
#pragma unroll
            for (int m = 0; m < 4; ++m) { bf16_t* rowp = O + (size_t)(row0 + ai * HALF + m * 16) * ldc + col0;
#pragma unroll
                for (int bj = 0; bj < 2; ++bj) { f32x4 v0 = acc[ai][bj][m][0] * scale, v1 = acc[ai][bj][m][1] * scale;
                    if (ACT == 1) {
#pragma unroll
                        for (int j = 0; j < 4; ++j) { const float a = fmaxf(v0[j], 0.f), b = fmaxf(v1[j], 0.f); v0[j] = a * a; v1[j] = b * b; }
                        if (rs2) { v0 = v0 * rr[ai][m]; v1 = v1 * rr[ai][m]; } }
                    *(u32x4*)(rowp + bj * HALF) = pack8(v0, v1); } }
    }
};
struct EpiLru {
    static constexpr bool PERM = true;
    bf16_t* G; const bf16_t* XC; const float* gbias; const float* sp8l2;
    f32x2* SUM; LAS f32x2* xch;
    template <int MB> static __device__ __forceinline__ void stage(float& A, float& H, bool mine_first) {
        const float pA = __builtin_bit_cast(float, __builtin_amdgcn_ds_swizzle(__builtin_bit_cast(int, A), (MB << 10) | 0x1f));
        const float pH = __builtin_bit_cast(float, __builtin_amdgcn_ds_swizzle(__builtin_bit_cast(int, H), (MB << 10) | 0x1f));
        H = mine_first ? __builtin_fmaf(pA, H, pH) : __builtin_fmaf(A, pH, H); A *= pA;
    }
    __device__ __forceinline__ void operator()(const f32x4 (&acc)[2][2][4][2], const Unit& u, int wr, int wc, int fr, int fq) const {
        const int hb = u.pn >> 2, dir = (u.pn >> 1) & 1, half = u.pn & 1, j0 = half * 128 + wc * 32 + 8 * fq, row0 = u.pm * BM + wr * 64 + 4 * fr;
        const float* bp = gbias + hb * 1024 + (2 * dir) * 256 + j0;
        const f32x4 br0 = *(const f32x4*)(bp), br1 = *(const f32x4*)(bp + 4), bi0 = *(const f32x4*)(bp + 256), bi1 = *(const f32x4*)(bp + 260);
        const f32x4 sp0 = *(const f32x4*)(sp8l2 + dir * 4096 + hb * 256 + j0), sp1 = *(const f32x4*)(sp8l2 + dir * 4096 + hb * 256 + j0 + 4);
        const bool fwd = dir == 0;
        const bool f1 = ((fr & 1) == 0) == fwd, f2 = ((fr & 2) == 0) == fwd, f4 = ((fr & 4) == 0) == fwd, f8 = ((fr & 8) == 0) == fwd;
        float Ar[2][8], Hr[2][8];
#pragma unroll
        for (int ai = 0; ai < 2; ++ai) {
#pragma unroll
            for (int m = 0; m < 4; ++m) { const size_t row = (size_t)(row0 + ai * HALF + m);
                f32x4 x0, x1; unpack8(*(const u32x4*)(XC + row * 4096 + hb * 256 + j0), x0, x1);
                f32x4 l0, l1, u0, u1; float As[8], Hs[8];
#pragma unroll
                for (int e = 0; e < 4; ++e) {
                    { const float r = fast_sigmoid(acc[ai][0][m][0][e] + br0[e]), i = fast_sigmoid(acc[ai][1][m][0][e] + bi0[e]); const float la = -r * sp0[e], a = __builtin_amdgcn_exp2f(la);
                      l0[e] = la; u0[e] = __builtin_amdgcn_sqrtf(__builtin_fmaf(-a, a, 1.0f)) * i * x0[e]; As[e] = a; Hs[e] = u0[e]; }
                    { const float r = fast_sigmoid(acc[ai][0][m][1][e] + br1[e]), i = fast_sigmoid(acc[ai][1][m][1][e] + bi1[e]); const float la = -r * sp1[e], a = __builtin_amdgcn_exp2f(la);
                      l1[e] = la; u1[e] = __builtin_amdgcn_sqrtf(__builtin_fmaf(-a, a, 1.0f)) * i * x1[e]; As[4 + e] = a; Hs[4 + e] = u1[e]; } }
                bf16_t* gp = G + row * 16384 + hb * 1024 + (2 * dir) * 256 + j0;
                *(u32x4*)(gp) = pack8(l0, l1); *(u32x4*)(gp + 256) = pack8(u0, u1);
#pragma unroll
                for (int e = 0; e < 8; ++e) {
                    if (m == 0) { Ar[ai][e] = As[e]; Hr[ai][e] = Hs[e]; }
                    else if (fwd) { Hr[ai][e] = __builtin_fmaf(As[e], Hr[ai][e], Hs[e]); Ar[ai][e] *= As[e]; }
                    else { Hr[ai][e] = __builtin_fmaf(Ar[ai][e], Hs[e], Hr[ai][e]); Ar[ai][e] *= As[e]; } } }
#pragma unroll
            for (int e = 0; e < 8; ++e) { stage<1>(Ar[ai][e], Hr[ai][e], f1); stage<2>(Ar[ai][e], Hr[ai][e], f2); stage<4>(Ar[ai][e], Hr[ai][e], f4); stage<8>(Ar[ai][e], Hr[ai][e], f8); }
        }
        if (fr == 0) {
#pragma unroll
            for (int ai = 0; ai < 2; ++ai)
#pragma unroll
                for (int e = 0; e < 8; ++e) xch[(wr * 2 + ai) * 128 + wc * 32 + 8 * fq + e] = (f32x2){Ar[ai][e], Hr[ai][e]}; }
        asm volatile("s_waitcnt lgkmcnt(0)" ::: "memory"); __builtin_amdgcn_s_barrier(); asm volatile("" ::: "memory");
        if (wr == 0 && fr == 0) {
#pragma unroll
            for (int ai = 0; ai < 2; ++ai)
#pragma unroll
                for (int e = 0; e < 8; ++e) { const f32x2 o_ = xch[(2 + ai) * 128 + wc * 32 + 8 * fq + e];
                    const float A0 = Ar[ai][e], H0 = Hr[ai][e];
                    const float Hh = fwd ? __builtin_fmaf(o_.x, H0, o_.y) : __builtin_fmaf(A0, o_.y, H0);
                    SUM[(size_t)((2 * u.pm + ai) * 2 + dir) * 4096 + hb * 256 + j0 + e] = (f32x2){A0 * o_.x, Hh}; } }
    }
};
struct EpiKV {
    static constexpr bool PERM = true;
    unsigned char* K8; unsigned char* V; float scale;
    __device__ __forceinline__ void operator()(const f32x4 (&acc)[2][2][4][2], const Unit& u, int wr, int wc, int fr, int fq) const {
        const int row0 = u.pm * BM + wr * 64 + fr, col = u.pn * 128 + wc * 32 + 8 * fq;
#pragma unroll
        for (int ai = 0; ai < 2; ++ai)
#pragma unroll
            for (int m = 0; m < 4; ++m) { const size_t row = (size_t)(row0 + ai * HALF + m * 16);
                { const f32x4 v0 = acc[ai][0][m][0] * scale, v1 = acc[ai][0][m][1] * scale;
                  *(u32x2*)(K8 + row * 4096 + col) = (u32x2){pk4_fp8(v0[0], v0[1], v0[2], v0[3]), pk4_fp8(v1[0], v1[1], v1[2], v1[3])}; }
                { const f32x4 v0 = acc[ai][1][m][0] * scale, v1 = acc[ai][1][m][1] * scale;
                  *(u32x2*)(V + row * 4096 + col) = (u32x2){pk4_fp8(v0[0], v0[1], v0[2], v0[3]), pk4_fp8(v1[0], v1[1], v1[2], v1[3])}; } }
    }
};
template <bool ADD, bool OUT_I8 = false> struct EpiGate {
    static constexpr bool PERM = true;
    bf16_t* O; int ldc; const bf16_t* gate; int ldg; const bf16_t* add; int ldadd; float scale; float qs; const float* rowscale;
    __device__ __forceinline__ void operator()(const f32x4 (&acc)[2][2][4][2], const Unit& u, int wr, int wc, int fr, int fq) const {
        const int row0 = u.pm * BM + wr * 64 + fr, col0 = u.pn * BM + wc * 32 + 8 * fq;
#pragma unroll
        for (int ai = 0; ai < 2; ++ai)
#pragma unroll
            for (int m = 0; m < 4; ++m) { const size_t row = (size_t)(row0 + ai * HALF + m * 16); const float sc_ = rowscale ? scale * rowscale[row] : scale;
#pragma unroll
                for (int bj = 0; bj < 2; ++bj) { const int col = col0 + bj * HALF;
                    f32x4 g0, g1; unpack8(*(const u32x4*)(gate + row * ldg + col), g0, g1);
                    f32x4 v0 = acc[ai][bj][m][0] * (g0 * sc_), v1 = acc[ai][bj][m][1] * (g1 * sc_);
                    if (ADD) { f32x4 a0, a1; unpack8(*(const u32x4*)(add + row * ldadd + col), a0, a1); v0 += a0; v1 += a1; }
                    if constexpr (OUT_I8) {
                        float h_[8] = {v0[0], v0[1], v0[2], v0[3], v1[0], v1[1], v1[2], v1[3]};
#pragma unroll
                        for (int s_ = 1; s_ < 8; s_ <<= 1)
#pragma unroll
                            for (int i = 0; i < 8; ++i) if ((i & s_) == 0) { const float a = h_[i], b = h_[i | s_]; h_[i] = a + b; h_[i | s_] = a - b; }
#pragma unroll
                        for (int i = 0; i < 8; ++i) { const float p = __builtin_bit_cast(float, __builtin_amdgcn_ds_swizzle(__builtin_bit_cast(int, h_[i]), (16 << 10) | 0x1f)); h_[i] = (fq & 1) ? p - h_[i] : h_[i] + p; }
#pragma unroll
                        for (int i = 0; i < 8; ++i) { const auto rr = __builtin_amdgcn_permlane32_swap(__float_as_uint(h_[i]), __float_as_uint(h_[i]), false, false);
                            const float p = __uint_as_float((fq & 2) ? rr[0] : rr[1]); h_[i] = (fq & 2) ? p - h_[i] : h_[i] + p; }
                        const float q_ = qs * 0.17677669529663689f;
                        *(u32x2*)((unsigned char*)O + row * ldc + col) = (u32x2){pk4_i8(h_[0], h_[1], h_[2], h_[3], q_), pk4_i8(h_[4], h_[5], h_[6], h_[7], q_)}; }
                    else *(u32x4*)(O + row * ldc + col) = pack8(v0, v1); } }
    }
};
template <bool BASE_BF> struct EpiResBf {
    static constexpr bool PERM = true;
    const void* base; int base_grp_rows; size_t base_grp_stride; bf16_t* out; int out_grp_rows; size_t out_grp_stride; int ldc; float scale;
    __device__ __forceinline__ void operator()(const f32x4 (&acc)[2][2][4][2], const Unit& u, int wr, int wc, int fr, int fq) const {
        const int row0 = u.pm * BM + wr * 64 + fr, col0 = u.pn * BM + wc * 32 + 8 * fq;
#pragma unroll
        for (int ai = 0; ai < 2; ++ai)
#pragma unroll
            for (int m = 0; m < 4; ++m) { const int row = row0 + ai * HALF + m * 16;
                const size_t bo = base_grp_rows ? (size_t)(row / base_grp_rows) * base_grp_stride + (size_t)(row % base_grp_rows) * ldc : (size_t)row * ldc;
                const size_t oo = out_grp_rows ? (size_t)(row / out_grp_rows) * out_grp_stride + (size_t)(row % out_grp_rows) * ldc : (size_t)row * ldc;
#pragma unroll
                for (int bj = 0; bj < 2; ++bj) { const int col = col0 + bj * HALF;
                    f32x4 b0, b1;
                    if constexpr (BASE_BF) unpack8(*(const u32x4*)((const bf16_t*)base + bo + col), b0, b1);
                    else { b0 = *(const f32x4*)((const float*)base + bo + col); b1 = *(const f32x4*)((const float*)base + bo + col + 4); }
                    *(u32x4*)(out + oo + col) = pack8(b0 + acc[ai][bj][m][0] * scale, b1 + acc[ai][bj][m][1] * scale); } }
    }
};
struct EpiResF32 {
    static constexpr bool PERM = false;
    const float* base; float* out; int ldc; float scale;
    __device__ __forceinline__ void operator()(const f32x4 (&acc)[2][2][4][2], const Unit& u, int wr, int wc, int fr, int fq) const {
        const int row0 = u.pm * BM + wr * 64 + fr, col0 = u.pn * BM + wc * 32 + 4 * fq;
#pragma unroll
        for (int ai = 0; ai < 2; ++ai)
#pragma unroll
            for (int m = 0; m < 4; ++m) { const size_t off = (size_t)(row0 + ai * HALF + m * 16) * ldc + col0;
#pragma unroll
                for (int bj = 0; bj < 2; ++bj)
#pragma unroll
                    for (int n = 0; n < 2; ++n) { const f32x4 bs = *(const f32x4*)(base + off + bj * HALF + n * 16); *(f32x4*)(out + off + bj * HALF + n * 16) = bs + acc[ai][bj][m][n] * scale; } }
    }
};

#if NAIVE_GEMM
template <class Epi, class Sched, bool ALIGN_EPI = false, bool SP2 = false>
__device__ __forceinline__ void gemm_phase(LAS unsigned char* lds, const Gemm g, const Sched& S, const Epi& E, int tid_in) {
    const int tid = tid_in, wid = __builtin_amdgcn_readfirstlane(tid >> 6), lane = tid & 63, wr = wid >> 2, wc = wid & 3, fr = lane & 15, fq = lane >> 4;
    Unit cur;
    for (int ui = 0; S.next(ui, cur); ++ui) {
        f32x4 acc[2][2][4][2];
#pragma unroll
        for (int a = 0; a < 2; ++a)
#pragma unroll
            for (int b = 0; b < 2; ++b)
#pragma unroll
                for (int m = 0; m < 4; ++m)
#pragma unroll
                    for (int n = 0; n < 2; ++n) acc[a][b][m][n] = (f32x4){0.f, 0.f, 0.f, 0.f};
        const bf16_t* Ab = g.A + (size_t)cur.pm * BM * g.lda + (size_t)(cur.pn >> g.a_pn_shift) * g.a_pn_stride;
        const bf16_t* Bb = g.Bt + (size_t)cur.pn * BM * g.ldb;
        for (int kk = 0; kk < g.K; kk += 32) {
#pragma unroll
            for (int ai = 0; ai < 2; ++ai)
#pragma unroll
                for (int bj = 0; bj < 2; ++bj)
#pragma unroll
                    for (int m = 0; m < 4; ++m)
#pragma unroll
                        for (int n = 0; n < 2; ++n) {
                            const int ar = ai * HALF + wr * 64 + m * 16 + fr;
                            const int slot = n * 16 + fr, bc = bj * HALF + wc * 32 + (Epi::PERM ? perm32(slot) : slot);
                            const bf16x8 af = *(const bf16x8*)(Ab + (size_t)ar * g.lda + kk + fq * 8);
                            const bf16x8 bf = *(const bf16x8*)(Bb + (size_t)bc * g.ldb + kk + fq * 8);
                            acc[ai][bj][m][n] = __builtin_amdgcn_mfma_f32_16x16x32_bf16(bf, af, acc[ai][bj][m][n], 0, 0, 0);
                        }
        }
        E(acc, cur, wr, wc, fr, fq);
    }
}
#else
template <class Epi, class Sched, bool ALIGN_EPI = false, bool SP2 = false, int LOWP = 0, bool APERM = false>
__device__ __forceinline__ void gemm_phase(LAS unsigned char* lds, const Gemm g, const Sched& S, const Epi& E, int tid_in) {
    constexpr bool F8 = (LOWP == 1), I8 = (LOWP == 2);
    int tid = tid_in; int lda = g.lda, ldb = g.ldb;
    asm volatile("" : "+v"(tid), "+s"(lda), "+s"(ldb));
    const int wid = __builtin_amdgcn_readfirstlane(tid >> 6), lane = tid & 63, wr = wid >> 2, wc = wid & 3, fr = lane & 15, fq = lane >> 4;
    const int K = g.K, nt = K / BK;
    unsigned voffA[2], voffB[2];
#pragma unroll
    for (int i = 0; i < 2; ++i) { int R, C; stage_rc(tid * 16 + i * 8192, R, C); const int Rb = Epi::PERM ? ((R & ~31) + perm32(R & 31)) : R;
        const int Ra = APERM ? ((R & ~63) + 4 * (R & 15) + ((R >> 4) & 3)) : R;
        voffA[i] = (unsigned)(Ra * lda + C) * 2u; voffB[i] = (unsigned)(Rb * ldb + C) * 2u; }
    const size_t kstep = (size_t)(BK * 2);
    const size_t hstepA = (size_t)HALF * lda * 2, hstepB = (size_t)HALF * ldb * 2;
    const size_t tstepA = 2 * hstepA, tstepB = 2 * hstepB;
    const unsigned ldsw = (unsigned)wid * 1024u;
    const int aoff = lds_byte(wr * 64 + fr, fq * 8), boff = lds_byte(wc * 32 + fr, fq * 8);
#define PG8_SA(b, h) (((b) * 2 + (h)) * HTB)
#define PG8_SB(b, h) ((4 + (b) * 2 + (h)) * HTB)
#define PG8_STAGE(bufoff, gbase, voff) do { _Pragma("unroll") for (int _i = 0; _i < 2; ++_i) \
        __builtin_amdgcn_global_load_lds((const unsigned*)((const char*)(gbase) + (voff)[_i]), (LAS unsigned*)(lds + (bufoff) + ldsw + _i * 8192), 16, 0, 0); } while (0)
#define PG8_LDA(dst, b, h) do { _Pragma("unroll") for (int m = 0; m < 4; ++m) _Pragma("unroll") for (int k = 0; k < 2; ++k) dst[m][k] = *(const LAS bf16x8*)(lds + PG8_SA(b, h) + aoff + m * 2048 + k * 1024); } while (0)
#define PG8_LDB(dst, b, h) do { _Pragma("unroll") for (int n = 0; n < 2; ++n) _Pragma("unroll") for (int k = 0; k < 2; ++k) dst[n][k] = *(const LAS bf16x8*)(lds + PG8_SB(b, h) + boff + n * 2048 + k * 1024); } while (0)
#define PG8_MMA(ai, bj, At, Bt) do { __builtin_amdgcn_s_setprio(1); _Pragma("unroll") for (int m = 0; m < 4; ++m) _Pragma("unroll") for (int n = 0; n < 2; ++n) { \
        if constexpr (F8) { typedef int v8i_ __attribute__((ext_vector_type(8))); typedef int v4i_ __attribute__((ext_vector_type(4))); \
            const v4i_ b0_ = __builtin_bit_cast(v4i_, Bt[n][0]), b1_ = __builtin_bit_cast(v4i_, Bt[n][1]), a0_ = __builtin_bit_cast(v4i_, At[m][0]), a1_ = __builtin_bit_cast(v4i_, At[m][1]); \
            const v8i_ bb_ = __builtin_shufflevector(b0_, b1_, 0, 1, 2, 3, 4, 5, 6, 7), aa_ = __builtin_shufflevector(a0_, a1_, 0, 1, 2, 3, 4, 5, 6, 7); \
            asm volatile("v_mfma_f32_16x16x128_f8f6f4 %0, %1, %2, %0" : "+v"(acc[ai][bj][m][n]) : "v"(bb_), "v"(aa_)); (void)f8scale_; } \
        else if constexpr (I8) { typedef int v4i_ __attribute__((ext_vector_type(4))); v4i_ c_ = __builtin_bit_cast(v4i_, acc[ai][bj][m][n]); \
            _Pragma("unroll") for (int k = 0; k < 2; ++k) c_ = __builtin_amdgcn_mfma_i32_16x16x64_i8(__builtin_bit_cast(v4i_, Bt[n][k]), __builtin_bit_cast(v4i_, At[m][k]), c_, 0, 0, 0); \
            acc[ai][bj][m][n] = __builtin_bit_cast(f32x4, c_); } \
        else { _Pragma("unroll") for (int k = 0; k < 2; ++k) acc[ai][bj][m][n] = __builtin_amdgcn_mfma_f32_16x16x32_bf16(Bt[n][k], At[m][k], acc[ai][bj][m][n], 0, 0, 0); } } \
        __builtin_amdgcn_s_setprio(0); } while (0)
#define PG8_WAIT_V(n) asm volatile("s_waitcnt vmcnt(" #n ")" ::: "memory")
#define PG8_WAIT_L(n) asm volatile("s_waitcnt lgkmcnt(" #n ")" ::: "memory")
#define PG8_BAR __builtin_amdgcn_s_barrier()
#define PG8_SCHED __builtin_amdgcn_sched_barrier(0)
#define PG8_ABASE(u) ((const char*)g.A + (g.a_gp ? (size_t)((u).pm / g.a_gp) * g.a_gs + (size_t)((u).pm % g.a_gp) * tstepA : (size_t)(u).pm * tstepA) + (size_t)((u).pn >> g.a_pn_shift) * (size_t)g.a_pn_stride * 2)
    Unit cur, nxt; int ui = 0;
    if (!S.next(0, cur)) return;
    int f8scale_ = 0x7f7f7f7f; asm volatile("" : "+v"(f8scale_));
    f32x4 acc[2][2][4][2];
#pragma unroll
    for (int a = 0; a < 2; ++a)
#pragma unroll
        for (int b = 0; b < 2; ++b)
#pragma unroll
            for (int m = 0; m < 4; ++m)
#pragma unroll
                for (int n = 0; n < 2; ++n) acc[a][b][m][n] = (f32x4){0.f, 0.f, 0.f, 0.f};
    bf16x8 At[4][2], B0[2][2], B1[2][2];
    const char* cA = PG8_ABASE(cur); const char* cB = (const char*)g.Bt + (size_t)cur.pn * tstepB;
    if constexpr (SP2) {
        PG8_STAGE(PG8_SB(0, 0), cB, voffB); PG8_STAGE(PG8_SB(0, 1), cB + hstepB, voffB); PG8_STAGE(PG8_SA(0, 0), cA, voffA); PG8_STAGE(PG8_SA(0, 1), cA + hstepA, voffA);
        if (wr == 1) PG8_BAR;
        PG8_WAIT_V(2); PG8_BAR;
        PG8_STAGE(PG8_SB(1, 0), cB + kstep, voffB); PG8_STAGE(PG8_SA(1, 0), cA + kstep, voffA); PG8_STAGE(PG8_SB(1, 1), cB + hstepB + kstep, voffB);
        PG8_WAIT_V(6); PG8_BAR;
    } else {
        PG8_STAGE(PG8_SB(0, 0), cB, voffB); PG8_STAGE(PG8_SA(0, 0), cA, voffA); PG8_STAGE(PG8_SB(0, 1), cB + hstepB, voffB); PG8_STAGE(PG8_SA(0, 1), cA + hstepA, voffA);
        if (wr == 1) PG8_BAR;
        PG8_WAIT_V(4); PG8_BAR;
        PG8_STAGE(PG8_SB(1, 0), cB + kstep, voffB); PG8_STAGE(PG8_SA(1, 0), cA + kstep, voffA); PG8_STAGE(PG8_SB(1, 1), cB + hstepB + kstep, voffB);
        PG8_WAIT_V(6); PG8_BAR;
    }
    for (;;) {
        const bool has_next = S.next(ui + 1, nxt);
        const char* nA = has_next ? PG8_ABASE(nxt) : cA; const char* nB = has_next ? (const char*)g.Bt + (size_t)nxt.pn * tstepB : cB;
#pragma unroll 1
        for (int t = 0; t < nt; t += 2) {
            const bool last = (t == nt - 2);
            const char* a1 = cA + (size_t)(t + 1) * kstep;
            const char* a2 = last ? nA : cA + (size_t)(t + 2) * kstep; const char* b2 = last ? nB : cB + (size_t)(t + 2) * kstep;
            const char* a3 = a2 + kstep; const char* b3 = b2 + kstep;
            if constexpr (SP2) {
            PG8_LDB(B0, 0, 0); PG8_LDB(B1, 0, 1); PG8_SCHED; PG8_LDA(At, 0, 0); PG8_STAGE(PG8_SA(1, 1), a1 + hstepA, voffA);
            PG8_WAIT_V(8); PG8_WAIT_L(0); PG8_BAR; PG8_MMA(0, 0, At, B0); PG8_MMA(0, 1, At, B1); PG8_BAR; PG8_SCHED;
            PG8_LDA(At, 0, 1); PG8_STAGE(PG8_SB(0, 0), b2, voffB); PG8_STAGE(PG8_SB(0, 1), b2 + hstepB, voffB); PG8_STAGE(PG8_SA(0, 0), a2, voffA);
            PG8_WAIT_V(8); PG8_WAIT_L(0); PG8_BAR; PG8_MMA(1, 0, At, B0); PG8_MMA(1, 1, At, B1); PG8_BAR; PG8_SCHED;
            PG8_LDB(B0, 1, 0); PG8_LDB(B1, 1, 1); PG8_SCHED; PG8_LDA(At, 1, 0); PG8_STAGE(PG8_SA(0, 1), a2 + hstepA, voffA);
            PG8_WAIT_V(8); PG8_WAIT_L(0); PG8_BAR; PG8_MMA(0, 0, At, B0); PG8_MMA(0, 1, At, B1); PG8_BAR; PG8_SCHED;
            PG8_LDA(At, 1, 1); PG8_STAGE(PG8_SB(1, 0), b3, voffB); PG8_STAGE(PG8_SB(1, 1), b3 + hstepB, voffB); PG8_STAGE(PG8_SA(1, 0), a3, voffA);
            PG8_WAIT_V(8); PG8_WAIT_L(0); PG8_BAR; PG8_MMA(1, 0, At, B0); PG8_MMA(1, 1, At, B1); PG8_BAR; PG8_SCHED;
            } else {
            PG8_LDB(B0, 0, 0); PG8_SCHED; PG8_LDA(At, 0, 0); PG8_STAGE(PG8_SA(1, 1), a1 + hstepA, voffA);
            PG8_WAIT_L(8); PG8_BAR; PG8_WAIT_L(0); PG8_MMA(0, 0, At, B0); PG8_BAR; PG8_SCHED;
            PG8_LDB(B1, 0, 1); PG8_STAGE(PG8_SB(0, 0), b2, voffB);
            PG8_BAR; PG8_WAIT_L(0); PG8_MMA(0, 1, At, B1); PG8_BAR;
            PG8_LDA(At, 0, 1); PG8_STAGE(PG8_SA(0, 0), a2, voffA);
            PG8_BAR; PG8_WAIT_L(0); PG8_MMA(1, 0, At, B0); PG8_BAR; PG8_SCHED;
            PG8_STAGE(PG8_SB(0, 1), b2 + hstepB, voffB);
            PG8_WAIT_V(6); PG8_BAR; PG8_MMA(1, 1, At, B1); PG8_BAR;
            PG8_LDB(B0, 1, 0); PG8_SCHED; PG8_LDA(At, 1, 0); PG8_STAGE(PG8_SA(0, 1), a2 + hstepA, voffA);
            PG8_WAIT_L(8); PG8_BAR; PG8_WAIT_L(0); PG8_MMA(0, 0, At, B0); PG8_BAR; PG8_SCHED;
            PG8_LDB(B1, 1, 1); PG8_STAGE(PG8_SB(1, 0), b3, voffB);
            PG8_BAR; PG8_WAIT_L(0); PG8_MMA(0, 1, At, B1); PG8_BAR;
            PG8_LDA(At, 1, 1); PG8_STAGE(PG8_SA(1, 0), a3, voffA);
            PG8_BAR; PG8_WAIT_L(0); PG8_MMA(1, 0, At, B0); PG8_BAR; PG8_SCHED;
            PG8_STAGE(PG8_SB(1, 1), b3 + hstepB, voffB);
            PG8_WAIT_V(6); PG8_BAR; PG8_MMA(1, 1, At, B1); PG8_BAR;
            }
        }
        if constexpr (ALIGN_EPI) { if (wr == 0) PG8_BAR; }
        if constexpr (I8) { typedef int v4i_ __attribute__((ext_vector_type(4)));
#pragma unroll
            for (int a = 0; a < 2; ++a)
#pragma unroll
                for (int b = 0; b < 2; ++b)
#pragma unroll
                    for (int m = 0; m < 4; ++m)
#pragma unroll
                        for (int n = 0; n < 2; ++n) { const v4i_ c_ = __builtin_bit_cast(v4i_, acc[a][b][m][n]); acc[a][b][m][n] = (f32x4){(float)c_[0], (float)c_[1], (float)c_[2], (float)c_[3]}; } }
        if constexpr (F8) asm volatile("s_nop 15\n\ts_nop 15" ::: "memory");
        E(acc, cur, wr, wc, fr, fq);
        if (!has_next) break;
#pragma unroll
        for (int a = 0; a < 2; ++a)
#pragma unroll
            for (int b = 0; b < 2; ++b)
#pragma unroll
                for (int m = 0; m < 4; ++m)
#pragma unroll
                    for (int n = 0; n < 2; ++n) acc[a][b][m][n] = (f32x4){0.f, 0.f, 0.f, 0.f};
        cur = nxt; cA = nA; cB = nB; ++ui;
        if constexpr (ALIGN_EPI) { if (wr == 1) PG8_BAR; }
    }
    PG8_WAIT_V(0);
    if constexpr (!ALIGN_EPI) { if (wr == 0) PG8_BAR; }
    PG8_BAR;
#undef PG8_SA
#undef PG8_SB
#undef PG8_STAGE
#undef PG8_LDA
#undef PG8_LDB
#undef PG8_MMA
#undef PG8_WAIT_V
#undef PG8_WAIT_L
#undef PG8_BAR
#undef PG8_SCHED
#undef PG8_ABASE
}
#endif
}

namespace att {
constexpr int NW = 8, QBLK = 32, KVBLK = 64;
constexpr int LDQ = NQ, LDKN8 = D, LDO = D, LDKP8 = 64;
constexpr float SCALE = 0.07216878364870322f;
constexpr float THR = 5.f;
constexpr float OSCALE = 32.f;
constexpr int SHM_V = KVBLK * 128, SHM_KN = KVBLK * 128, SHM_KR = KVBLK * 64, NSLOT = 6;
constexpr int OFF_V = 0, OFF_KN = NSLOT * SHM_V, OFF_KR = OFF_KN + NSLOT * SHM_KN, OFF_WS = OFF_KR + NSLOT * SHM_KR, LDS_BYTES = OFF_WS + NW * 64 * 4;
#define KN8SW(row, c) ((row) * 128 + ((((c) ^ (((row) >> 1) & 7))) << 4))
#define KR8SW(row, c) ((row) * 64 + ((((c) ^ (((row) >> 2) & 3))) << 4))
typedef int v8i __attribute__((ext_vector_type(8)));
typedef int v4i __attribute__((ext_vector_type(4)));
typedef int v6i __attribute__((ext_vector_type(6)));
typedef int v2i_ __attribute__((ext_vector_type(2)));
#define SBAR() __builtin_amdgcn_sched_barrier(0)
__device__ __forceinline__ int crow(int r, int hi) { return (r & 3) + 8 * (r >> 2) + 4 * hi; }

constexpr float QC = SCALE * 1.4426950408889634f;
constexpr float THR6 = 2.0f, SEED6 = 1.8073549220576042f, THRP = THR6 * 1.4426950408889634f + SEED6, VSC6 = 1.75f;
__device__ __forceinline__ void sm_raise(f32x16& p0, f32x16& p1, f32x16& nm, float delta) {
  const f32x2 d2 = {delta, delta};
#pragma unroll
  for (int r = 0; r < 16; r += 2) { const f32x2 t = (f32x2){p0[r], p0[r + 1]} - d2; p0[r] = t.x; p0[r + 1] = t.y; const f32x2 w = (f32x2){p1[r], p1[r + 1]} - d2; p1[r] = w.x; p1[r + 1] = w.y;
    const f32x2 n_ = (f32x2){nm[r], nm[r + 1]} - d2; nm[r] = n_.x; nm[r + 1] = n_.y; }
}
__device__ __forceinline__ void partialSM(f32x16& p0, f32x16& p1, f32x16& nm, float& alpha, bool first) {
  float pmax, pmb;
  asm("v_max3_f32 %0, %1, %2, %3" : "=v"(pmax) : "v"(p0[0]), "v"(p0[1]), "v"(p1[0]));
  asm("v_max3_f32 %0, %1, %2, %3" : "=v"(pmb) : "v"(p0[2]), "v"(p0[3]), "v"(p1[1]));
  asm("v_max3_f32 %0, %1, %2, %3" : "=v"(pmax) : "v"(pmax), "v"(p1[2]), "v"(p1[3]));
#pragma unroll
  for (int r = 4; r < 16; r += 4) {
    asm("v_max3_f32 %0, %1, %2, %3" : "=v"(pmax) : "v"(pmax), "v"(p0[r]), "v"(p0[r + 1]));
    asm("v_max3_f32 %0, %1, %2, %3" : "=v"(pmb) : "v"(pmb), "v"(p0[r + 2]), "v"(p0[r + 3]));
    asm("v_max3_f32 %0, %1, %2, %3" : "=v"(pmax) : "v"(pmax), "v"(p1[r]), "v"(p1[r + 1]));
    asm("v_max3_f32 %0, %1, %2, %3" : "=v"(pmb) : "v"(pmb), "v"(p1[r + 2]), "v"(p1[r + 3])); }
  pmax = fmaxf(pmax, pmb);
  { auto rr = __builtin_amdgcn_permlane32_swap(__float_as_uint(pmax), __float_as_uint(pmax), false, false);
    pmax = fmaxf(__uint_as_float(rr[0]), __uint_as_float(rr[1])); }
  if (first) { alpha = 1.f; sm_raise(p0, p1, nm, pmax - SEED6); }
  else if (__builtin_expect(__all(pmax <= THRP), 1)) alpha = 1.f;
  else { const float delta = fmaxf(pmax - SEED6, 0.f); alpha = __builtin_amdgcn_exp2f(-delta); sm_raise(p0, p1, nm, delta); }
}
__device__ __forceinline__ void p_pack6(const f32x16& p0, const f32x16& p1, v6i& pf) {
  asm("v_cvt_scalef32_2xpk16_bf6_f32 %0, %1, %2, 1.0" : "=&v"(pf) : "v"(p0), "v"(p1));
}
__device__ __forceinline__ void finishSM(f32x16& p0, f32x16& p1, float alpha, float& l_reg, v6i& pf) {
#pragma unroll
  for (int r = 0; r < 16; ++r) p0[r] = __builtin_amdgcn_exp2f(p0[r]);
#pragma unroll
  for (int r = 0; r < 16; ++r) p1[r] = __builtin_amdgcn_exp2f(p1[r]);
  f32x2 s2a = {p0[0], p0[1]}, s2b = {p1[0], p1[1]};
#pragma unroll
  for (int r = 2; r < 16; r += 2) { s2a += (f32x2){p0[r], p0[r + 1]}; s2b += (f32x2){p1[r], p1[r + 1]}; }
  s2a += s2b; float ps = s2a.x + s2a.y;
  { auto rr = __builtin_amdgcn_permlane32_swap(__float_as_uint(ps), __float_as_uint(ps), false, false);
    ps = __uint_as_float(rr[0]) + __uint_as_float(rr[1]); }
  l_reg = l_reg * alpha + ps;
  p_pack6(p0, p1, pf);
}
template <int C_> __device__ __forceinline__ void fin_chunk(f32x16& p0, f32x16& p1, f32x2& s2, v6i& pf) {
  f32x16& p = (C_ < 2) ? p0 : p1; constexpr int r0 = 8 * (C_ & 1), g0 = (C_ < 2 ? 0 : 4) + 2 * (C_ & 1);
#pragma unroll
  for (int r = r0; r < r0 + 8; ++r) p[r] = __builtin_amdgcn_exp2f(p[r]);
#pragma unroll
  for (int r = r0; r < r0 + 8; r += 2) s2 += (f32x2){p[r], p[r + 1]};
  (void)pf; (void)g0;
}
__device__ __forceinline__ void fin_tail(const f32x2& s2, float alpha, float& l_reg) {
  float ps = s2.x + s2.y;
  { auto rr = __builtin_amdgcn_permlane32_swap(__float_as_uint(ps), __float_as_uint(ps), false, false);
    ps = __uint_as_float(rr[0]) + __uint_as_float(rr[1]); }
  l_reg = l_reg * alpha + ps;
}
__device__ __forceinline__ void part_max(const f32x16& p, float& a, float& b, bool first) {
  if (first) { asm("v_max3_f32 %0, %1, %2, %3" : "=v"(a) : "v"(p[0]), "v"(p[1]), "v"(p[2])); asm("v_max3_f32 %0, %1, %2, %3" : "=v"(b) : "v"(p[3]), "v"(p[4]), "v"(p[5]));
    asm("v_max3_f32 %0, %1, %2, %3" : "=v"(a) : "v"(a), "v"(p[6]), "v"(p[7])); asm("v_max3_f32 %0, %1, %2, %3" : "=v"(b) : "v"(b), "v"(p[8]), "v"(p[9]));
    asm("v_max3_f32 %0, %1, %2, %3" : "=v"(a) : "v"(a), "v"(p[10]), "v"(p[11])); asm("v_max3_f32 %0, %1, %2, %3" : "=v"(b) : "v"(b), "v"(p[12]), "v"(p[13]));
    asm("v_max3_f32 %0, %1, %2, %3" : "=v"(a) : "v"(a), "v"(p[14]), "v"(p[15])); }
  else {
#pragma unroll
    for (int r = 0; r < 16; r += 4) { asm("v_max3_f32 %0, %1, %2, %3" : "=v"(a) : "v"(a), "v"(p[r]), "v"(p[r + 1])); asm("v_max3_f32 %0, %1, %2, %3" : "=v"(b) : "v"(b), "v"(p[r + 2]), "v"(p[r + 3])); } }
}
__device__ __forceinline__ void part_decide(float a, float b, f32x16& p0, f32x16& p1, f32x16& nm, float& alpha) {
  float pmax = fmaxf(a, b);
  { auto rr = __builtin_amdgcn_permlane32_swap(__float_as_uint(pmax), __float_as_uint(pmax), false, false);
    pmax = fmaxf(__uint_as_float(rr[0]), __uint_as_float(rr[1])); }
  if (__builtin_expect(__all(pmax <= THRP), 1)) alpha = 1.f;
  else { const float delta = fmaxf(pmax - SEED6, 0.f); alpha = __builtin_amdgcn_exp2f(-delta); sm_raise(p0, p1, nm, delta); }
}
#define ATT_MFMA8_FIRST(P, KF, QF) asm volatile("v_mfma_f32_32x32x64_f8f6f4 %0, %1, %2, %3" : "=&v"(P) : "v"(KF), "v"(QF), "v"(nm))
#define ATT_MFMA8(P, KF, QF) asm volatile("v_mfma_f32_32x32x64_f8f6f4 %0, %1, %2, %0" : "+v"(P) : "v"(KF), "v"(QF))
__device__ __forceinline__ void k_load_nope(v8i* k0, v8i* k1, const LAS char* Kn, int r32, int hi) {
#pragma unroll
  for (int s_ = 0; s_ < 2; ++s_) { const int c = 4 * s_ + 2 * hi;
    k0[s_] = __builtin_shufflevector(*(const LAS v4i*)(Kn + KN8SW(r32, c)), *(const LAS v4i*)(Kn + KN8SW(r32, c + 1)), 0, 1, 2, 3, 4, 5, 6, 7);
    k1[s_] = __builtin_shufflevector(*(const LAS v4i*)(Kn + KN8SW(32 + r32, c)), *(const LAS v4i*)(Kn + KN8SW(32 + r32, c + 1)), 0, 1, 2, 3, 4, 5, 6, 7); }
}
__device__ __forceinline__ void k_load_pe(v8i* k0, v8i* k1, const LAS char* Kr, int r32, int hi) {
  const int c = 2 * hi;
  k0[2] = __builtin_shufflevector(*(const LAS v4i*)(Kr + KR8SW(r32, c)), *(const LAS v4i*)(Kr + KR8SW(r32, c + 1)), 0, 1, 2, 3, 4, 5, 6, 7);
  k1[2] = __builtin_shufflevector(*(const LAS v4i*)(Kr + KR8SW(32 + r32, c)), *(const LAS v4i*)(Kr + KR8SW(32 + r32, c + 1)), 0, 1, 2, 3, 4, 5, 6, 7);
}
__device__ __forceinline__ void qk_mma(f32x16& p0, f32x16& p1, v8i* k0, v8i* k1, const LAS char* Kr, const v8i* qf, const f32x16& nm, int r32, int hi, int sc) {
  k_load_pe(k0, k1, Kr, r32, hi);
  asm volatile("s_waitcnt lgkmcnt(4)" ::: "memory");
  ATT_MFMA8_FIRST(p0, k0[0], qf[0]); ATT_MFMA8_FIRST(p1, k1[0], qf[0]);
  ATT_MFMA8(p0, k0[1], qf[1]); ATT_MFMA8(p1, k1[1], qf[1]);
  asm volatile("s_waitcnt lgkmcnt(0)" ::: "memory");
  ATT_MFMA8(p0, k0[2], qf[2]); ATT_MFMA8(p1, k1[2], qf[2]);
}
#define ATT_MFMA_SETTLE() asm volatile("s_nop 15\n\ts_nop 15" ::: "memory")
template <int D0> __device__ __forceinline__ v6i pv_ldv(const LAS char* va, const LAS char* vb) {
  const v4i a_ = *(const LAS v4i*)(va + D0 * 2048); const v2i_ b_ = *(const LAS v2i_*)(vb + D0 * 2048);
  return (v6i){a_[0], a_[1], a_[2], a_[3], b_[0], b_[1]};
}
#define ATT_PVMFMA(OD, VF) asm volatile("v_mfma_f32_32x32x64_f8f6f4 %0, %1, %2, %0 cbsz:3 blgp:2" : "+v"(OD) : "v"(pf), "v"(VF))
__device__ __forceinline__ void pv_loadv(v6i* vf, const LAS char* va, const LAS char* vb) { vf[0] = pv_ldv<0>(va, vb); vf[1] = pv_ldv<1>(va, vb); }
__device__ __forceinline__ void pv_mma(f32x16* o, const v6i* vf, const LAS char* va, const LAS char* vb, const v6i& pf, int sc) {
  asm volatile("s_nop 4\n\ts_waitcnt lgkmcnt(0)" ::: "memory");
  ATT_PVMFMA(o[0], vf[0]); ATT_PVMFMA(o[1], vf[1]);
  { const v6i v2 = pv_ldv<2>(va, vb), v3 = pv_ldv<3>(va, vb);
    asm volatile("s_waitcnt lgkmcnt(0)" ::: "memory");
    ATT_PVMFMA(o[2], v2); ATT_PVMFMA(o[3], v3); }
}

#define ATT_GLDS(g, l) __builtin_amdgcn_global_load_lds((const unsigned*)(g), (LAS unsigned*)(l), 16, 0, 0)
#define ATT_BAR() asm volatile("s_waitcnt lgkmcnt(0)\n\ts_barrier" ::: "memory")
#define ATT_WAITV(n) asm volatile("s_waitcnt vmcnt(" #n ")" ::: "memory")
__device__ __forceinline__ void attn_unit(const bf16_t* __restrict__ Qb, const unsigned char* __restrict__ Kn, const unsigned char* __restrict__ Vp, const unsigned char* __restrict__ Kp,
                                          unsigned char* __restrict__ Ob, const f32x2* __restrict__ rope, int pos0, int seq, LAS char* lds, int tid_in) {
  int tid = tid_in; asm volatile("" : "+v"(tid));
  const int wid = __builtin_amdgcn_readfirstlane(tid >> 6), lane = tid & 63, r32 = lane & 31, hi = lane >> 5;
  LAS char* V_lds = lds + OFF_V; LAS char* KN_lds = lds + OFF_KN; LAS char* KR_lds = lds + OFF_KR;
  LAS float* ws = (LAS float*)(lds + OFF_WS) + wid * 64; LAS float* li_l = ws; LAS float* al_l = ws + 32;
  float l_reg = 0; f32x16 o[4] = {}; f32x16 nm = {SEED6, SEED6, SEED6, SEED6, SEED6, SEED6, SEED6, SEED6, SEED6, SEED6, SEED6, SEED6, SEED6, SEED6, SEED6, SEED6}; v8i qf[3];
  int sc = 0x7f7f7f7f; asm volatile("" : "+v"(sc));
  {
    const bf16_t* Qw = Qb + (long)(wid * QBLK + r32) * LDQ;
#pragma unroll
    for (int s_ = 0; s_ < 2; ++s_) {
      u32x4 w[4];
#pragma unroll
      for (int j = 0; j < 4; ++j) w[j] = *(const u32x4*)(Qw + 64 * s_ + 32 * hi + 8 * j);
      v8i f;
#pragma unroll
      for (int j = 0; j < 4; ++j) { f[2 * j] = (int)pk4_fp8(QC * bf_lo(w[j].x), QC * bf_hi(w[j].x), QC * bf_lo(w[j].y), QC * bf_hi(w[j].y)); f[2 * j + 1] = (int)pk4_fp8(QC * bf_lo(w[j].z), QC * bf_hi(w[j].z), QC * bf_lo(w[j].w), QC * bf_hi(w[j].w)); }
      qf[s_] = f;
    }
    const f32x2* rp = rope + (size_t)(pos0 + wid * QBLK + r32) * 32;
    v8i f;
#pragma unroll
    for (int j = 0; j < 4; ++j) {
      const u32x4 xa = *(const u32x4*)(Qw + 128 + 8 * j), xb = *(const u32x4*)(Qw + 160 + 8 * j);
      float r_[8];
#pragma unroll
      for (int e = 0; e < 8; ++e) { const f32x2 cs = rp[8 * j + e];
        const unsigned wa = e < 2 ? xa.x : e < 4 ? xa.y : e < 6 ? xa.z : xa.w, wb = e < 2 ? xb.x : e < 4 ? xb.y : e < 6 ? xb.z : xb.w;
        const float x1 = (e & 1) ? bf_hi(wa) : bf_lo(wa), x2 = (e & 1) ? bf_hi(wb) : bf_lo(wb);
        r_[e] = QC * (hi ? (x1 * cs.y + x2 * cs.x) : (x1 * cs.x - x2 * cs.y)); }
      f[2 * j] = (int)pk4_fp8(r_[0], r_[1], r_[2], r_[3]); f[2 * j + 1] = (int)pk4_fp8(r_[4], r_[5], r_[6], r_[7]);
    }
    qf[2] = f;
  }
  unsigned oK, oP; const unsigned oV = (unsigned)(wid * 1024 + lane * 16);
  { const int row = 8 * wid + (lane >> 3), c = (lane & 7) ^ ((row >> 1) & 7); oK = (unsigned)(row * LDKN8 + c * 16); }
  { const int row = 16 * (wid & 3) + (lane >> 2), c = (lane & 3) ^ ((row >> 2) & 3); oP = (unsigned)(row * LDKP8 + c * 16); }
#define ISSUE(b, k0) do { const char* vsrc_ = (const char*)Vp + (size_t)(k0) * 128; const char* ksrc_ = (const char*)Kn + (size_t)(k0) * LDKN8; const char* psrc_ = (const char*)Kp + (size_t)(k0) * LDKP8; \
    ATT_GLDS(vsrc_ + oV, V_lds + (b) * SHM_V + wid * 1024); \
    ATT_GLDS(ksrc_ + oK, KN_lds + (b) * SHM_KN + wid * 1024); \
    if (wid < 4) ATT_GLDS(psrc_ + oP, KR_lds + (b) * SHM_KR + wid * 1024); } while (0)
  const LAS char* vla0 = V_lds + r32 * 64 + (((2 * hi) ^ ((r32 >> 2) & 3)) << 4);
  const LAS char* vlb0 = V_lds + r32 * 64 + (((2 * hi + 1) ^ ((r32 >> 2) & 3)) << 4);
#define RESC(a) do { if (__any((a) < 1.f)) { if (hi == 0) al_l[r32] = (a); asm volatile("s_nop 15\n\ts_nop 15\n\ts_waitcnt lgkmcnt(0)" ::: "memory");   \
    _Pragma("unroll") for (int d = 0; d < 4; ++d) _Pragma("unroll") for (int r = 0; r < 16; ++r) o[d][r] *= al_l[crow(r, hi)]; asm volatile("s_nop 4" ::: "memory"); } } while (0)
  f32x16 pA0, pA1, pB0, pB1; float alA, alB; v6i pf; const int NT = seq / KVBLK;
  v8i k0[3], k1[3]; v6i vf[2];
#define SLOT_NEXT(x) ((x) == NSLOT - 1 ? 0 : (x) + 1)
#define SLOT_PREV(x) ((x) == 0 ? NSLOT - 1 : (x) - 1)
#define KLOAD(sl_) k_load_nope(k0, k1, KN_lds + (sl_) * SHM_KN, r32, hi)
#define VLOAD(sl_) pv_loadv(vf, vla0 + (sl_) * SHM_V, vlb0 + (sl_) * SHM_V)
#define WAIT_TILES2() do { if (wid < 4) { ATT_WAITV(6); } else { ATT_WAITV(4); } } while (0)
#define STEP(j_, Pn0, Pn1, alN, Po0, Po1, alO) do { const int sm1_ = SLOT_PREV(s0), sp1_ = SLOT_NEXT(s0); f32x2 s2_ = {0.f, 0.f}; float ma_, mb_; v6i v2_, v3_; \
    const LAS char* va_ = vla0 + sm1_ * SHM_V; const LAS char* vb_ = vlb0 + sm1_ * SHM_V; \
    SBAR(); k_load_pe(k0, k1, KR_lds + s0 * SHM_KR, r32, hi); SBAR(); \
    ATT_MFMA8_FIRST(Pn0, k0[0], qf[0]); SBAR(); fin_chunk<0>(Po0, Po1, s2_, pf); SBAR(); \
    ATT_MFMA8_FIRST(Pn1, k1[0], qf[0]); SBAR(); fin_chunk<1>(Po0, Po1, s2_, pf); SBAR(); \
    ATT_MFMA8(Pn0, k0[1], qf[1]); SBAR(); fin_chunk<2>(Po0, Po1, s2_, pf); SBAR(); \
    ATT_MFMA8(Pn1, k1[1], qf[1]); SBAR(); VLOAD(sm1_); fin_chunk<3>(Po0, Po1, s2_, pf); SBAR(); p_pack6(Po0, Po1, pf); SBAR();     \
    ATT_MFMA8(Pn0, k0[2], qf[2]); SBAR(); fin_tail(s2_, alO, l_reg); SBAR(); \
    ATT_MFMA8(Pn1, k1[2], qf[2]); SBAR(); \
    ATT_PVMFMA(o[0], vf[0]); SBAR(); v2_ = pv_ldv<2>(va_, vb_); v3_ = pv_ldv<3>(va_, vb_); part_max(Pn0, ma_, mb_, true); SBAR(); \
    ATT_PVMFMA(o[1], vf[1]); SBAR(); part_max(Pn1, ma_, mb_, false); KLOAD(sp1_); SBAR(); \
    ATT_PVMFMA(o[2], v2_); SBAR(); part_decide(ma_, mb_, Pn0, Pn1, nm, alN); SBAR(); \
    ATT_PVMFMA(o[3], v3_); SBAR(); \
    RESC(alN); \
    if ((j_) + 4 < NT) { WAIT_TILES2(); } else { ATT_WAITV(0); }        \
    ATT_BAR();                                                           \
    if ((j_) + 5 < NT) { ISSUE(sm1_, ((j_) + 5) * KVBLK); } \
    s0 = sp1_; } while (0)
  ISSUE(0, 0); ISSUE(1, KVBLK); ISSUE(2, 2 * KVBLK); ISSUE(3, 3 * KVBLK); ISSUE(4, 4 * KVBLK);
  if (wid < 4) { ATT_WAITV(9); } else { ATT_WAITV(6); }
  ATT_BAR();
  KLOAD(0); qk_mma(pA0, pA1, k0, k1, KR_lds, qf, nm, r32, hi, sc); ATT_MFMA_SETTLE(); SBAR(); KLOAD(1); partialSM(pA0, pA1, nm, alA, true);
  WAIT_TILES2(); ATT_BAR();
  ISSUE(5, 5 * KVBLK);
  int s0 = 1;
  for (int j = 1; j + 1 < NT; j += 2) {
    STEP(j, pB0, pB1, alB, pA0, pA1, alA);
    STEP(j + 1, pA0, pA1, alA, pB0, pB1, alB);
  }
  { const int sm1_ = SLOT_PREV(s0);
    SBAR(); qk_mma(pB0, pB1, k0, k1, KR_lds + s0 * SHM_KR, qf, nm, r32, hi, sc); VLOAD(sm1_); SBAR();
    finishSM(pA0, pA1, alA, l_reg, pf); SBAR();
    pv_mma(o, vf, vla0 + sm1_ * SHM_V, vlb0 + sm1_ * SHM_V, pf, sc); SBAR(); VLOAD(s0); partialSM(pB0, pB1, nm, alB, false);
    RESC(alB);
    finishSM(pB0, pB1, alB, l_reg, pf); SBAR();
    pv_mma(o, vf, vla0 + s0 * SHM_V, vlb0 + s0 * SHM_V, pf, sc); }
  asm volatile("s_nop 15\n\ts_nop 15" ::: "memory");
  if (hi == 0) li_l[r32] = l_reg; asm volatile("s_waitcnt lgkmcnt(0)" ::: "memory");
  float rli[16];
#pragma unroll
  for (int r = 0; r < 16; ++r) rli[r] = (OSCALE / VSC6) * __builtin_amdgcn_rcpf(li_l[crow(r, hi)]);
  unsigned char* Ow = Ob + (long)(wid * QBLK) * LDO;
#pragma unroll
  for (int r = 0; r < 16; ++r) { const int orow = crow(r, hi);
#pragma unroll
    for (int d0 = 0; d0 < 4; ++d0) Ow[(long)orow * LDO + d0 * 32 + r32] = (unsigned char)(__builtin_amdgcn_cvt_pk_fp8_f32(o[d0][r] * rli[r], 0.f, 0, false) & 0xff); }
  ATT_BAR();
#undef ISSUE
#undef STEP
#undef RESC
}
}

constexpr int RING_OFF = 0, RING_BYTES = 131072;
constexpr int LDSCTL_OFF = RING_BYTES, MISC_OFF = LDSCTL_OFF + 320;
constexpr int LDS_BYTES = 147456;
constexpr int NWAVES = 8;
static_assert(att::LDS_BYTES <= RING_BYTES, "attention LDS");

typedef GAS unsigned gu32;
#define RLX_AGENT __ATOMIC_RELAXED, __HIP_MEMORY_SCOPE_AGENT
#define LDS_WAIT() asm volatile("s_waitcnt lgkmcnt(0)" ::: "memory")
#define VM_WAIT() asm volatile("s_waitcnt vmcnt(0)" ::: "memory")

#define XB_TMO      128
#define XB_XCNT(j)  (256  + 64 * (j))
#define XB_XSUB(j)  (1280 + 64 * (j))
#define XB_XGEN(j)  (2304 + 64 * (j))
#define XB_TOP      3328
#define XB_TOPGEN   3392
#define XCD_BAR_WORDS 3456
#define XB_SPIN_CAP (1u << 22)

__device__ __forceinline__ unsigned xb_ld(unsigned* p)              { return __hip_atomic_load(p, __ATOMIC_RELAXED, __HIP_MEMORY_SCOPE_AGENT); }
__device__ __forceinline__ unsigned xb_add(unsigned* p, unsigned v) { return __hip_atomic_fetch_add(p, v, __ATOMIC_RELAXED, __HIP_MEMORY_SCOPE_AGENT); }
__device__ __forceinline__ unsigned xb_xcc_id() { return (unsigned)__builtin_amdgcn_s_getreg((3 << 11) | 20) & 0xFu; }
#define XB_SPIN(cond, bar) do { unsigned _sp = 0; while (cond) { __builtin_amdgcn_s_sleep(1); \
    if ((++_sp & 255u) == 0u) { if (xb_ld(&(bar)[XB_TMO])) break; if (_sp > XB_SPIN_CAP) { atomicAdd(&(bar)[XB_TMO], 1u); break; } } } } while (0)

struct XcdBarrier { unsigned* bar; unsigned x; volatile LAS unsigned* st; };

__device__ __forceinline__ XcdBarrier xcd_barrier_post(unsigned* bar, volatile LAS unsigned* st) {
    XcdBarrier b; b.bar = bar; b.x = xb_xcc_id(); b.st = st;
    if (threadIdx.x == 0) (void)xb_add(&bar[XB_XCNT(b.x)], 1u);
    return b;
}
__device__ __forceinline__ void xcd_barrier_complete(unsigned* bar, unsigned x, unsigned& nloc, unsigned& nx) {
    const unsigned G = gridDim.x * gridDim.y * gridDim.z;
    unsigned sum, cnt, mine, sp = 0u;
    for (;;) {
        sum = 0u; cnt = 0u; mine = 0u;
#pragma unroll
        for (unsigned j = 0; j < 16; ++j) { const unsigned c = xb_ld(&bar[XB_XCNT(j)]); sum += c; cnt += (c > 0u) ? 1u : 0u; mine = (j == x) ? c : mine; }
        if (sum == G) break;
        __builtin_amdgcn_s_sleep(1);
        if ((++sp & 255u) == 0u) { if (xb_ld(&bar[XB_TMO])) break; if (sp > XB_SPIN_CAP) { atomicAdd(&bar[XB_TMO], 1u); break; } }
    }
    nloc = mine > 0u ? mine : 1u; nx = cnt > 0u ? cnt : 1u;
}
__device__ __forceinline__ void xcd_barrier(const XcdBarrier& b, int tid) {
    asm volatile("s_waitcnt vmcnt(0)" ::: "memory");
    __syncthreads();
    if (tid == 0) {
        unsigned* bar = b.bar;
        __builtin_amdgcn_s_waitcnt(0);
        unsigned nloc = b.st[0], nx = b.st[1];
        if (nloc == 0u) { xcd_barrier_complete(bar, b.x, nloc, nx); b.st[0] = nloc; b.st[1] = nx; }
        const unsigned old = xb_add(&bar[XB_XSUB(b.x)], 1u);
        const unsigned gen = old / nloc;
        if (old + 1u == (gen + 1u) * nloc) {
            __builtin_amdgcn_fence(__ATOMIC_RELEASE, "agent");
            asm volatile("s_waitcnt vmcnt(0)" ::: "memory");
            const unsigned og = xb_add(&bar[XB_TOP], 1u);
            const unsigned tg = og / nx;
            if (og + 1u == (tg + 1u) * nx) xb_add(&bar[XB_TOPGEN], 1u);
            else XB_SPIN(xb_ld(&bar[XB_TOPGEN]) == tg, bar);
            __builtin_amdgcn_fence(__ATOMIC_ACQUIRE, "agent");
            xb_add(&bar[XB_XGEN(b.x)], 1u);
            asm volatile("s_waitcnt vmcnt(0)" ::: "memory");
        } else {
            XB_SPIN(xb_ld(&bar[XB_XGEN(b.x)]) == gen, bar);
            __builtin_amdgcn_fence(__ATOMIC_ACQUIRE, "agent");
            asm volatile("s_waitcnt vmcnt(0)" ::: "memory");
        }
    }
    __syncthreads();
}

struct Args {
    const float* x_prompt; const float* x_sample; const float* norm1; const float* w_in; const float* conv_w; const float* conv_b;
    const float* lru_wa; const float* lru_ba; const float* lru_wx; const float* lru_bx; const float* lru_lam;
    const float* q_norm; const float* w_q_up; const float* kv_norm; const float* w_kv_up; const float* w_lru_proj; const float* w_mla_proj; const float* w_out;
    const float* norm2; const float* w_up; const float* w_down; const float* norm_f;
    float* out; unsigned char* ws; int ph_lo, ph_hi, li, pad;
};

__device__ __forceinline__ float wave_sum(float v) {
    v += __builtin_bit_cast(float, __builtin_amdgcn_ds_swizzle(__builtin_bit_cast(int, v), (1 << 10) | 0x1f));
    v += __builtin_bit_cast(float, __builtin_amdgcn_ds_swizzle(__builtin_bit_cast(int, v), (2 << 10) | 0x1f));
    v += __builtin_bit_cast(float, __builtin_amdgcn_ds_swizzle(__builtin_bit_cast(int, v), (4 << 10) | 0x1f));
    v += __builtin_bit_cast(float, __builtin_amdgcn_ds_swizzle(__builtin_bit_cast(int, v), (8 << 10) | 0x1f));
    v += __builtin_bit_cast(float, __builtin_amdgcn_ds_swizzle(__builtin_bit_cast(int, v), (16 << 10) | 0x1f));
    { const auto rr = __builtin_amdgcn_permlane32_swap(__float_as_uint(v), __float_as_uint(v), false, false); v = __uint_as_float(rr[0]) + __uint_as_float(rr[1]); }
    return v;
}
__device__ __forceinline__ float wave_max(float v) {
    v = fmaxf(v, __builtin_bit_cast(float, __builtin_amdgcn_ds_swizzle(__builtin_bit_cast(int, v), (1 << 10) | 0x1f)));
    v = fmaxf(v, __builtin_bit_cast(float, __builtin_amdgcn_ds_swizzle(__builtin_bit_cast(int, v), (2 << 10) | 0x1f)));
    v = fmaxf(v, __builtin_bit_cast(float, __builtin_amdgcn_ds_swizzle(__builtin_bit_cast(int, v), (4 << 10) | 0x1f)));
    v = fmaxf(v, __builtin_bit_cast(float, __builtin_amdgcn_ds_swizzle(__builtin_bit_cast(int, v), (8 << 10) | 0x1f)));
    v = fmaxf(v, __builtin_bit_cast(float, __builtin_amdgcn_ds_swizzle(__builtin_bit_cast(int, v), (16 << 10) | 0x1f)));
    { const auto rr = __builtin_amdgcn_permlane32_swap(__float_as_uint(v), __float_as_uint(v), false, false); v = fmaxf(__uint_as_float(rr[0]), __uint_as_float(rr[1])); }
    return v;
}
__device__ __forceinline__ void transpose_item(const float* W, int ldw, int k0, int n0, bf16_t* WT, int ldt, int drow0, LAS float* scr, int lane, const float* kgain = nullptr) {
#pragma unroll 8
    for (int i = 0; i < 32; ++i) { const int kk = 2 * i + (lane >> 5); const float w_ = W[(size_t)(k0 + kk) * ldw + n0 + (lane & 31)]; scr[kk * 33 + (lane & 31)] = kgain ? w_ * kgain[k0 + kk] : w_; }
    LDS_WAIT(); asm volatile("" ::: "memory");
    const int c = lane & 7;
#pragma unroll
    for (int j = 0; j < 4; ++j) { const int n = (lane >> 3) + 8 * j; const LAS float* s = scr + (8 * c) * 33 + n;
        u32x4 o; o.x = cvt_pk_bf16(s[0 * 33], s[1 * 33]); o.y = cvt_pk_bf16(s[2 * 33], s[3 * 33]); o.z = cvt_pk_bf16(s[4 * 33], s[5 * 33]); o.w = cvt_pk_bf16(s[6 * 33], s[7 * 33]);
        *(u32x4*)(WT + (size_t)(drow0 + n) * ldt + k0 + 8 * c) = o; }
    LDS_WAIT(); asm volatile("" ::: "memory");
}
template <bool I8 = false> __device__ __forceinline__ void transpose_item_f8(const float* W, int ldw, int k0, int n0, unsigned char* WT, int ldt, int drow0, float mul, LAS float* scr, int lane) {
    float v_[32];
#pragma unroll
    for (int i = 0; i < 32; ++i) { const int kk = 2 * i + (lane >> 5); v_[i] = W[(size_t)(k0 + kk) * ldw + n0 + (lane & 31)]; }
#pragma unroll
    for (int i = 0; i < 32; ++i) { const int kk = 2 * i + (lane >> 5); scr[kk * 33 + (lane & 31)] = v_[i]; }
    LDS_WAIT(); asm volatile("" ::: "memory");
    const int c = lane & 7;
#pragma unroll
    for (int j = 0; j < 4; ++j) { const int n = (lane >> 3) + 8 * j; const LAS float* s = scr + (8 * c) * 33 + n;
        u32x2 o; if constexpr (I8) { o.x = pk4_i8(s[0 * 33], s[1 * 33], s[2 * 33], s[3 * 33], mul); o.y = pk4_i8(s[4 * 33], s[5 * 33], s[6 * 33], s[7 * 33], mul); }
        else { o.x = pk4_fp8(s[0 * 33] * mul, s[1 * 33] * mul, s[2 * 33] * mul, s[3 * 33] * mul); o.y = pk4_fp8(s[4 * 33] * mul, s[5 * 33] * mul, s[6 * 33] * mul, s[7 * 33] * mul); }
        *(u32x2*)(WT + (size_t)(drow0 + n) * ldt + k0 + 8 * c) = o; }
    LDS_WAIT(); asm volatile("" ::: "memory");
}
__device__ __forceinline__ void fwht64(float (&v)[64]) {
#pragma unroll
    for (int s_ = 1; s_ < 64; s_ <<= 1)
#pragma unroll
        for (int i = 0; i < 64; ++i) if ((i & s_) == 0) { const float a = v[i], b = v[i | s_]; v[i] = a + b; v[i | s_] = a - b; }
#pragma unroll
    for (int i = 0; i < 64; ++i) v[i] *= 0.125f;
}
__device__ __forceinline__ void transpose_item_h64_i8(const float* W, int ldw, int k0, int n0, unsigned char* WT, int ldt, int drow0, float qs, LAS float* scr, int lane) {
    float v_[32];
#pragma unroll
    for (int i = 0; i < 32; ++i) { const int kk = 2 * i + (lane >> 5); v_[i] = W[(size_t)(k0 + kk) * ldw + n0 + (lane & 31)]; }
#pragma unroll
    for (int i = 0; i < 32; ++i) { const int kk = 2 * i + (lane >> 5); scr[kk * 33 + (lane & 31)] = v_[i]; }
    LDS_WAIT(); asm volatile("" ::: "memory");
    if (lane < 32) {
        float c_[64];
#pragma unroll
        for (int k = 0; k < 64; ++k) c_[k] = scr[k * 33 + lane];
        fwht64(c_);
#pragma unroll
        for (int k = 0; k < 64; ++k) scr[k * 33 + lane] = c_[k];
    }
    LDS_WAIT(); asm volatile("" ::: "memory");
    const int c = lane & 7;
#pragma unroll
    for (int j = 0; j < 4; ++j) { const int n = (lane >> 3) + 8 * j; const LAS float* s = scr + (8 * c) * 33 + n;
        u32x2 o; o.x = pk4_i8(s[0 * 33], s[1 * 33], s[2 * 33], s[3 * 33], qs); o.y = pk4_i8(s[4 * 33], s[5 * 33], s[6 * 33], s[7 * 33], qs);
        *(u32x2*)(WT + (size_t)(drow0 + n) * ldt + k0 + 8 * c) = o; }
    LDS_WAIT(); asm volatile("" ::: "memory");
}
__device__ __forceinline__ void transpose_item_h32_i8(const float* W, int ldw, int k0, int n0, unsigned char* WT, int ldt, int drow0, float qs, LAS float* scr, int lane) {
    float v_[32];
#pragma unroll
    for (int i = 0; i < 32; ++i) { const int kk = 2 * i + (lane >> 5); v_[i] = W[(size_t)(k0 + kk) * ldw + n0 + (lane & 31)]; }
#pragma unroll
    for (int i = 0; i < 32; ++i) { const int kk = 2 * i + (lane >> 5); scr[kk * 33 + (lane & 31)] = v_[i]; }
    LDS_WAIT(); asm volatile("" ::: "memory");
    { const int n = lane & 31, kb = (lane >> 5) * 32;
      float c_[32];
#pragma unroll
      for (int k = 0; k < 32; ++k) c_[k] = scr[(kb + k) * 33 + n];
#pragma unroll
      for (int s_ = 1; s_ < 32; s_ <<= 1)
#pragma unroll
          for (int i = 0; i < 32; ++i) if ((i & s_) == 0) { const float a = c_[i], b = c_[i | s_]; c_[i] = a + b; c_[i | s_] = a - b; }
#pragma unroll
      for (int k = 0; k < 32; ++k) scr[(kb + k) * 33 + n] = c_[k] * 0.17677669529663689f; }
    LDS_WAIT(); asm volatile("" ::: "memory");
    const int c = lane & 7;
#pragma unroll
    for (int j = 0; j < 4; ++j) { const int n = (lane >> 3) + 8 * j; const LAS float* s = scr + (8 * c) * 33 + n;
        u32x2 o; o.x = pk4_i8(s[0 * 33], s[1 * 33], s[2 * 33], s[3 * 33], qs); o.y = pk4_i8(s[4 * 33], s[5 * 33], s[6 * 33], s[7 * 33], qs);
        *(u32x2*)(WT + (size_t)(drow0 + n) * ldt + k0 + 8 * c) = o; }
    LDS_WAIT(); asm volatile("" ::: "memory");
}
__device__ __forceinline__ void transpose_job(const float* W, int K, int N, bf16_t* WT, int r, LAS float* scr, int lane) {
    const int nblk = N / 32, kb = r / nblk, nb = r % nblk;
    transpose_item(W, N, 64 * kb, 32 * nb, WT, K, 32 * nb, scr, lane);
}

__device__ __forceinline__ void rms_row_to_bf16(const float* xrow, const float* g, bf16_t* orow, int lane, unsigned char* o8row = nullptr) {
    const f32x4* xr = (const f32x4*)xrow + lane; const f32x4* gr = (const f32x4*)g + lane;
    f32x4 v[16]; float s = 0.f;
#pragma unroll
    for (int j = 0; j < 16; ++j) { v[j] = xr[64 * j]; s += (v[j].x * v[j].x + v[j].y * v[j].y) + (v[j].z * v[j].z + v[j].w * v[j].w); }
    const float rstd = 1.0f / sqrtf(wave_sum(s) * (1.f / D) + EPS);
    u32x2* o8 = (u32x2*)orow + lane;
#pragma unroll
    for (int j = 0; j < 16; ++j) { const f32x4 gg = gr[64 * j]; const f32x4 y = v[j] * rstd * gg;
        if (orow) { u32x2 w; w.x = cvt_pk_bf16(y.x, y.y); w.y = cvt_pk_bf16(y.z, y.w); o8[64 * j] = w; }
        if (o8row) ((unsigned*)o8row)[lane + 64 * j] = pk4_i8(y.x, y.y, y.z, y.w, XN_QS); }
}
__device__ __forceinline__ void rms_row_inplace_f32(float* xrow, const float* g, int lane) {
    f32x4* xr = (f32x4*)xrow + lane; const f32x4* gr = (const f32x4*)g + lane;
    f32x4 v[16]; float s = 0.f;
#pragma unroll
    for (int j = 0; j < 16; ++j) { v[j] = xr[64 * j]; s += (v[j].x * v[j].x + v[j].y * v[j].y) + (v[j].z * v[j].z + v[j].w * v[j].w); }
    const float rstd = 1.0f / sqrtf(wave_sum(s) * (1.f / D) + EPS);
#pragma unroll
    for (int j = 0; j < 16; ++j) { const f32x4 gg = gr[64 * j]; xr[64 * j] = v[j] * rstd * gg; }
}

__device__ __forceinline__ void rms_row_from_bf16(const bf16_t* xrow, const float* g, bf16_t* obf, unsigned char* o8, float* of32, int lane, float* rs2out = nullptr) {
    f32x4 v[16]; float s = 0.f;
#pragma unroll
    for (int j = 0; j < 8; ++j) { pg8::unpack8(*(const u32x4*)(xrow + (lane + 64 * j) * 8), v[2 * j], v[2 * j + 1]); }
#pragma unroll
    for (int j = 0; j < 16; ++j) s += (v[j].x * v[j].x + v[j].y * v[j].y) + (v[j].z * v[j].z + v[j].w * v[j].w);
    const float rstd = 1.0f / sqrtf(wave_sum(s) * (1.f / D) + EPS);
    if (rs2out && lane == 0) *rs2out = rstd * rstd;
#pragma unroll
    for (int j = 0; j < 8; ++j) { const int c = (lane + 64 * j) * 8; const f32x4 y0 = v[2 * j] * rstd * *(const f32x4*)(g + c), y1 = v[2 * j + 1] * rstd * *(const f32x4*)(g + c + 4);
        if (obf) *(u32x4*)(obf + c) = pg8::pack8(y0, y1);
        if (o8) *(u32x2*)(o8 + c) = (u32x2){pk4_i8(y0.x, y0.y, y0.z, y0.w, XN_QS), pk4_i8(y1.x, y1.y, y1.z, y1.w, XN_QS)};
        if (of32) { *(f32x4*)(of32 + c) = y0; *(f32x4*)(of32 + c + 4) = y1; } }
}
__device__ __forceinline__ void lru_gate(float lr, float li, float x, float sp8l2, float& la2, float& u) {
    const float r = fast_sigmoid(lr), i = fast_sigmoid(li);
    la2 = -r * sp8l2;
    const float a = __builtin_amdgcn_exp2f(la2);
    const float m = sqrtf(fmaxf(1.0f - a * a, 0.f));
    u = m * i * x;
}
constexpr int TB_SP8 = 0, TB_GBIAS = 2 * D, TB_NORM1 = TB_GBIAS + NG, TB_NORM2 = TB_NORM1 + D, TB_NORMF = TB_NORM2 + D, TB_CONVW = TB_NORMF + D, TB_CONVB = TB_CONVW + 4 * D,
              TB_QNORM = TB_CONVB + D, TB_KVNORM = TB_QNORM + 1024, TB_END = TB_KVNORM + 512;
static_assert(TB_END * 4 <= (int)MiB, "TAB region");
#ifndef PHMASK
#define PHMASK 0xffffu
#endif
#define EN(b) ((PHMASK >> (b)) & 1u)
#define CAS __attribute__((address_space(4)))
#define PHASE_BEGIN() int tid; asm volatile("v_mbcnt_lo_u32_b32 %0, -1, 0\n\tv_mbcnt_hi_u32_b32 %0, -1, %0" : "=v"(tid)); tid += wave0 * 64;     \
    const CAS Args* kp = (const CAS Args*)__builtin_amdgcn_kernarg_segment_ptr(); int G = G0, bx = bx0, vcu = vcu0; \
    asm volatile("" : "+v"(tid), "+s"(kp), "+s"(G), "+s"(bx), "+s"(vcu)); unsigned char* ws = kp->ws; const int NGW = G * NWAVES; (void)NGW; (void)bx; \
    const int lane = tid & 63, wave = __builtin_amdgcn_readfirstlane(tid >> 6), gw = vcu * NWAVES + wave; (void)lane; (void)wave; (void)gw; \
    float* TAB = (float*)(ws + WS_TAB); (void)TAB

__global__ void __launch_bounds__(NWAVES * 64, 2) fwd(Args args) {
    extern __shared__ __attribute__((aligned(16))) unsigned char lds_raw[];
    LAS unsigned char* lds = (LAS unsigned char*)lds_raw;
    volatile LAS unsigned* MISC = (volatile LAS unsigned*)(lds + MISC_OFF);
    const int wave0 = __builtin_amdgcn_readfirstlane((int)threadIdx.x >> 6);
    const int G0 = gridDim.x, bx0 = blockIdx.x;
    const int vcu0 = (G0 % 8 == 0) ? (bx0 % 8) * (G0 / 8) + bx0 / 8 : bx0;
    gu32* ctl = (gu32*)(args.ws + WS_CTL);
    for (int u = threadIdx.x; u < (LDS_BYTES - LDSCTL_OFF) / 4; u += NWAVES * 64) ((LAS unsigned*)(lds + LDSCTL_OFF))[u] = 0u;
    __syncthreads();
    XcdBarrier bar; bar.bar = (unsigned*)(ctl + CW_BAR) + args.li * XCD_BAR_WORDS; bar.x = 0; bar.st = nullptr;
    if (MK_N_LAUNCHES == 0) bar = xcd_barrier_post((unsigned*)(ctl + CW_BAR) + args.li * XCD_BAR_WORDS, MISC + 8);
    const int lo = args.ph_lo, hi = args.ph_hi;
#define IN(k) (lo <= (k) && (k) < hi)
#define SEAM(k) do { if ((k) + 1 < hi) { if (MK_N_LAUNCHES == 0) xcd_barrier(bar, tid); } } while (0)

    if (EN(0) && IN(0)) {
        PHASE_BEGIN();
        bf16_t* WIN_T = (bf16_t*)(ws + WS_WIN); bf16_t* WG_T = (bf16_t*)(ws + WS_WG);
        LAS float* scr = (LAS float*)(lds + RING_OFF + wave * 16384);
        constexpr int I_IN = (D / 64) * (IN_COLS / 32);
        constexpr int I_G = 64 * 32;
        constexpr int I_Q = (1024 / 64) * (NQ / 32);
        constexpr int I_KV = (512 / 64) * (NKV / 32);
        constexpr int I_SQ = (D / 64) * (D / 32);
        constexpr int I_UP = (D / 64) * (DFF / 32);
        constexpr int I_DN = (DFF / 64) * (D / 32);
        constexpr int NITEMS = I_IN + I_G + I_Q + I_KV + 3 * I_SQ + I_UP + I_DN;
        for (int it = gw; it < NITEMS; it += NGW) {
            int r = it;
            if (r < I_IN) { const int nblk = IN_COLS / 32, kb = r / nblk, nb = r % nblk, n0 = 32 * nb;
                transpose_item_f8<true>(kp->w_in, IN_COLS, 64 * kb, n0, (unsigned char*)WIN_T, D, n0 < SRC_GATE ? n0 : n0 + 192, WIN_QS, scr, lane);
                continue; } r -= I_IN;
            if (r < I_G) { const int mat = r >> 5, sub = r & 31, kb = sub >> 3, nb = sub & 7;
                const int isx = mat & 1, hb = (mat >> 1) & 15, dir = mat >> 5; const float* W = (isx ? kp->lru_wx : kp->lru_wa) + (size_t)(dir * 16 + hb) * 65536;
                transpose_item(W, 256, 64 * kb, 32 * nb, WG_T, 256, (hb * 4 + dir * 2 + (nb >> 2)) * 256 + isx * 128 + (nb & 3) * 32, scr, lane); continue; } r -= I_G;
            if (r < I_Q) { const int nblk = NQ / 32, kb = r / nblk, nb = r % nblk; transpose_item_f8(kp->w_q_up, NQ, 64 * kb, 32 * nb, (unsigned char*)(ws + WS_WQ), 1024, 32 * nb, 64.0f, scr, lane); continue; } r -= I_Q;
            if (r < I_KV) { const int nblk = NKV / 32, kb = r / nblk, nb = r % nblk; transpose_item_f8(kp->w_kv_up, NKV, 64 * kb, 32 * nb, (unsigned char*)(ws + WS_WKV), 512, 32 * nb, 64.0f, scr, lane); continue; } r -= I_KV;
            if (r < I_SQ) { const int nblk = D / 32, kb = r / nblk, nb = r % nblk; transpose_item_h64_i8(kp->w_lru_proj, D, 64 * kb, 32 * nb, (unsigned char*)(ws + WS_WLP), D, 32 * nb, WSQ_QS, scr, lane); continue; } r -= I_SQ;
            if (r < I_SQ) { const int nblk = D / 32, kb = r / nblk, nb = r % nblk; transpose_item_f8(kp->w_mla_proj, D, 64 * kb, 32 * nb, (unsigned char*)(ws + WS_WMP), D, 32 * nb, 64.0f, scr, lane); continue; } r -= I_SQ;
            if (r < I_SQ) { const int nblk = D / 32, kb = r / nblk, nb = r % nblk; transpose_item_h32_i8(kp->w_out, D, 64 * kb, 32 * nb, (unsigned char*)(ws + WS_WO), D, 32 * nb, WSQ_QS, scr, lane); continue; } r -= I_SQ;
            if (r < I_UP) { const int nblk = DFF / 32, kb = r / nblk, nb = r % nblk, n0 = 32 * nb;
                if (n0 < NUP8) transpose_item_f8<true>(kp->w_up, DFF, 64 * kb, n0, (unsigned char*)(ws + WS_WUP), D, n0, WSQ_QS, scr, lane);
                else transpose_item(kp->w_up, DFF, 64 * kb, n0, (bf16_t*)(ws + WS_WUPB), D, n0 - NUP8, scr, lane, kp->norm2);
                continue; } r -= I_UP;
            transpose_job(kp->w_down, DFF, D, (bf16_t*)(ws + WS_WDN), r, scr, lane);
        }
        const int gt = vcu * (NWAVES * 64) + tid, NGT = G * NWAVES * 64;
        for (int i = gt; i < 192 * D / 16; i += NGT) *(u32x4*)(ws + WS_WIN + (size_t)SRC_GATE * D + (size_t)i * 16) = (u32x4){0u, 0u, 0u, 0u};
        f32x2* ROPE = (f32x2*)(ws + WS_ROPE);
        for (int i = gt; i < SEQ_P * 32; i += NGT) { const int pos = i >> 5, k = i & 31;
            const float inv = 1.0f / powf(10000.0f, (float)k * (1.0f / 32.0f)); const float ang = (float)pos * inv;
            const double rev = (double)ang * 0.15915494309189535; const float fr = (float)(rev - __builtin_rint(rev));
            ROPE[i] = (f32x2){__builtin_amdgcn_cosf(fr), __builtin_amdgcn_sinf(fr)}; }
        for (int i = gt; i < 2 * D; i += NGT) { const float lam = kp->lru_lam[i]; TAB[TB_SP8 + i] = 8.0f * 1.4426950408889634f * log1pf(expf(-lam)); }
        for (int i = gt; i < NG; i += NGT) { const int hb = i >> 10, gate = (i >> 8) & 3, j = i & 255, dir = gate >> 1, isx = gate & 1;
            TAB[TB_GBIAS + i] = (isx ? kp->lru_bx : kp->lru_ba)[(dir * 16 + hb) * 256 + j]; }
        for (int i = gt; i < D; i += NGT) { TAB[TB_NORM1 + i] = kp->norm1[i]; TAB[TB_NORM2 + i] = kp->norm2[i]; TAB[TB_NORMF + i] = kp->norm_f[i]; TAB[TB_CONVB + i] = kp->conv_b[i]; }
        for (int i = gt; i < 4 * D; i += NGT) TAB[TB_CONVW + i] = kp->conv_w[i];
        for (int i = gt; i < 1024; i += NGT) TAB[TB_QNORM + i] = kp->q_norm[i];
        for (int i = gt; i < 512; i += NGT) TAB[TB_KVNORM + i] = kp->kv_norm[i];
        { bf16_t* XN = (bf16_t*)(ws + WS_XN);
          for (int m = gw; m < MG; m += NGW) rms_row_to_bf16(kp->x_prompt + (size_t)m * D, kp->norm1, nullptr, lane, ws + WS_XN8 + (size_t)m * D); }
        SEAM(0);
    }

    for (int grp = 0; grp < NGROUP; ++grp) {
        const int pb = 1 + grp * 7;
        if (hi <= pb || lo >= pb + 7) continue;
        const int L = grp == 0 ? SEQ_P : SEQ_S;
#define XG() (grp == 0 ? kp->x_prompt : kp->x_sample + (size_t)(grp - 1) * MG * D)
#define OUTG() (kp->out + (size_t)grp * MG * D)
#define KVB() ((bf16_t*)OUTG())

        if (EN(2) && IN(pb + 0)) {
            PHASE_BEGIN();
            {
              pg8::Gemm g{(bf16_t*)(ws + WS_XN8), (bf16_t*)(ws + WS_WIN), MG, NZ, D / 2, D / 2, D / 2, 0, 0}; pg8::StaticOrder S; S.init(MG, NZ, G, bx);
              pg8::EpiZ E{(bf16_t*)(ws + WS_Z), NZ, 0, 1.0f / (XN_QS * WIN_QS)};
              pg8::gemm_phase<pg8::EpiZ, pg8::StaticOrder, true, true, 2>(lds + RING_OFF, g, S, E, tid); }
            SEAM(pb + 0);
        }
        if (EN(3) && IN(pb + 1)) {
            PHASE_BEGIN();
            const bf16_t* Z = (const bf16_t*)(ws + WS_Z); bf16_t* XC = (bf16_t*)(ws + WS_XC); bf16_t* CQN = (bf16_t*)(ws + WS_CQN); bf16_t* CKVN = (bf16_t*)(ws + WS_CKVN); bf16_t* KPE = (bf16_t*)(ws + WS_KPE);
            const f32x2* ROPE = (const f32x2*)(ws + WS_ROPE);
            for (int mb = gw; mb < MG / 4; mb += NGW) {
              const int m0 = mb * 4, pos0 = m0 % L;
#pragma unroll 1
              for (int j = 0; j < 8; ++j) { const int ch = lane * 8 + 512 * j;
                  float wgt[4][8], bia[8];
                  { const f32x4 b0 = *(const f32x4*)(TAB + TB_CONVB + ch), b1 = *(const f32x4*)(TAB + TB_CONVB + ch + 4);
                    bia[0] = b0.x; bia[1] = b0.y; bia[2] = b0.z; bia[3] = b0.w; bia[4] = b1.x; bia[5] = b1.y; bia[6] = b1.z; bia[7] = b1.w; }
#pragma unroll
                  for (int k = 0; k < 4; ++k) { const f32x4 w0 = *(const f32x4*)(TAB + TB_CONVW + k * D + ch), w1 = *(const f32x4*)(TAB + TB_CONVW + k * D + ch + 4);
                      wgt[k][0] = w0.x; wgt[k][1] = w0.y; wgt[k][2] = w0.z; wgt[k][3] = w0.w; wgt[k][4] = w1.x; wgt[k][5] = w1.y; wgt[k][6] = w1.z; wgt[k][7] = w1.w; }
                  u32x4 xr[7];
#pragma unroll
                  for (int i = 0; i < 7; ++i) { const int pp = pos0 + i - 2, pc = pp < 0 ? 0 : (pp >= L ? L - 1 : pp);
                      const u32x4 t_ = *(const u32x4*)(Z + (size_t)(m0 - pos0 + pc) * NZ + ch); const unsigned k_ = (pp >= 0 && pp < L) ? 0xffffffffu : 0u;
                      xr[i] = (u32x4){t_.x & k_, t_.y & k_, t_.z & k_, t_.w & k_}; }
#pragma unroll
                  for (int r = 0; r < 4; ++r) { float a[8];
#pragma unroll
                      for (int e = 0; e < 8; ++e) a[e] = bia[e];
#pragma unroll
                      for (int k = 0; k < 4; ++k) { const u32x4 xv = xr[r + k];
                          a[0] += wgt[k][0] * bf_lo(xv.x); a[1] += wgt[k][1] * bf_hi(xv.x); a[2] += wgt[k][2] * bf_lo(xv.y); a[3] += wgt[k][3] * bf_hi(xv.y);
                          a[4] += wgt[k][4] * bf_lo(xv.z); a[5] += wgt[k][5] * bf_hi(xv.z); a[6] += wgt[k][6] * bf_lo(xv.w); a[7] += wgt[k][7] * bf_hi(xv.w); }
                      u32x4 o; o.x = cvt_pk_bf16(a[0], a[1]); o.y = cvt_pk_bf16(a[2], a[3]); o.z = cvt_pk_bf16(a[4], a[5]); o.w = cvt_pk_bf16(a[6], a[7]);
                      *(u32x4*)(XC + (size_t)(m0 + r) * D + ch) = o; } }
#pragma unroll 1
              for (int r4 = 0; r4 < 4; ++r4) { const int m = m0 + r4, pos = pos0 + r4;
                const bf16_t* zr = Z + (size_t)m * NZ;
                {
                    f32x4 v[4]; float s = 0.f;
#pragma unroll
                    for (int j = 0; j < 2; ++j) { pg8::unpack8(*(const u32x4*)(zr + ZC_CQ + lane * 8 + 512 * j), v[2 * j], v[2 * j + 1]); }
#pragma unroll
                    for (int j = 0; j < 4; ++j) s += (v[j].x * v[j].x + v[j].y * v[j].y) + (v[j].z * v[j].z + v[j].w * v[j].w);
                    const float rstd = 1.0f / sqrtf(wave_sum(s) * (1.f / 1024.f) + EPS);
#pragma unroll
                    for (int j = 0; j < 2; ++j) { const int c = lane * 8 + 512 * j; const f32x4 g0 = *(const f32x4*)(TAB + TB_QNORM + c), g1 = *(const f32x4*)(TAB + TB_QNORM + c + 4);
                        const f32x4 y0 = v[2 * j] * rstd * g0, y1 = v[2 * j + 1] * rstd * g1;
                        *(u32x2*)((unsigned char*)CQN + (size_t)m * 1024 + c) = (u32x2){pk4_fp8(y0.x, y0.y, y0.z, y0.w), pk4_fp8(y1.x, y1.y, y1.z, y1.w)}; }
                }
                {
                    f32x4 v0, v1; pg8::unpack8(*(const u32x4*)(zr + ZC_CKV + lane * 8), v0, v1);
                    float s = (v0.x * v0.x + v0.y * v0.y) + (v0.z * v0.z + v0.w * v0.w) + (v1.x * v1.x + v1.y * v1.y) + (v1.z * v1.z + v1.w * v1.w);
                    const float rstd = 1.0f / sqrtf(wave_sum(s) * (1.f / 512.f) + EPS);
                    const int c = lane * 8; const f32x4 g0 = *(const f32x4*)(TAB + TB_KVNORM + c), g1 = *(const f32x4*)(TAB + TB_KVNORM + c + 4);
                    const f32x4 y0 = v0 * rstd * g0, y1 = v1 * rstd * g1;
                    *(u32x2*)((unsigned char*)CKVN + (size_t)m * 512 + c) = (u32x2){pk4_fp8(y0.x, y0.y, y0.z, y0.w), pk4_fp8(y1.x, y1.y, y1.z, y1.w)};
                }
                if (lane < 32) {
                    const float x1 = __uint_as_float(((unsigned)zr[ZC_KR + lane]) << 16), x2 = __uint_as_float(((unsigned)zr[ZC_KR + 32 + lane]) << 16);
                    const f32x2 cs = ROPE[(size_t)pos * 32 + lane];
                    ((unsigned char*)KPE)[(size_t)m * 64 + lane] = (unsigned char)(__builtin_amdgcn_cvt_pk_fp8_f32(x1 * cs.x - x2 * cs.y, 0.f, 0, false) & 0xff);
                    ((unsigned char*)KPE)[(size_t)m * 64 + 32 + lane] = (unsigned char)(__builtin_amdgcn_cvt_pk_fp8_f32(x1 * cs.y + x2 * cs.x, 0.f, 0, false) & 0xff);
                }
              }
            }
            SEAM(pb + 1);
        }
        if (EN(4) && IN(pb + 2)) {
            PHASE_BEGIN();
            { pg8::Gemm g{(bf16_t*)(ws + WS_XC), (bf16_t*)(ws + WS_WG), MG, NG, 256, D, 256, 2, 256}; pg8::StaticOrder S; S.init(MG, NG, G, bx);
              pg8::EpiLru E{(bf16_t*)(ws + WS_G), (const bf16_t*)(ws + WS_XC), TAB + TB_GBIAS, TAB + TB_SP8, (f32x2*)(ws + WS_SUM), (LAS f32x2*)(lds + LDSCTL_OFF + 2048)};
              pg8::gemm_phase<pg8::EpiLru, pg8::StaticOrder, true, false, 0, true>(lds + RING_OFF, g, S, E, tid); }
            { pg8::Gemm g{(bf16_t*)(ws + WS_CQN), (bf16_t*)(ws + WS_WQ), MG, NQ, 512, 512, 512, 0, 0}; pg8::StaticOrder S; S.init(MG, NQ, G, bx);
              pg8::EpiBf16<0> E{(bf16_t*)(ws + WS_Q), NQ, 1.0f / 64.0f};
              pg8::gemm_phase<pg8::EpiBf16<0>, pg8::StaticOrder, true, true, 1>(lds + RING_OFF, g, S, E, tid); }
            { pg8::Gemm g{(bf16_t*)(ws + WS_CKVN), (bf16_t*)(ws + WS_WKV), MG, NKV, 256, 256, 256, 0, 0}; pg8::StaticOrder S; S.init(MG, NKV, G, bx);
              pg8::EpiKV E{(unsigned char*)KVB(), (unsigned char*)KVB() + (size_t)MG * 4096, 1.0f / 64.0f};
              pg8::gemm_phase<pg8::EpiKV, pg8::StaticOrder, true, false, 1>(lds + RING_OFF, g, S, E, tid); }
            SEAM(pb + 2);
        }
        if (EN(6) && IN(pb + 3)) {
            PHASE_BEGIN();
            const bf16_t* GB = (const bf16_t*)(ws + WS_G); const f32x2* SUM = (const f32x2*)(ws + WS_SUM);
            const bf16_t* Z = (const bf16_t*)(ws + WS_Z); bf16_t* ALRU = (bf16_t*)(ws + WS_XN);
            const int ncs = L / CHUNK;
            for (int u = vcu; u < NCHUNK * 4; u += G) {
                const int c = u >> 2, cb = u & 3, ch = cb * 1024 + tid * 2, hb = ch >> 8, jj = ch & 255, t0 = c * CHUNK;
                const int c_lo = (c / ncs) * ncs, c_hi = c_lo + ncs;
                const bf16_t* gp = GB + (size_t)hb * 1024 + jj; const bf16_t* yp = Z + ZC_Y + ch; bf16_t* ap = ALRU + ch;
                float hf0 = 0.f, hf1 = 0.f, hr0 = 0.f, hr1 = 0.f;
#pragma unroll 4
                for (int cc = c_lo; cc < c; ++cc) { const f32x4 s = *(const f32x4*)(SUM + ((size_t)(cc * 2 + 0) * D + ch)); hf0 = s.x * hf0 + s.y; hf1 = s.z * hf1 + s.w; }
#pragma unroll 4
                for (int cc = c_hi - 1; cc > c; --cc) { const f32x4 s = *(const f32x4*)(SUM + ((size_t)(cc * 2 + 1) * D + ch)); hr0 = s.x * hr0 + s.y; hr1 = s.z * hr1 + s.w; }
                { unsigned wn[8][2], wc_[8][2];
#define P6F_LOAD(W, g_) _Pragma("unroll") for (int s_ = 0; s_ < 8; ++s_) { const size_t tf_ = (size_t)(t0 + 8 * (g_) + s_); W[s_][0] = *(const unsigned*)(gp + tf_ * NG); W[s_][1] = *(const unsigned*)(gp + tf_ * NG + 256); }
                  P6F_LOAD(wn, 0);
#pragma unroll 1
                  for (int g8 = 0; g8 < CHUNK / 8; ++g8) {
#pragma unroll
                    for (int s_ = 0; s_ < 8; ++s_) { wc_[s_][0] = wn[s_][0]; wc_[s_][1] = wn[s_][1]; }
                    if (g8 + 1 < CHUNK / 8) { P6F_LOAD(wn, g8 + 1); }
#pragma unroll
                    for (int s_ = 0; s_ < 8; ++s_) { const size_t tf = (size_t)(t0 + 8 * g8 + s_);
                        hf0 = __builtin_amdgcn_exp2f(bf_lo(wc_[s_][0])) * hf0 + bf_lo(wc_[s_][1]); hf1 = __builtin_amdgcn_exp2f(bf_hi(wc_[s_][0])) * hf1 + bf_hi(wc_[s_][1]);
                        *(unsigned*)(ap + tf * D) = cvt_pk_bf16(hf0, hf1); }
                  }
#undef P6F_LOAD
                }
                { unsigned wn[4][4], wc_[4][4];
#define P6R_LOAD(W, g_) _Pragma("unroll") for (int s_ = 0; s_ < 4; ++s_) { const size_t tr_ = (size_t)(t0 + CHUNK - 1 - 4 * (g_) - s_); W[s_][0] = *(const unsigned*)(gp + tr_ * NG + 512); W[s_][1] = *(const unsigned*)(gp + tr_ * NG + 768); \
                    W[s_][2] = *(const unsigned*)(yp + tr_ * NZ); W[s_][3] = *(const unsigned*)(ap + tr_ * D); }
                  P6R_LOAD(wn, 0);
#pragma unroll 1
                  for (int g4 = 0; g4 < CHUNK / 4; ++g4) {
#pragma unroll
                    for (int s_ = 0; s_ < 4; ++s_)
#pragma unroll
                        for (int q_ = 0; q_ < 4; ++q_) wc_[s_][q_] = wn[s_][q_];
                    if (g4 + 1 < CHUNK / 4) { P6R_LOAD(wn, g4 + 1); }
#pragma unroll
                    for (int s_ = 0; s_ < 4; ++s_) { const size_t tr = (size_t)(t0 + CHUNK - 1 - 4 * g4 - s_);
                        hr0 = __builtin_amdgcn_exp2f(bf_lo(wc_[s_][0])) * hr0 + bf_lo(wc_[s_][1]); hr1 = __builtin_amdgcn_exp2f(bf_hi(wc_[s_][0])) * hr1 + bf_hi(wc_[s_][1]);
                        *(unsigned*)(ap + tr * D) = cvt_pk_bf16((bf_lo(wc_[s_][3]) + hr0) * bf_lo(wc_[s_][2]), (bf_hi(wc_[s_][3]) + hr1) * bf_hi(wc_[s_][2])); }
                  }
#undef P6R_LOAD
                }
            }
            {
                const unsigned char* V8 = (const unsigned char*)KVB() + (size_t)MG * 4096; unsigned char* VP = (unsigned char*)KVB() + (size_t)MG * 8192;
                for (int idx = vcu * (NWAVES * 64) + tid; idx < (MG / 64) * 2048; idx += G * NWAVES * 64) {
                    const int T = idx >> 11, hi_ = (idx >> 10) & 1, cg = idx & 1023, h = cg >> 5, cl = (cg & 31) * 4;
                    const unsigned char* src = V8 + (size_t)(T * 64 + 4 * hi_) * 4096 + 4 * cg;
                    int wa[16], wb[16];
#pragma unroll
                    for (int r = 0; r < 16; ++r) { const int k_ = (r & 3) + 8 * (r >> 2); wa[r] = *(const int*)(src + (size_t)k_ * 4096); wb[r] = *(const int*)(src + (size_t)(32 + k_) * 4096); }
                    unsigned char* dst = VP + ((size_t)h * (MG / 64) + T) * 8192;
#define V6_COL(i) { f32x16 va_, vb_; \
                        _Pragma("unroll") for (int r = 0; r < 16; ++r) { va_[r] = att::VSC6 * __builtin_amdgcn_cvt_f32_fp8(wa[r], i); vb_[r] = att::VSC6 * __builtin_amdgcn_cvt_f32_fp8(wb[r], i); } \
                        att::v6i w6; asm("v_cvt_scalef32_2xpk16_fp6_f32 %0, %1, %2, 1.0" : "=&v"(w6) : "v"(va_), "v"(vb_)); const int c = cl + i, sw_ = (c >> 2) & 3; \
                        *(u32x4*)(dst + c * 64 + (((2 * hi_) ^ sw_) << 4)) = (u32x4){(unsigned)w6[0], (unsigned)w6[1], (unsigned)w6[2], (unsigned)w6[3]}; \
                        *(u32x4*)(dst + c * 64 + (((2 * hi_ + 1) ^ sw_) << 4)) = (u32x4){(unsigned)w6[4], (unsigned)w6[5], 0u, 0u}; }
                    V6_COL(0) V6_COL(1) V6_COL(2) V6_COL(3)
#undef V6_COL
                }
            }
            SEAM(pb + 3);
        }
        if (EN(7) && IN(pb + 4)) {
            PHASE_BEGIN();
            const bf16_t* QB = (const bf16_t*)(ws + WS_Q); const unsigned char* KPE = (const unsigned char*)(ws + WS_KPE); unsigned char* OB = (unsigned char*)(ws + WS_O);
            const unsigned char* KN8 = (const unsigned char*)KVB(); const unsigned char* VP = (const unsigned char*)KVB() + (size_t)MG * 8192;
            const f32x2* ROPE = (const f32x2*)(ws + WS_ROPE);
            const int nqb = L / 256;
            for (int u = vcu; u < (MG / 256) * 32; u += G) {
                const int sh = u / nqb, qb = u % nqb, sq = sh >> 5, h = sh & 31;
                const size_t row_s = (size_t)sq * L, row_q = row_s + (size_t)qb * 256;
                att::attn_unit(QB + row_q * NQ + h * 192, KN8 + row_s * 4096 + h * 128, VP + ((size_t)h * (MG / 4) + row_s / 4) * 512, KPE + row_s * 64,
                               OB + row_q * D + h * 128, ROPE, qb * 256, L, (LAS char*)(lds + RING_OFF), tid);
            }
            { const bf16_t* AL = (const bf16_t*)(ws + WS_XN); unsigned char* A8 = ws + WS_O + 32 * MiB; float* ROWS = (float*)(ws + WS_SUM);
              for (int m = gw; m < MG; m += NGW) {
                  float v_[64];
#pragma unroll
                  for (int j = 0; j < 8; ++j) { const u32x4 w = *(const u32x4*)(AL + (size_t)m * D + lane * 64 + j * 8);
                      v_[8 * j] = bf_lo(w.x); v_[8 * j + 1] = bf_hi(w.x); v_[8 * j + 2] = bf_lo(w.y); v_[8 * j + 3] = bf_hi(w.y); v_[8 * j + 4] = bf_lo(w.z); v_[8 * j + 5] = bf_hi(w.z); v_[8 * j + 6] = bf_lo(w.w); v_[8 * j + 7] = bf_hi(w.w); }
                  fwht64(v_);
                  float mx = 0.f;
#pragma unroll
                  for (int i = 0; i < 64; ++i) mx = fmaxf(mx, fabsf(v_[i]));
                  mx = wave_max(mx);
                  const float qs = mx > 0.f ? 127.0f / mx : 1.0f;
#pragma unroll
                  for (int j = 0; j < 4; ++j) *(u32x4*)(A8 + (size_t)m * D + lane * 64 + j * 16) =
                      (u32x4){pk4_i8(v_[16 * j], v_[16 * j + 1], v_[16 * j + 2], v_[16 * j + 3], qs), pk4_i8(v_[16 * j + 4], v_[16 * j + 5], v_[16 * j + 6], v_[16 * j + 7], qs),
                              pk4_i8(v_[16 * j + 8], v_[16 * j + 9], v_[16 * j + 10], v_[16 * j + 11], qs), pk4_i8(v_[16 * j + 12], v_[16 * j + 13], v_[16 * j + 14], v_[16 * j + 15], qs)};
                  if (lane == 0) ROWS[m] = 1.0f / qs;
              } }
            SEAM(pb + 4);
        }
        if (EN(9) && IN(pb + 5)) {
            PHASE_BEGIN();
            {
              pg8::Gemm g{(bf16_t*)(ws + WS_O + 32 * MiB), (bf16_t*)(ws + WS_WLP), MG, D, D / 2, D / 2, D / 2, 0, 0}; pg8::StaticOrder S; S.init(MG, D, G, bx);
              pg8::EpiGate<false> E{(bf16_t*)(ws + WS_XC), D, (const bf16_t*)(ws + WS_Z) + ZC_GATE, NZ, nullptr, 0, 1.0f / WSQ_QS, 0.f, (const float*)(ws + WS_SUM)};
              pg8::gemm_phase<pg8::EpiGate<false>, pg8::StaticOrder, true, true, 2>(lds + RING_OFF, g, S, E, tid); }
            pg8::Gemm g{(bf16_t*)(ws + WS_O), (bf16_t*)(ws + WS_WMP), MG, D, D / 2, D / 2, D / 2, 0, 0}; pg8::StaticOrder S; S.init(MG, D, G, bx);
            pg8::EpiGate<true, true> E{(bf16_t*)(ws + WS_XN), D, (const bf16_t*)(ws + WS_Z) + ZC_GATE + D, NZ, (const bf16_t*)(ws + WS_XC), D, 1.0f / (64.0f * att::OSCALE), MERGED_QS, nullptr};
            pg8::gemm_phase<pg8::EpiGate<true, true>, pg8::StaticOrder, true, true, 1>(lds + RING_OFF, g, S, E, tid);
            SEAM(pb + 5);
        }
        if (EN(10) && IN(pb + 6)) {
            PHASE_BEGIN();
            pg8::Gemm g{(bf16_t*)(ws + WS_XN), (bf16_t*)(ws + WS_WO), MG, D, D / 2, D / 2, D / 2, 0, 0}; pg8::StaticOrder S; S.init(MG, D, G, bx);
            pg8::EpiResBf<false> E{XG(), 0, 0, (bf16_t*)OUTG(), 0, 0, D, 1.0f / (MERGED_QS * WSQ_QS)};
            pg8::gemm_phase<pg8::EpiResBf<false>, pg8::StaticOrder, true, true, 2>(lds + RING_OFF, g, S, E, tid);
            if (grp + 1 < NGROUP) {
                const float* xn_src = kp->x_sample + (size_t)grp * MG * D; bf16_t* XN = (bf16_t*)(ws + WS_XN);
                for (int m = gw; m < MG; m += NGW) rms_row_to_bf16(xn_src + (size_t)m * D, TAB + TB_NORM1, nullptr, lane, ws + WS_XN8 + (size_t)m * D);
            }
            SEAM(pb + 6);
        }
    }
    {
        constexpr int pm_ = 1 + NGROUP * 7;
        if (EN(11) && IN(pm_ + 0)) {
            PHASE_BEGIN();
            const bf16_t* hb = (const bf16_t*)kp->out; float* RS2 = (float*)(ws + WS_O);
            for (int m = gw; m < MTOT; m += NGW) rms_row_from_bf16(hb + (size_t)(m >> 13) * ((size_t)MG * D * 2) + (size_t)(m & (MG - 1)) * D, TAB + TB_NORM2, nullptr, ws + WS_N2I8 + (size_t)m * D, nullptr, lane, RS2 + m);
            SEAM(pm_ + 0);
        }
        if (EN(12) && IN(pm_ + 1)) {
            PHASE_BEGIN();
            {
              pg8::Gemm g{(bf16_t*)(ws + WS_N2I8), (bf16_t*)(ws + WS_WUP), MTOT, NUP8, D / 2, D / 2, D / 2, 0, 0}; pg8::StaticOrder S; S.init(MTOT, NUP8, G, bx);
              pg8::EpiBf16<1> E{(bf16_t*)(ws + WS_HALL), DFF, 1.0f / (XN_QS * WSQ_QS)};
              pg8::gemm_phase<pg8::EpiBf16<1>, pg8::StaticOrder, true, true, 2>(lds + RING_OFF, g, S, E, tid); }
            {
              pg8::Gemm g{(const bf16_t*)kp->out, (bf16_t*)(ws + WS_WUPB), MTOT, DFF - NUP8, D, D, D, 0, 0, MG / 256, (size_t)MG * D * 4}; pg8::StaticOrder S; S.init(MTOT, DFF - NUP8, G, bx);
              pg8::EpiBf16<1> E{(bf16_t*)(ws + WS_HALL) + NUP8, DFF, 1.0f, (const float*)(ws + WS_O)};
              pg8::gemm_phase<pg8::EpiBf16<1>, pg8::StaticOrder, true, true>(lds + RING_OFF, g, S, E, tid); }
            SEAM(pm_ + 1);
        }
        if (EN(13) && IN(pm_ + 2)) {
            PHASE_BEGIN();
            pg8::Gemm g{(bf16_t*)(ws + WS_HALL), (bf16_t*)(ws + WS_WDN), MTOT, D, DFF, DFF, DFF, 0, 0}; pg8::StaticOrder S; S.init(MTOT, D, G, bx);
            pg8::EpiResBf<true> E{kp->out, MG, (size_t)MG * D * 2, (bf16_t*)(ws + WS_N2ALL), 0, 0, D, 1.0f};
            pg8::gemm_phase<pg8::EpiResBf<true>, pg8::StaticOrder, true, true>(lds + RING_OFF, g, S, E, tid);
            SEAM(pm_ + 2);
        }
        if (EN(14) && IN(pm_ + 3)) {
            PHASE_BEGIN();
            float* og = kp->out; const bf16_t* X2 = (const bf16_t*)(ws + WS_N2ALL);
            for (int m = gw; m < MTOT; m += NGW) rms_row_from_bf16(X2 + (size_t)m * D, TAB + TB_NORMF, nullptr, nullptr, og + (size_t)m * D, lane);
            SEAM(pm_ + 3);
        }
    }
#undef IN
#undef SEAM
}

constexpr int NPHASES = 1 + NGROUP * 7 + 4;
extern "C" void kernel_launch(void* const* d_in, const int* in_sizes, int n_in, void* d_out, int out_size, void* d_ws, size_t ws_size, hipStream_t stream) {
    static int grid = 0;
    if (grid == 0) {
        if (n_in != 22 || out_size != MTOT * D || ws_size < WS_END) { fprintf(stderr, "kernel_launch: shape/workspace mismatch (n_in %d out %d ws %zu need %zu)\n", n_in, out_size, ws_size, (size_t)WS_END); grid = -1; return; }
        int dev = 0, cus = 0;
        if (hipGetDevice(&dev) != hipSuccess || hipDeviceGetAttribute(&cus, hipDeviceAttributeMultiprocessorCount, dev) != hipSuccess) { grid = -1; return; }
        if (hipFuncSetAttribute((const void*)fwd, hipFuncAttributeMaxDynamicSharedMemorySize, LDS_BYTES) != hipSuccess) { fprintf(stderr, "kernel_launch: hipFuncSetAttribute failed\n"); grid = -1; return; }
        int per_cu = 0;
        if (hipOccupancyMaxActiveBlocksPerMultiprocessor(&per_cu, (const void*)fwd, NWAVES * 64, LDS_BYTES) != hipSuccess || per_cu < 1) fprintf(stderr, "kernel_launch: occupancy query says %d\n", per_cu);
        (void)hipGetLastError();
        grid = cus;
    }
    if (grid < 0) return;
    (void)hipMemsetAsync((char*)d_ws + WS_CTL, 0, CTL_ZERO_BYTES, stream);
    Args a{};
    a.x_prompt = (const float*)d_in[0]; a.x_sample = (const float*)d_in[1]; a.norm1 = (const float*)d_in[2]; a.w_in = (const float*)d_in[3]; a.conv_w = (const float*)d_in[4]; a.conv_b = (const float*)d_in[5];
    a.lru_wa = (const float*)d_in[6]; a.lru_ba = (const float*)d_in[7]; a.lru_wx = (const float*)d_in[8]; a.lru_bx = (const float*)d_in[9]; a.lru_lam = (const float*)d_in[10];
    a.q_norm = (const float*)d_in[11]; a.w_q_up = (const float*)d_in[12]; a.kv_norm = (const float*)d_in[13]; a.w_kv_up = (const float*)d_in[14]; a.w_lru_proj = (const float*)d_in[15];
    a.w_mla_proj = (const float*)d_in[16]; a.w_out = (const float*)d_in[17]; a.norm2 = (const float*)d_in[18]; a.w_up = (const float*)d_in[19]; a.w_down = (const float*)d_in[20]; a.norm_f = (const float*)d_in[21];
    a.out = (float*)d_out; a.ws = (unsigned char*)d_ws;
#if MK_N_LAUNCHES == 0
#ifdef PROBE_PHASE
    { int lo_[16], hi_[16], n = 0, start = 0;
      if (PROBE_PHASE == 0) { lo_[n] = 0; hi_[n++] = 1; lo_[n] = 0; hi_[n++] = 1; start = 1; }
      else if (PROBE_PHASE <= 7) for (int g = 0; g < NGROUP; ++g) { const int k = 1 + g * 7 + (PROBE_PHASE - 1); lo_[n] = start; hi_[n++] = k + PROBE_LEN; lo_[n] = k; hi_[n++] = k + PROBE_LEN; start = k + PROBE_LEN; }
      else { const int k = 1 + NGROUP * 7 + (PROBE_PHASE - 8); lo_[n] = start; hi_[n++] = k + PROBE_LEN; lo_[n] = k; hi_[n++] = k + PROBE_LEN; start = k + PROBE_LEN; }
      if (start < NPHASES) { lo_[n] = start; hi_[n++] = NPHASES; }
      for (int i = 0; i < n; ++i) { a.ph_lo = lo_[i]; a.ph_hi = hi_[i]; a.li = i; hipLaunchKernelGGL(fwd, dim3(grid), dim3(NWAVES * 64), LDS_BYTES, stream, a); } }
#else
    a.ph_lo = 0; a.ph_hi = NPHASES; a.li = 0;
    hipLaunchKernelGGL(fwd, dim3(grid), dim3(NWAVES * 64), LDS_BYTES, stream, a);
#endif
#else
    for (int p = 0; p < NPHASES; ++p) { a.ph_lo = p; a.ph_hi = p + 1; hipLaunchKernelGGL(fwd, dim3(grid), dim3(NWAVES * 64), LDS_BYTES, stream, a); }
#endif
    const hipError_t le = hipPeekAtLastError();
    if (le != hipSuccess) fprintf(stderr, "kernel_launch: launch failed: %s\n", hipGetErrorName(le));
}
```

```cpp
#include <hip/hip_runtime.h>
#include <cstdio>
#include <cstdint>

#ifndef MK_N_LAUNCHES
#define MK_N_LAUNCHES 0
#endif
#ifndef NAIVE_GEMM
#define NAIVE_GEMM 0
#endif

#define GAS __attribute__((address_space(1)))
#define LAS __attribute__((address_space(3)))
typedef unsigned short bf16_t;
typedef short bf16x8 __attribute__((ext_vector_type(8)));
typedef short s16x4 __attribute__((ext_vector_type(4)));
typedef float f32x2 __attribute__((ext_vector_type(2)));
typedef float f32x4 __attribute__((ext_vector_type(4)));
typedef float f32x16 __attribute__((ext_vector_type(16)));
typedef unsigned u32x2 __attribute__((ext_vector_type(2)));
typedef unsigned u32x4 __attribute__((ext_vector_type(4)));

__device__ __forceinline__ unsigned cvt_pk_bf16(float lo, float hi) { unsigned r; asm volatile("v_cvt_pk_bf16_f32 %0, %1, %2" : "=v"(r) : "v"(lo), "v"(hi)); return r; }
__device__ __forceinline__ unsigned pk4_fp8(float a, float b, float c, float d) { unsigned w;
    asm("v_cvt_pk_fp8_f32 %0, %1, %2" : "=v"(w) : "v"(a), "v"(b)); asm("v_cvt_pk_fp8_f32 %0, %1, %2 op_sel:[0,0,1]" : "+v"(w) : "v"(c), "v"(d)); return w; }
constexpr float XN_QS = 127.0f / 4.0f;
constexpr float WIN_QS = 127.0f * 64.0f / 4.0f;
constexpr float WSQ_QS = 127.0f * 64.0f / 4.0f;
constexpr float MERGED_QS = 127.0f / 1.2f;
__device__ __forceinline__ unsigned pk4_i8(float a, float b, float c, float d, float qs) {
    const int q0 = (int)__builtin_rintf(fminf(fmaxf(a * qs, -127.f), 127.f)), q1 = (int)__builtin_rintf(fminf(fmaxf(b * qs, -127.f), 127.f));
    const int q2 = (int)__builtin_rintf(fminf(fmaxf(c * qs, -127.f), 127.f)), q3 = (int)__builtin_rintf(fminf(fmaxf(d * qs, -127.f), 127.f));
    return ((unsigned)q0 & 0xffu) | (((unsigned)q1 & 0xffu) << 8) | (((unsigned)q2 & 0xffu) << 16) | ((unsigned)q3 << 24);
}
__device__ __forceinline__ float bf_lo(unsigned w) { return __uint_as_float(w << 16); }
__device__ __forceinline__ float bf_hi(unsigned w) { return __uint_as_float(w & 0xffff0000u); }
__device__ __forceinline__ float fast_sigmoid(float v) { return __builtin_amdgcn_rcpf(1.0f + __builtin_amdgcn_exp2f(-1.4426950408889634f * v)); }
__device__ __forceinline__ float gelu_tanh(float v) {
    const float y = 1.5957691216057308f * (v + 0.044715f * v * v * v);
    return v * fast_sigmoid(y);
}

constexpr int D = 4096, MG = 8192, NGROUP = 3, MTOT = 24576;
constexpr int SEQ_P = 8192, SEQ_S = 2048;
constexpr int NZ = 18176, NZ_BF = 8192, NZ_F8 = 9984;
constexpr int ZC_Y = 4096, ZC_CQ = 8192, ZC_CKV = 9216, ZC_KR = 9728, ZC_GATE = 9984;
constexpr int IN_COLS = 17984, SRC_GATE = 9792;
constexpr int NQ = 6144, NKV = 8192, DFF = 16384, NG = 16384;
constexpr float EPS = 1e-6f;
constexpr int CHUNK = 128, NCHUNK = MG / CHUNK;

constexpr size_t MiB = 1u << 20;
constexpr size_t WS_CTL = 0, CTL_ZERO_BYTES = 1 * MiB;
constexpr size_t WS_ROPE = 1 * MiB;
constexpr size_t WS_TAB = 3 * MiB;
constexpr int NUP8 = 8192;
constexpr size_t WS_WUP = 4 * MiB;
constexpr size_t WS_WUPB = WS_WUP + (size_t)NUP8 * 4096;
constexpr size_t WS_WDN = WS_WUP + 128 * MiB;
constexpr size_t WS_WIN = WS_WDN + 128 * MiB;
constexpr size_t WS_XN8 = WS_WIN + 78 * MiB;
constexpr size_t WS_WG = WS_XN8 + 64 * MiB;
constexpr size_t WS_WQ = WS_WG + 8 * MiB;
constexpr size_t WS_WKV = WS_WQ + 12 * MiB;
constexpr size_t WS_WLP = WS_WKV + 8 * MiB;
constexpr size_t WS_WMP = WS_WLP + 32 * MiB;
constexpr size_t WS_WO = WS_WMP + 32 * MiB;
constexpr size_t WS_XN = WS_WO + 32 * MiB;
constexpr size_t WS_Z = WS_XN + 64 * MiB;
constexpr size_t WS_XC = WS_Z + 284 * MiB;
constexpr size_t WS_CQN = WS_XC + 64 * MiB;
constexpr size_t WS_CKVN = WS_CQN + 16 * MiB;
constexpr size_t WS_KPE = WS_CKVN + 8 * MiB;
constexpr size_t WS_SUM = WS_KPE + 1 * MiB;
constexpr size_t WS_G = WS_SUM + 4 * MiB;
constexpr size_t WS_Q = WS_G + 256 * MiB;
constexpr size_t WS_O = WS_Q + 96 * MiB;
constexpr size_t WS_END = WS_O + 64 * MiB;
constexpr size_t WS_N2ALL = WS_WIN;
constexpr size_t WS_HALL = WS_N2ALL + 192 * MiB;
constexpr size_t WS_N2I8 = WS_HALL + 768 * MiB;
static_assert(WS_N2I8 + 96 * MiB <= WS_END, "MLP-stage overlay");

constexpr int CW_TMO = 0, CW_CODE = 1, CW_DIAG = 2, CW_BAR = 4096;

namespace pg8 {
constexpr int BM = 256, BK = 64, HALF = 128, HTB = HALF * BK * 2, STAGE_BYTES = 8 * HTB, NXCD = 8, WGM = 8;
__host__ __device__ __forceinline__ int lds_byte(int r, int c) { const int st = (r >> 4) * 2 + (c >> 5), rr = r & 15, cc = c & 31, ob = rr * 64 + cc * 2; return st * 1024 + (ob ^ (((ob >> 9) & 1) << 5)); }
__host__ __device__ __forceinline__ void stage_rc(int b, int& R, int& C) { const int st = b / 1024, sb = b % 1024, swz = sb ^ (((sb >> 9) & 1) << 5); R = (st >> 1) * 16 + swz / 64; C = (st & 1) * 32 + (swz % 64) / 2; }
__host__ __device__ __forceinline__ int perm32(int rho) { const int n = rho >> 4, i = rho & 15; return 8 * (i >> 2) + 4 * n + (i & 3); }

struct Unit { int pm, pn; };
struct Gemm { const bf16_t* A; const bf16_t* Bt; int M, N, K, lda, ldb, a_pn_shift, a_pn_stride; };

struct StaticOrder {
    int nM, nN, nwg, G, c, shared16;
    __host__ __device__ void init(int M, int N, int G_, int c_, int shared16_ = 0) { nM = M / BM; nN = N / BM; nwg = nM * nN; G = G_; c = c_; shared16 = shared16_ && G_ == 256 && nN == 16 && nM % 16 == 0; }
    __host__ __device__ bool next(int i, Unit& u) const {
        const long L = (long)i * G + c; if (L >= nwg) return false;
        if (shared16) {
            const int x = c & 7, j = c >> 3;
            u.pm = 16 * i + 8 * (x >> 2) + (j & 7); u.pn = 4 * (x & 3) + (j >> 3); return true; }
        int wgid = (int)L; { const int q = nwg / NXCD, r = nwg % NXCD, xcd = wgid % NXCD, off = wgid / NXCD; wgid = (xcd < r ? xcd * (q + 1) : r * (q + 1) + (xcd - r) * q) + off; }
        const int nig = WGM * nN, gid = wgid / nig, fm = gid * WGM, gsz = (nM - fm) < WGM ? (nM - fm) : WGM;
        u.pm = fm + ((wgid % nig) % gsz); u.pn = (wgid % nig) / gsz; return true;
    }
};

__device__ __forceinline__ u32x4 pack8(const f32x4 v0, const f32x4 v1) { u32x4 w; w.x = cvt_pk_bf16(v0[0], v0[1]); w.y = cvt_pk_bf16(v0[2], v0[3]); w.z = cvt_pk_bf16(v1[0], v1[1]); w.w = cvt_pk_bf16(v1[2], v1[3]); return w; }
__device__ __forceinline__ void unpack8(const u32x4 w, f32x4& v0, f32x4& v1) { v0 = (f32x4){bf_lo(w.x), bf_hi(w.x), bf_lo(w.y), bf_hi(w.y)}; v1 = (f32x4){bf_lo(w.z), bf_hi(w.z), bf_lo(w.w), bf_hi(w.w)}; }

struct EpiZ {
    static constexpr bool PERM = true;
    bf16_t* O; int ldc; int pn_off; float scale;
    __device__ __forceinline__ void operator()(const f32x4 (&acc)[2][2][4][2], const Unit& u, int wr, int wc, int fr, int fq) const {
        const int pn = u.pn + pn_off;
        const int row0 = u.pm * BM + wr * 64 + fr, col0 = pn * BM + wc * 32 + 8 * fq;
        const int act = (pn >= 16 && pn < 32) ? 1 : (pn >= 39 ? 2 : 0);
#pragma unroll
        for (int ai = 0; ai < 2; ++ai)
#pragma unroll
            for (int m = 0; m < 4; ++m) { bf16_t* rowp = O + (size_t)(row0 + ai * HALF + m * 16) * ldc + col0;
#pragma unroll
                for (int bj = 0; bj < 2; ++bj) { f32x4 v0 = acc[ai][bj][m][0] * scale, v1 = acc[ai][bj][m][1] * scale;
                    if (act == 1) {
#pragma unroll
                        for (int j = 0; j < 4; ++j) { v0[j] = gelu_tanh(v0[j]); v1[j] = gelu_tanh(v1[j]); } }
                    else if (act == 2) {
#pragma unroll
                        for (int j = 0; j < 4; ++j) { v0[j] = fast_sigmoid(v0[j]); v1[j] = fast_sigmoid(v1[j]); } }
                    *(u32x4*)(rowp + bj * HALF) = pack8(v0, v1); } }
    }
};
template <int ACT> struct EpiBf16 {
    static constexpr bool PERM = true;
    bf16_t* O; int ldc; float scale;
    __device__ __forceinline__ void operator()(const f32x4 (&acc)[2][2][4][2], const Unit& u, int wr, int wc, int fr, int fq) const {
        const int row0 = u.pm * BM + wr * 64 + fr, col0 = u.pn * BM + wc * 32 + 8 * fq;
#pragma unroll
        for (int ai = 0; ai < 2; ++ai)
#pragma unroll
            for (int m = 0; m < 4; ++m) { bf16_t* rowp = O + (size_t)(row0 + ai * HALF + m * 16) * ldc + col0;
#pragma unroll
                for (int bj = 0; bj < 2; ++bj) { f32x4 v0 = acc[ai][bj][m][0] * scale, v1 = acc[ai][bj][m][1] * scale;
                    if (ACT == 1) {
#pragma unroll
                        for (int j = 0; j < 4; ++j) { const float a = fmaxf(v0[j], 0.f), b = fmaxf(v1[j], 0.f); v0[j] = a * a; v1[j] = b * b; } }
                    *(u32x4*)(rowp + bj * HALF) = pack8(v0, v1); } }
    }
};
struct EpiLru {
    static constexpr bool PERM = true;
    bf16_t* G; const bf16_t* XC; const float* gbias; const float* sp8l2;
    f32x2* SUM; LAS f32x2* xch;
    template <int MB> static __device__ __forceinline__ void stage(float& A, float& H, bool mine_first) {
        const float pA = __builtin_bit_cast(float, __builtin_amdgcn_ds_swizzle(__builtin_bit_cast(int, A), (MB << 10) | 0x1f));
        const float pH = __builtin_bit_cast(float, __builtin_amdgcn_ds_swizzle(__builtin_bit_cast(int, H), (MB << 10) | 0x1f));
        H = mine_first ? __builtin_fmaf(pA, H, pH) : __builtin_fmaf(A, pH, H); A *= pA;
    }
    __device__ __forceinline__ void operator()(const f32x4 (&acc)[2][2][4][2], const Unit& u, int wr, int wc, int fr, int fq) const {
        const int hb = u.pn >> 2, dir = (u.pn >> 1) & 1, half = u.pn & 1, j0 = half * 128 + wc * 32 + 8 * fq, row0 = u.pm * BM + wr * 64 + 4 * fr;
        const float* bp = gbias + hb * 1024 + (2 * dir) * 256 + j0;
        const f32x4 br0 = *(const f32x4*)(bp), br1 = *(const f32x4*)(bp + 4), bi0 = *(const f32x4*)(bp + 256), bi1 = *(const f32x4*)(bp + 260);
        const f32x4 sp0 = *(const f32x4*)(sp8l2 + dir * 4096 + hb * 256 + j0), sp1 = *(const f32x4*)(sp8l2 + dir * 4096 + hb * 256 + j0 + 4);
        const bool fwd = dir == 0;
        const bool f1 = ((fr & 1) == 0) == fwd, f2 = ((fr & 2) == 0) == fwd, f4 = ((fr & 4) == 0) == fwd, f8 = ((fr & 8) == 0) == fwd;
        float Ar[2][8], Hr[2][8];
#pragma unroll
        for (int ai = 0; ai < 2; ++ai) {
#pragma unroll
            for (int m = 0; m < 4; ++m) { const size_t row = (size_t)(row0 + ai * HALF + m);
                f32x4 x0, x1; unpack8(*(const u32x4*)(XC + row * 4096 + hb * 256 + j0), x0, x1);
                f32x4 l0, l1, u0, u1; float As[8], Hs[8];
#pragma unroll
                for (int e = 0; e < 4; ++e) {
                    { const float r = fast_sigmoid(acc[ai][0][m][0][e] + br0[e]), i = fast_sigmoid(acc[ai][1][m][0][e] + bi0[e]); const float la = -r * sp0[e], a = __builtin_amdgcn_exp2f(la);
                      l0[e] = la; u0[e] = __builtin_amdgcn_sqrtf(__builtin_fmaf(-a, a, 1.0f)) * i * x0[e]; As[e] = a; Hs[e] = u0[e]; }
                    { const float r = fast_sigmoid(acc[ai][0][m][1][e] + br1[e]), i = fast_sigmoid(acc[ai][1][m][1][e] + bi1[e]); const float la = -r * sp1[e], a = __builtin_amdgcn_exp2f(la);
                      l1[e] = la; u1[e] = __builtin_amdgcn_sqrtf(__builtin_fmaf(-a, a, 1.0f)) * i * x1[e]; As[4 + e] = a; Hs[4 + e] = u1[e]; } }
                bf16_t* gp = G + row * 16384 + hb * 1024 + (2 * dir) * 256 + j0;
                *(u32x4*)(gp) = pack8(l0, l1); *(u32x4*)(gp + 256) = pack8(u0, u1);
#pragma unroll
                for (int e = 0; e < 8; ++e) {
                    if (m == 0) { Ar[ai][e] = As[e]; Hr[ai][e] = Hs[e]; }
                    else if (fwd) { Hr[ai][e] = __builtin_fmaf(As[e], Hr[ai][e], Hs[e]); Ar[ai][e] *= As[e]; }
                    else { Hr[ai][e] = __builtin_fmaf(Ar[ai][e], Hs[e], Hr[ai][e]); Ar[ai][e] *= As[e]; } } }
#pragma unroll
            for (int e = 0; e < 8; ++e) { stage<1>(Ar[ai][e], Hr[ai][e], f1); stage<2>(Ar[ai][e], Hr[ai][e], f2); stage<4>(Ar[ai][e], Hr[ai][e], f4); stage<8>(Ar[ai][e], Hr[ai][e], f8); }
        }
        if (fr == 0) {
#pragma unroll
            for (int ai = 0; ai < 2; ++ai)
#pragma unroll
                for (int e = 0; e < 8; ++e) xch[(wr * 2 + ai) * 128 + wc * 32 + 8 * fq + e] = (f32x2){Ar[ai][e], Hr[ai][e]}; }
        asm volatile("s_waitcnt lgkmcnt(0)" ::: "memory"); __builtin_amdgcn_s_barrier(); asm volatile("" ::: "memory");
        if (wr == 0 && fr == 0) {
#pragma unroll
            for (int ai = 0; ai < 2; ++ai)
#pragma unroll
                for (int e = 0; e < 8; ++e) { const f32x2 o_ = xch[(2 + ai) * 128 + wc * 32 + 8 * fq + e];
                    const float A0 = Ar[ai][e], H0 = Hr[ai][e];
                    const float Hh = fwd ? __builtin_fmaf(o_.x, H0, o_.y) : __builtin_fmaf(A0, o_.y, H0);
                    SUM[(size_t)((2 * u.pm + ai) * 2 + dir) * 4096 + hb * 256 + j0 + e] = (f32x2){A0 * o_.x, Hh}; } }
    }
};
struct EpiKV {
    static constexpr bool PERM = true;
    unsigned char* K8; unsigned char* V; float scale;
    __device__ __forceinline__ void operator()(const f32x4 (&acc)[2][2][4][2], const Unit& u, int wr, int wc, int fr, int fq) const {
        const int row0 = u.pm * BM + wr * 64 + fr, col = u.pn * 128 + wc * 32 + 8 * fq;
#pragma unroll
        for (int ai = 0; ai < 2; ++ai)
#pragma unroll
            for (int m = 0; m < 4; ++m) { const size_t row = (size_t)(row0 + ai * HALF + m * 16);
                { const f32x4 v0 = acc[ai][0][m][0] * scale, v1 = acc[ai][0][m][1] * scale;
                  *(u32x2*)(K8 + row * 4096 + col) = (u32x2){pk4_fp8(v0[0], v0[1], v0[2], v0[3]), pk4_fp8(v1[0], v1[1], v1[2], v1[3])}; }
                { const f32x4 v0 = acc[ai][1][m][0] * scale, v1 = acc[ai][1][m][1] * scale;
                  *(u32x2*)(V + row * 4096 + col) = (u32x2){pk4_fp8(v0[0], v0[1], v0[2], v0[3]), pk4_fp8(v1[0], v1[1], v1[2], v1[3])}; } }
    }
};
template <bool ADD, bool OUT_I8 = false> struct EpiGate {
    static constexpr bool PERM = true;
    bf16_t* O; int ldc; const bf16_t* gate; int ldg; const bf16_t* add; int ldadd; float scale; float qs; const float* rowscale;
    __device__ __forceinline__ void operator()(const f32x4 (&acc)[2][2][4][2], const Unit& u, int wr, int wc, int fr, int fq) const {
        const int row0 = u.pm * BM + wr * 64 + fr, col0 = u.pn * BM + wc * 32 + 8 * fq;
#pragma unroll
        for (int ai = 0; ai < 2; ++ai)
#pragma unroll
            for (int m = 0; m < 4; ++m) { const size_t row = (size_t)(row0 + ai * HALF + m * 16); const float sc_ = rowscale ? scale * rowscale[row] : scale;
#pragma unroll
                for (int bj = 0; bj < 2; ++bj) { const int col = col0 + bj * HALF;
                    f32x4 g0, g1; unpack8(*(const u32x4*)(gate + row * ldg + col), g0, g1);
                    f32x4 v0 = acc[ai][bj][m][0] * (g0 * sc_), v1 = acc[ai][bj][m][1] * (g1 * sc_);
                    if (ADD) { f32x4 a0, a1; unpack8(*(const u32x4*)(add + row * ldadd + col), a0, a1); v0 += a0; v1 += a1; }
                    if constexpr (OUT_I8) {
                        float h_[8] = {v0[0], v0[1], v0[2], v0[3], v1[0], v1[1], v1[2], v1[3]};
#pragma unroll
                        for (int s_ = 1; s_ < 8; s_ <<= 1)
#pragma unroll
                            for (int i = 0; i < 8; ++i) if ((i & s_) == 0) { const float a = h_[i], b = h_[i | s_]; h_[i] = a + b; h_[i | s_] = a - b; }
#pragma unroll
                        for (int i = 0; i < 8; ++i) { const float p = __builtin_bit_cast(float, __builtin_amdgcn_ds_swizzle(__builtin_bit_cast(int, h_[i]), (16 << 10) | 0x1f)); h_[i] = (fq & 1) ? p - h_[i] : h_[i] + p; }
#pragma unroll
                        for (int i = 0; i < 8; ++i) { const auto rr = __builtin_amdgcn_permlane32_swap(__float_as_uint(h_[i]), __float_as_uint(h_[i]), false, false);
                            const float p = __uint_as_float((fq & 2) ? rr[0] : rr[1]); h_[i] = (fq & 2) ? p - h_[i] : h_[i] + p; }
                        const float q_ = qs * 0.17677669529663689f;
                        *(u32x2*)((unsigned char*)O + row * ldc + col) = (u32x2){pk4_i8(h_[0], h_[1], h_[2], h_[3], q_), pk4_i8(h_[4], h_[5], h_[6], h_[7], q_)}; }
                    else *(u32x4*)(O + row * ldc + col) = pack8(v0, v1); } }
    }
};
template <bool BASE_BF> struct EpiResBf {
    static constexpr bool PERM = true;
    const void* base; int base_grp_rows; size_t base_grp_stride; bf16_t* out; int out_grp_rows; size_t out_grp_stride; int ldc; float scale;
    __device__ __forceinline__ void operator()(const f32x4 (&acc)[2][2][4][2], const Unit& u, int wr, int wc, int fr, int fq) const {
        const int row0 = u.pm * BM + wr * 64 + fr, col0 = u.pn * BM + wc * 32 + 8 * fq;
#pragma unroll
        for (int ai = 0; ai < 2; ++ai)
#pragma unroll
            for (int m = 0; m < 4; ++m) { const int row = row0 + ai * HALF + m * 16;
                const size_t bo = base_grp_rows ? (size_t)(row / base_grp_rows) * base_grp_stride + (size_t)(row % base_grp_rows) * ldc : (size_t)row * ldc;
                const size_t oo = out_grp_rows ? (size_t)(row / out_grp_rows) * out_grp_stride + (size_t)(row % out_grp_rows) * ldc : (size_t)row * ldc;
#pragma unroll
                for (int bj = 0; bj < 2; ++bj) { const int col = col0 + bj * HALF;
                    f32x4 b0, b1;
                    if constexpr (BASE_BF) unpack8(*(const u32x4*)((const bf16_t*)base + bo + col), b0, b1);
                    else { b0 = *(const f32x4*)((const float*)base + bo + col); b1 = *(const f32x4*)((const float*)base + bo + col + 4); }
                    *(u32x4*)(out + oo + col) = pack8(b0 + acc[ai][bj][m][0] * scale, b1 + acc[ai][bj][m][1] * scale); } }
    }
};
struct EpiResF32 {
    static constexpr bool PERM = false;
    const float* base; float* out; int ldc; float scale;
    __device__ __forceinline__ void operator()(const f32x4 (&acc)[2][2][4][2], const Unit& u, int wr, int wc, int fr, int fq) const {
        const int row0 = u.pm * BM + wr * 64 + fr, col0 = u.pn * BM + wc * 32 + 4 * fq;
#pragma unroll
        for (int ai = 0; ai < 2; ++ai)
#pragma unroll
            for (int m = 0; m < 4; ++m) { const size_t off = (size_t)(row0 + ai * HALF + m * 16) * ldc + col0;
#pragma unroll
                for (int bj = 0; bj < 2; ++bj)
#pragma unroll
                    for (int n = 0; n < 2; ++n) { const f32x4 bs = *(const f32x4*)(base + off + bj * HALF + n * 16); *(f32x4*)(out + off + bj * HALF + n * 16) = bs + acc[ai][bj][m][n] * scale; } }
    }
};

#if NAIVE_GEMM
template <class Epi, class Sched, bool ALIGN_EPI = false, bool SP2 = false>
__device__ __forceinline__ void gemm_phase(LAS unsigned char* lds, const Gemm g, const Sched& S, const Epi& E, int tid_in) {
    const int tid = tid_in, wid = __builtin_amdgcn_readfirstlane(tid >> 6), lane = tid & 63, wr = wid >> 2, wc = wid & 3, fr = lane & 15, fq = lane >> 4;
    Unit cur;
    for (int ui = 0; S.next(ui, cur); ++ui) {
        f32x4 acc[2][2][4][2];
#pragma unroll
        for (int a = 0; a < 2; ++a)
#pragma unroll
            for (int b = 0; b < 2; ++b)
#pragma unroll
                for (int m = 0; m < 4; ++m)
#pragma unroll
                    for (int n = 0; n < 2; ++n) acc[a][b][m][n] = (f32x4){0.f, 0.f, 0.f, 0.f};
        const bf16_t* Ab = g.A + (size_t)cur.pm * BM * g.lda + (size_t)(cur.pn >> g.a_pn_shift) * g.a_pn_stride;
        const bf16_t* Bb = g.Bt + (size_t)cur.pn * BM * g.ldb;
        for (int kk = 0; kk < g.K; kk += 32) {
#pragma unroll
            for (int ai = 0; ai < 2; ++ai)
#pragma unroll
                for (int bj = 0; bj < 2; ++bj)
#pragma unroll
                    for (int m = 0; m < 4; ++m)
#pragma unroll
                        for (int n = 0; n < 2; ++n) {
                            const int ar = ai * HALF + wr * 64 + m * 16 + fr;
                            const int slot = n * 16 + fr, bc = bj * HALF + wc * 32 + (Epi::PERM ? perm32(slot) : slot);
                            const bf16x8 af = *(const bf16x8*)(Ab + (size_t)ar * g.lda + kk + fq * 8);
                            const bf16x8 bf = *(const bf16x8*)(Bb + (size_t)bc * g.ldb + kk + fq * 8);
                            acc[ai][bj][m][n] = __builtin_amdgcn_mfma_f32_16x16x32_bf16(bf, af, acc[ai][bj][m][n], 0, 0, 0);
                        }
        }
        E(acc, cur, wr, wc, fr, fq);
    }
}
#else
template <class Epi, class Sched, bool ALIGN_EPI = false, bool SP2 = false, int LOWP = 0, bool APERM = false>
__device__ __forceinline__ void gemm_phase(LAS unsigned char* lds, const Gemm g, const Sched& S, const Epi& E, int tid_in) {
    constexpr bool F8 = (LOWP == 1), I8 = (LOWP == 2);
    int tid = tid_in; int lda = g.lda, ldb = g.ldb;
    asm volatile("" : "+v"(tid), "+s"(lda), "+s"(ldb));
    const int wid = __builtin_amdgcn_readfirstlane(tid >> 6), lane = tid & 63, wr = wid >> 2, wc = wid & 3, fr = lane & 15, fq = lane >> 4;
    const int K = g.K, nt = K / BK;
    unsigned voffA[2], voffB[2];
#pragma unroll
    for (int i = 0; i < 2; ++i) { int R, C; stage_rc(tid * 16 + i * 8192, R, C); const int Rb = Epi::PERM ? ((R & ~31) + perm32(R & 31)) : R;
        const int Ra = APERM ? ((R & ~63) + 4 * (R & 15) + ((R >> 4) & 3)) : R;
        voffA[i] = (unsigned)(Ra * lda + C) * 2u; voffB[i] = (unsigned)(Rb * ldb + C) * 2u; }
    const size_t kstep = (size_t)(BK * 2);
    const size_t hstepA = (size_t)HALF * lda * 2, hstepB = (size_t)HALF * ldb * 2;
    const size_t tstepA = 2 * hstepA, tstepB = 2 * hstepB;
    const unsigned ldsw = (unsigned)wid * 1024u;
    const int aoff = lds_byte(wr * 64 + fr, fq * 8), boff = lds_byte(wc * 32 + fr, fq * 8);
#define PG8_SA(b, h) (((b) * 2 + (h)) * HTB)
#define PG8_SB(b, h) ((4 + (b) * 2 + (h)) * HTB)
#define PG8_STAGE(bufoff, gbase, voff) do { _Pragma("unroll") for (int _i = 0; _i < 2; ++_i) \
        __builtin_amdgcn_global_load_lds((const unsigned*)((const char*)(gbase) + (voff)[_i]), (LAS unsigned*)(lds + (bufoff) + ldsw + _i * 8192), 16, 0, 0); } while (0)
#define PG8_LDA(dst, b, h) do { _Pragma("unroll") for (int m = 0; m < 4; ++m) _Pragma("unroll") for (int k = 0; k < 2; ++k) dst[m][k] = *(const LAS bf16x8*)(lds + PG8_SA(b, h) + aoff + m * 2048 + k * 1024); } while (0)
#define PG8_LDB(dst, b, h) do { _Pragma("unroll") for (int n = 0; n < 2; ++n) _Pragma("unroll") for (int k = 0; k < 2; ++k) dst[n][k] = *(const LAS bf16x8*)(lds + PG8_SB(b, h) + boff + n * 2048 + k * 1024); } while (0)
#define PG8_MMA(ai, bj, At, Bt) do { __builtin_amdgcn_s_setprio(1); _Pragma("unroll") for (int m = 0; m < 4; ++m) _Pragma("unroll") for (int n = 0; n < 2; ++n) { \
        if constexpr (F8) { typedef int v8i_ __attribute__((ext_vector_type(8))); typedef int v4i_ __attribute__((ext_vector_type(4))); \
            const v4i_ b0_ = __builtin_bit_cast(v4i_, Bt[n][0]), b1_ = __builtin_bit_cast(v4i_, Bt[n][1]), a0_ = __builtin_bit_cast(v4i_, At[m][0]), a1_ = __builtin_bit_cast(v4i_, At[m][1]); \
            const v8i_ bb_ = __builtin_shufflevector(b0_, b1_, 0, 1, 2, 3, 4, 5, 6, 7), aa_ = __builtin_shufflevector(a0_, a1_, 0, 1, 2, 3, 4, 5, 6, 7); \
            asm volatile("v_mfma_f32_16x16x128_f8f6f4 %0, %1, %2, %0" : "+v"(acc[ai][bj][m][n]) : "v"(bb_), "v"(aa_)); (void)f8scale_; } \
        else if constexpr (I8) { typedef int v4i_ __attribute__((ext_vector_type(4))); v4i_ c_ = __builtin_bit_cast(v4i_, acc[ai][bj][m][n]); \
            _Pragma("unroll") for (int k = 0; k < 2; ++k) c_ = __builtin_amdgcn_mfma_i32_16x16x64_i8(__builtin_bit_cast(v4i_, Bt[n][k]), __builtin_bit_cast(v4i_, At[m][k]), c_, 0, 0, 0); \
            acc[ai][bj][m][n] = __builtin_bit_cast(f32x4, c_); } \
        else { _Pragma("unroll") for (int k = 0; k < 2; ++k) acc[ai][bj][m][n] = __builtin_amdgcn_mfma_f32_16x16x32_bf16(Bt[n][k], At[m][k], acc[ai][bj][m][n], 0, 0, 0); } } \
        __builtin_amdgcn_s_setprio(0); } while (0)
#define PG8_WAIT_V(n) asm volatile("s_waitcnt vmcnt(" #n ")" ::: "memory")
#define PG8_WAIT_L(n) asm volatile("s_waitcnt lgkmcnt(" #n ")" ::: "memory")
#define PG8_BAR __builtin_amdgcn_s_barrier()
#define PG8_SCHED __builtin_amdgcn_sched_barrier(0)
#define PG8_ABASE(u) ((const char*)g.A + (size_t)(u).pm * tstepA + (size_t)((u).pn >> g.a_pn_shift) * (size_t)g.a_pn_stride * 2)
    Unit cur, nxt; int ui = 0;
    if (!S.next(0, cur)) return;
    int f8scale_ = 0x7f7f7f7f; asm volatile("" : "+v"(f8scale_));
    f32x4 acc[2][2][4][2];
#pragma unroll
    for (int a = 0; a < 2; ++a)
#pragma unroll
        for (int b = 0; b < 2; ++b)
#pragma unroll
            for (int m = 0; m < 4; ++m)
#pragma unroll
                for (int n = 0; n < 2; ++n) acc[a][b][m][n] = (f32x4){0.f, 0.f, 0.f, 0.f};
    bf16x8 At[4][2], B0[2][2], B1[2][2];
    const char* cA = PG8_ABASE(cur); const char* cB = (const char*)g.Bt + (size_t)cur.pn * tstepB;
    if constexpr (SP2) {
        PG8_STAGE(PG8_SB(0, 0), cB, voffB); PG8_STAGE(PG8_SB(0, 1), cB + hstepB, voffB); PG8_STAGE(PG8_SA(0, 0), cA, voffA); PG8_STAGE(PG8_SA(0, 1), cA + hstepA, voffA);
        if (wr == 1) PG8_BAR;
        PG8_WAIT_V(2); PG8_BAR;
        PG8_STAGE(PG8_SB(1, 0), cB + kstep, voffB); PG8_STAGE(PG8_SA(1, 0), cA + kstep, voffA); PG8_STAGE(PG8_SB(1, 1), cB + hstepB + kstep, voffB);
        PG8_WAIT_V(6); PG8_BAR;
    } else {
        PG8_STAGE(PG8_SB(0, 0), cB, voffB); PG8_STAGE(PG8_SA(0, 0), cA, voffA); PG8_STAGE(PG8_SB(0, 1), cB + hstepB, voffB); PG8_STAGE(PG8_SA(0, 1), cA + hstepA, voffA);
        if (wr == 1) PG8_BAR;
        PG8_WAIT_V(4); PG8_BAR;
        PG8_STAGE(PG8_SB(1, 0), cB + kstep, voffB); PG8_STAGE(PG8_SA(1, 0), cA + kstep, voffA); PG8_STAGE(PG8_SB(1, 1), cB + hstepB + kstep, voffB);
        PG8_WAIT_V(6); PG8_BAR;
    }
    for (;;) {
        const bool has_next = S.next(ui + 1, nxt);
        const char* nA = has_next ? PG8_ABASE(nxt) : cA; const char* nB = has_next ? (const char*)g.Bt + (size_t)nxt.pn * tstepB : cB;
#pragma unroll 1
        for (int t = 0; t < nt; t += 2) {
            const bool last = (t == nt - 2);
            const char* a1 = cA + (size_t)(t + 1) * kstep;
            const char* a2 = last ? nA : cA + (size_t)(t + 2) * kstep; const char* b2 = last ? nB : cB + (size_t)(t + 2) * kstep;
            const char* a3 = a2 + kstep; const char* b3 = b2 + kstep;
            if constexpr (SP2) {
            PG8_LDB(B0, 0, 0); PG8_LDB(B1, 0, 1); PG8_SCHED; PG8_LDA(At, 0, 0); PG8_STAGE(PG8_SA(1, 1), a1 + hstepA, voffA);
            PG8_WAIT_V(8); PG8_WAIT_L(0); PG8_BAR; PG8_MMA(0, 0, At, B0); PG8_MMA(0, 1, At, B1); PG8_BAR; PG8_SCHED;
            PG8_LDA(At, 0, 1); PG8_STAGE(PG8_SB(0, 0), b2, voffB); PG8_STAGE(PG8_SB(0, 1), b2 + hstepB, voffB); PG8_STAGE(PG8_SA(0, 0), a2, voffA);
            PG8_WAIT_V(8); PG8_WAIT_L(0); PG8_BAR; PG8_MMA(1, 0, At, B0); PG8_MMA(1, 1, At, B1); PG8_BAR; PG8_SCHED;
            PG8_LDB(B0, 1, 0); PG8_LDB(B1, 1, 1); PG8_SCHED; PG8_LDA(At, 1, 0); PG8_STAGE(PG8_SA(0, 1), a2 + hstepA, voffA);
            PG8_WAIT_V(8); PG8_WAIT_L(0); PG8_BAR; PG8_MMA(0, 0, At, B0); PG8_MMA(0, 1, At, B1); PG8_BAR; PG8_SCHED;
            PG8_LDA(At, 1, 1); PG8_STAGE(PG8_SB(1, 0), b3, voffB); PG8_STAGE(PG8_SB(1, 1), b3 + hstepB, voffB); PG8_STAGE(PG8_SA(1, 0), a3, voffA);
            PG8_WAIT_V(8); PG8_WAIT_L(0); PG8_BAR; PG8_MMA(1, 0, At, B0); PG8_MMA(1, 1, At, B1); PG8_BAR; PG8_SCHED;
            } else {
            PG8_LDB(B0, 0, 0); PG8_SCHED; PG8_LDA(At, 0, 0); PG8_STAGE(PG8_SA(1, 1), a1 + hstepA, voffA);
            PG8_WAIT_L(8); PG8_BAR; PG8_WAIT_L(0); PG8_MMA(0, 0, At, B0); PG8_BAR; PG8_SCHED;
            PG8_LDB(B1, 0, 1); PG8_STAGE(PG8_SB(0, 0), b2, voffB);
            PG8_BAR; PG8_WAIT_L(0); PG8_MMA(0, 1, At, B1); PG8_BAR;
            PG8_LDA(At, 0, 1); PG8_STAGE(PG8_SA(0, 0), a2, voffA);
            PG8_BAR; PG8_WAIT_L(0); PG8_MMA(1, 0, At, B0); PG8_BAR; PG8_SCHED;
            PG8_STAGE(PG8_SB(0, 1), b2 + hstepB, voffB);
            PG8_WAIT_V(6); PG8_BAR; PG8_MMA(1, 1, At, B1); PG8_BAR;
            PG8_LDB(B0, 1, 0); PG8_SCHED; PG8_LDA(At, 1, 0); PG8_STAGE(PG8_SA(0, 1), a2 + hstepA, voffA);
            PG8_WAIT_L(8); PG8_BAR; PG8_WAIT_L(0); PG8_MMA(0, 0, At, B0); PG8_BAR; PG8_SCHED;
            PG8_LDB(B1, 1, 1); PG8_STAGE(PG8_SB(1, 0), b3, voffB);
            PG8_BAR; PG8_WAIT_L(0); PG8_MMA(0, 1, At, B1); PG8_BAR;
            PG8_LDA(At, 1, 1); PG8_STAGE(PG8_SA(1, 0), a3, voffA);
            PG8_BAR; PG8_WAIT_L(0); PG8_MMA(1, 0, At, B0); PG8_BAR; PG8_SCHED;
            PG8_STAGE(PG8_SB(1, 1), b3 + hstepB, voffB);
            PG8_WAIT_V(6); PG8_BAR; PG8_MMA(1, 1, At, B1); PG8_BAR;
            }
        }
        if constexpr (ALIGN_EPI) { if (wr == 0) PG8_BAR; }
        if constexpr (I8) { typedef int v4i_ __attribute__((ext_vector_type(4)));
#pragma unroll
            for (int a = 0; a < 2; ++a)
#pragma unroll
                for (int b = 0; b < 2; ++b)
#pragma unroll
                    for (int m = 0; m < 4; ++m)
#pragma unroll
                        for (int n = 0; n < 2; ++n) { const v4i_ c_ = __builtin_bit_cast(v4i_, acc[a][b][m][n]); acc[a][b][m][n] = (f32x4){(float)c_[0], (float)c_[1], (float)c_[2], (float)c_[3]}; } }
        if constexpr (F8) asm volatile("s_nop 15\n\ts_nop 15" ::: "memory");
        E(acc, cur, wr, wc, fr, fq);
        if (!has_next) break;
#pragma unroll
        for (int a = 0; a < 2; ++a)
#pragma unroll
            for (int b = 0; b < 2; ++b)
#pragma unroll
                for (int m = 0; m < 4; ++m)
#pragma unroll
                    for (int n = 0; n < 2; ++n) acc[a][b][m][n] = (f32x4){0.f, 0.f, 0.f, 0.f};
        cur = nxt; cA = nA; cB = nB; ++ui;
        if constexpr (ALIGN_EPI) { if (wr == 1) PG8_BAR; }
    }
    PG8_WAIT_V(0);
    if constexpr (!ALIGN_EPI) { if (wr == 0) PG8_BAR; }
    PG8_BAR;
#undef PG8_SA
#undef PG8_SB
#undef PG8_STAGE
#undef PG8_LDA
#undef PG8_LDB
#undef PG8_MMA
#undef PG8_WAIT_V
#undef PG8_WAIT_L
#undef PG8_BAR
#undef PG8_SCHED
#undef PG8_ABASE
}
#endif
}

namespace att {
constexpr int NW = 8, QBLK = 32, KVBLK = 64;
constexpr int LDQ = NQ, LDKN8 = D, LDO = D, LDKP8 = 64;
constexpr float SCALE = 0.07216878364870322f;
constexpr float THR = 5.f;
constexpr float OSCALE = 32.f;
constexpr int SHM_V = KVBLK * 128, SHM_KN = KVBLK * 128, SHM_KR = KVBLK * 64, NSLOT = 6;
constexpr int OFF_V = 0, OFF_KN = NSLOT * SHM_V, OFF_KR = OFF_KN + NSLOT * SHM_KN, OFF_WS = OFF_KR + NSLOT * SHM_KR, LDS_BYTES = OFF_WS + NW * 64 * 4;
#define KN8SW(row, c) ((row) * 128 + ((((c) ^ (((row) >> 1) & 7))) << 4))
#define KR8SW(row, c) ((row) * 64 + ((((c) ^ (((row) >> 2) & 3))) << 4))
typedef int v8i __attribute__((ext_vector_type(8)));
typedef int v4i __attribute__((ext_vector_type(4)));
typedef int v6i __attribute__((ext_vector_type(6)));
typedef int v2i_ __attribute__((ext_vector_type(2)));
#define SBAR() __builtin_amdgcn_sched_barrier(0)
__device__ __forceinline__ int crow(int r, int hi) { return (r & 3) + 8 * (r >> 2) + 4 * hi; }

constexpr float QC = SCALE * 1.4426950408889634f;
constexpr float THR6 = 2.0f, SEED6 = 1.8073549220576042f, THRP = THR6 * 1.4426950408889634f + SEED6, VSC6 = 1.75f;
__device__ __forceinline__ void sm_raise(f32x16& p0, f32x16& p1, f32x16& nm, float delta) {
  const f32x2 d2 = {delta, delta};
#pragma unroll
  for (int r = 0; r < 16; r += 2) { const f32x2 t = (f32x2){p0[r], p0[r + 1]} - d2; p0[r] = t.x; p0[r + 1] = t.y; const f32x2 w = (f32x2){p1[r], p1[r + 1]} - d2; p1[r] = w.x; p1[r + 1] = w.y;
    const f32x2 n_ = (f32x2){nm[r], nm[r + 1]} - d2; nm[r] = n_.x; nm[r + 1] = n_.y; }
}
__device__ __forceinline__ void partialSM(f32x16& p0, f32x16& p1, f32x16& nm, float& alpha, bool first) {
  float pmax, pmb;
  asm("v_max3_f32 %0, %1, %2, %3" : "=v"(pmax) : "v"(p0[0]), "v"(p0[1]), "v"(p1[0]));
  asm("v_max3_f32 %0, %1, %2, %3" : "=v"(pmb) : "v"(p0[2]), "v"(p0[3]), "v"(p1[1]));
  asm("v_max3_f32 %0, %1, %2, %3" : "=v"(pmax) : "v"(pmax), "v"(p1[2]), "v"(p1[3]));
#pragma unroll
  for (int r = 4; r < 16; r += 4) {
    asm("v_max3_f32 %0, %1, %2, %3" : "=v"(pmax) : "v"(pmax), "v"(p0[r]), "v"(p0[r + 1]));
    asm("v_max3_f32 %0, %1, %2, %3" : "=v"(pmb) : "v"(pmb), "v"(p0[r + 2]), "v"(p0[r + 3]));
    asm("v_max3_f32 %0, %1, %2, %3" : "=v"(pmax) : "v"(pmax), "v"(p1[r]), "v"(p1[r + 1]));
    asm("v_max3_f32 %0, %1, %2, %3" : "=v"(pmb) : "v"(pmb), "v"(p1[r + 2]), "v"(p1[r + 3])); }
  pmax = fmaxf(pmax, pmb);
  { auto rr = __builtin_amdgcn_permlane32_swap(__float_as_uint(pmax), __float_as_uint(pmax), false, false);
    pmax = fmaxf(__uint_as_float(rr[0]), __uint_as_float(rr[1])); }
  if (first) { alpha = 1.f; sm_raise(p0, p1, nm, pmax - SEED6); }
  else if (__builtin_expect(__all(pmax <= THRP), 1)) alpha = 1.f;
  else { const float delta = fmaxf(pmax - SEED6, 0.f); alpha = __builtin_amdgcn_exp2f(-delta); sm_raise(p0, p1, nm, delta); }
}
__device__ __forceinline__ void p_pack6(const f32x16& p0, const f32x16& p1, v6i& pf) {
  asm("v_cvt_scalef32_2xpk16_bf6_f32 %0, %1, %2, 1.0" : "=&v"(pf) : "v"(p0), "v"(p1));
}
__device__ __forceinline__ void finishSM(f32x16& p0, f32x16& p1, float alpha, float& l_reg, v6i& pf) {
#pragma unroll
  for (int r = 0; r < 16; ++r) p0[r] = __builtin_amdgcn_exp2f(p0[r]);
#pragma unroll
  for (int r = 0; r < 16; ++r) p1[r] = __builtin_amdgcn_exp2f(p1[r]);
  f32x2 s2a = {p0[0], p0[1]}, s2b = {p1[0], p1[1]};
#pragma unroll
  for (int r = 2; r < 16; r += 2) { s2a += (f32x2){p0[r], p0[r + 1]}; s2b += (f32x2){p1[r], p1[r + 1]}; }
  s2a += s2b; float ps = s2a.x + s2a.y;
  { auto rr = __builtin_amdgcn_permlane32_swap(__float_as_uint(ps), __float_as_uint(ps), false, false);
    ps = __uint_as_float(rr[0]) + __uint_as_float(rr[1]); }
  l_reg = l_reg * alpha + ps;
  p_pack6(p0, p1, pf);
}
template <int C_> __device__ __forceinline__ void fin_chunk(f32x16& p0, f32x16& p1, f32x2& s2, v6i& pf) {
  f32x16& p = (C_ < 2) ? p0 : p1; constexpr int r0 = 8 * (C_ & 1), g0 = (C_ < 2 ? 0 : 4) + 2 * (C_ & 1);
#pragma unroll
  for (int r = r0; r < r0 + 8; ++r) p[r] = __builtin_amdgcn_exp2f(p[r]);
#pragma unroll
  for (int r = r0; r < r0 + 8; r += 2) s2 += (f32x2){p[r], p[r + 1]};
  (void)pf; (void)g0;
}
__device__ __forceinline__ void fin_tail(const f32x2& s2, float alpha, float& l_reg) {
  float ps = s2.x + s2.y;
  { auto rr = __builtin_amdgcn_permlane32_swap(__float_as_uint(ps), __float_as_uint(ps), false, false);
    ps = __uint_as_float(rr[0]) + __uint_as_float(rr[1]); }
  l_reg = l_reg * alpha + ps;
}
__device__ __forceinline__ void part_max(const f32x16& p, float& a, float& b, bool first) {
  if (first) { asm("v_max3_f32 %0, %1, %2, %3" : "=v"(a) : "v"(p[0]), "v"(p[1]), "v"(p[2])); asm("v_max3_f32 %0, %1, %2, %3" : "=v"(b) : "v"(p[3]), "v"(p[4]), "v"(p[5]));
    asm("v_max3_f32 %0, %1, %2, %3" : "=v"(a) : "v"(a), "v"(p[6]), "v"(p[7])); asm("v_max3_f32 %0, %1, %2, %3" : "=v"(b) : "v"(b), "v"(p[8]), "v"(p[9]));
    asm("v_max3_f32 %0, %1, %2, %3" : "=v"(a) : "v"(a), "v"(p[10]), "v"(p[11])); asm("v_max3_f32 %0, %1, %2, %3" : "=v"(b) : "v"(b), "v"(p[12]), "v"(p[13]));
    asm("v_max3_f32 %0, %1, %2, %3" : "=v"(a) : "v"(a), "v"(p[14]), "v"(p[15])); }
  else {
#pragma unroll
    for (int r = 0; r < 16; r += 4) { asm("v_max3_f32 %0, %1, %2, %3" : "=v"(a) : "v"(a), "v"(p[r]), "v"(p[r + 1])); asm("v_max3_f32 %0, %1, %2, %3" : "=v"(b) : "v"(b), "v"(p[r + 2]), "v"(p[r + 3])); } }
}
__device__ __forceinline__ void part_decide(float a, float b, f32x16& p0, f32x16& p1, f32x16& nm, float& alpha) {
  float pmax = fmaxf(a, b);
  { auto rr = __builtin_amdgcn_permlane32_swap(__float_as_uint(pmax), __float_as_uint(pmax), false, false);
    pmax = fmaxf(__uint_as_float(rr[0]), __uint_as_float(rr[1])); }
  if (__builtin_expect(__all(pmax <= THRP), 1)) alpha = 1.f;
  else { const float delta = fmaxf(pmax - SEED6, 0.f); alpha = __builtin_amdgcn_exp2f(-delta); sm_raise(p0, p1, nm, delta); }
}
#define ATT_MFMA8_FIRST(P, KF, QF) asm volatile("v_mfma_f32_32x32x64_f8f6f4 %0, %1, %2, %3" : "=&v"(P) : "v"(KF), "v"(QF), "v"(nm))
#define ATT_MFMA8(P, KF, QF) asm volatile("v_mfma_f32_32x32x64_f8f6f4 %0, %1, %2, %0" : "+v"(P) : "v"(KF), "v"(QF))
__device__ __forceinline__ void k_load_nope(v8i* k0, v8i* k1, const LAS char* Kn, int r32, int hi) {
#pragma unroll
  for (int s_ = 0; s_ < 2; ++s_) { const int c = 4 * s_ + 2 * hi;
    k0[s_] = __builtin_shufflevector(*(const LAS v4i*)(Kn + KN8SW(r32, c)), *(const LAS v4i*)(Kn + KN8SW(r32, c + 1)), 0, 1, 2, 3, 4, 5, 6, 7);
    k1[s_] = __builtin_shufflevector(*(const LAS v4i*)(Kn + KN8SW(32 + r32, c)), *(const LAS v4i*)(Kn + KN8SW(32 + r32, c + 1)), 0, 1, 2, 3, 4, 5, 6, 7); }
}
__device__ __forceinline__ void k_load_pe(v8i* k0, v8i* k1, const LAS char* Kr, int r32, int hi) {
  const int c = 2 * hi;
  k0[2] = __builtin_shufflevector(*(const LAS v4i*)(Kr + KR8SW(r32, c)), *(const LAS v4i*)(Kr + KR8SW(r32, c + 1)), 0, 1, 2, 3, 4, 5, 6, 7);
  k1[2] = __builtin_shufflevector(*(const LAS v4i*)(Kr + KR8SW(32 + r32, c)), *(const LAS v4i*)(Kr + KR8SW(32 + r32, c + 1)), 0, 1, 2, 3, 4, 5, 6, 7);
}
__device__ __forceinline__ void qk_mma(f32x16& p0, f32x16& p1, v8i* k0, v8i* k1, const LAS char* Kr, const v8i* qf, const f32x16& nm, int r32, int hi, int sc) {
  k_load_pe(k0, k1, Kr, r32, hi);
  asm volatile("s_waitcnt lgkmcnt(4)" ::: "memory");
  ATT_MFMA8_FIRST(p0, k0[0], qf[0]); ATT_MFMA8_FIRST(p1, k1[0], qf[0]);
  ATT_MFMA8(p0, k0[1], qf[1]); ATT_MFMA8(p1, k1[1], qf[1]);
  asm volatile("s_waitcnt lgkmcnt(0)" ::: "memory");
  ATT_MFMA8(p0, k0[2], qf[2]); ATT_MFMA8(p1, k1[2], qf[2]);
}
#define ATT_MFMA_SETTLE() asm volatile("s_nop 15\n\ts_nop 15" ::: "memory")
template <int D0> __device__ __forceinline__ v6i pv_ldv(const LAS char* va, const LAS char* vb) {
  const v4i a_ = *(const LAS v4i*)(va + D0 * 2048); const v2i_ b_ = *(const LAS v2i_*)(vb + D0 * 2048);
  return (v6i){a_[0], a_[1], a_[2], a_[3], b_[0], b_[1]};
}
#define ATT_PVMFMA(OD, VF) asm volatile("v_mfma_f32_32x32x64_f8f6f4 %0, %1, %2, %0 cbsz:3 blgp:2" : "+v"(OD) : "v"(pf), "v"(VF))
__device__ __forceinline__ void pv_loadv(v6i* vf, const LAS char* va, const LAS char* vb) { vf[0] = pv_ldv<0>(va, vb); vf[1] = pv_ldv<1>(va, vb); }
__device__ __forceinline__ void pv_mma(f32x16* o, const v6i* vf, const LAS char* va, const LAS char* vb, const v6i& pf, int sc) {
  asm volatile("s_nop 4\n\ts_waitcnt lgkmcnt(0)" ::: "memory");
  ATT_PVMFMA(o[0], vf[0]); ATT_PVMFMA(o[1], vf[1]);
  { const v6i v2 = pv_ldv<2>(va, vb), v3 = pv_ldv<3>(va, vb);
    asm volatile("s_waitcnt lgkmcnt(0)" ::: "memory");
    ATT_PVMFMA(o[2], v2); ATT_PVMFMA(o[3], v3); }
}

#define ATT_GLDS(g, l) __builtin_amdgcn_global_load_lds((const unsigned*)(g), (LAS unsigned*)(l), 16, 0, 0)
#define ATT_BAR() asm volatile("s_waitcnt lgkmcnt(0)\n\ts_barrier" ::: "memory")
#define ATT_WAITV(n) asm volatile("s_waitcnt vmcnt(" #n ")" ::: "memory")
__device__ __forceinline__ void attn_unit(const bf16_t* __restrict__ Qb, const unsigned char* __restrict__ Kn, const unsigned char* __restrict__ Vp, const unsigned char* __restrict__ Kp,
                                          unsigned char* __restrict__ Ob, const f32x2* __restrict__ rope, int pos0, int seq, LAS char* lds, int tid_in) {
  int tid = tid_in; asm volatile("" : "+v"(tid));
  const int wid = __builtin_amdgcn_readfirstlane(tid >> 6), lane = tid & 63, r32 = lane & 31, hi = lane >> 5;
  LAS char* V_lds = lds + OFF_V; LAS char* KN_lds = lds + OFF_KN; LAS char* KR_lds = lds + OFF_KR;
  LAS float* ws = (LAS float*)(lds + OFF_WS) + wid * 64; LAS float* li_l = ws; LAS float* al_l = ws + 32;
  float l_reg = 0; f32x16 o[4] = {}; f32x16 nm = {SEED6, SEED6, SEED6, SEED6, SEED6, SEED6, SEED6, SEED6, SEED6, SEED6, SEED6, SEED6, SEED6, SEED6, SEED6, SEED6}; v8i qf[3];
  int sc = 0x7f7f7f7f; asm volatile("" : "+v"(sc));
  {
    const bf16_t* Qw = Qb + (long)(wid * QBLK + r32) * LDQ;
#pragma unroll
    for (int s_ = 0; s_ < 2; ++s_) {
      u32x4 w[4];
#pragma unroll
      for (int j = 0; j < 4; ++j) w[j] = *(const u32x4*)(Qw + 64 * s_ + 32 * hi + 8 * j);
      v8i f;
#pragma unroll
      for (int j = 0; j < 4; ++j) { f[2 * j] = (int)pk4_fp8(QC * bf_lo(w[j].x), QC * bf_hi(w[j].x), QC * bf_lo(w[j].y), QC * bf_hi(w[j].y)); f[2 * j + 1] = (int)pk4_fp8(QC * bf_lo(w[j].z), QC * bf_hi(w[j].z), QC * bf_lo(w[j].w), QC * bf_hi(w[j].w)); }
      qf[s_] = f;
    }
    const f32x2* rp = rope + (size_t)(pos0 + wid * QBLK + r32) * 32;
    v8i f;
#pragma unroll
    for (int j = 0; j < 4; ++j) {
      const u32x4 xa = *(const u32x4*)(Qw + 128 + 8 * j), xb = *(const u32x4*)(Qw + 160 + 8 * j);
      float r_[8];
#pragma unroll
      for (int e = 0; e < 8; ++e) { const f32x2 cs = rp[8 * j + e];
        const unsigned wa = e < 2 ? xa.x : e < 4 ? xa.y : e < 6 ? xa.z : xa.w, wb = e < 2 ? xb.x : e < 4 ? xb.y : e < 6 ? xb.z : xb.w;
        const float x1 = (e & 1) ? bf_hi(wa) : bf_lo(wa), x2 = (e & 1) ? bf_hi(wb) : bf_lo(wb);
        r_[e] = QC * (hi ? (x1 * cs.y + x2 * cs.x) : (x1 * cs.x - x2 * cs.y)); }
      f[2 * j] = (int)pk4_fp8(r_[0], r_[1], r_[2], r_[3]); f[2 * j + 1] = (int)pk4_fp8(r_[4], r_[5], r_[6], r_[7]);
    }
    qf[2] = f;
  }
  unsigned oK, oP; const unsigned oV = (unsigned)(wid * 1024 + lane * 16);
  { const int row = 8 * wid + (lane >> 3), c = (lane & 7) ^ ((row >> 1) & 7); oK = (unsigned)(row * LDKN8 + c * 16); }
  { const int row = 16 * (wid & 3) + (lane >> 2), c = (lane & 3) ^ ((row >> 2) & 3); oP = (unsigned)(row * LDKP8 + c * 16); }
#define ISSUE(b, k0) do { const char* vsrc_ = (const char*)Vp + (size_t)(k0) * 128; const char* ksrc_ = (const char*)Kn + (size_t)(k0) * LDKN8; const char* psrc_ = (const char*)Kp + (size_t)(k0) * LDKP8; \
    ATT_GLDS(vsrc_ + oV, V_lds + (b) * SHM_V + wid * 1024); \
    ATT_GLDS(ksrc_ + oK, KN_lds + (b) * SHM_KN + wid * 1024); \
    if (wid < 4) ATT_GLDS(psrc_ + oP, KR_lds + (b) * SHM_KR + wid * 1024); } while (0)
  const LAS char* vla0 = V_lds + r32 * 64 + (((2 * hi) ^ ((r32 >> 2) & 3)) << 4);
  const LAS char* vlb0 = V_lds + r32 * 64 + (((2 * hi + 1) ^ ((r32 >> 2) & 3)) << 4);
#define RESC(a) do { if (__any((a) < 1.f)) { if (hi == 0) al_l[r32] = (a); asm volatile("s_nop 15\n\ts_nop 15\n\ts_waitcnt lgkmcnt(0)" ::: "memory");   \
    _Pragma("unroll") for (int d = 0; d < 4; ++d) _Pragma("unroll") for (int r = 0; r < 16; ++r) o[d][r] *= al_l[crow(r, hi)]; asm volatile("s_nop 4" ::: "memory"); } } while (0)
  f32x16 pA0, pA1, pB0, pB1; float alA, alB; v6i pf; const int NT = seq / KVBLK;
  v8i k0[3], k1[3]; v6i vf[2];
#define SLOT_NEXT(x) ((x) == NSLOT - 1 ? 0 : (x) + 1)
#define SLOT_PREV(x) ((x) == 0 ? NSLOT - 1 : (x) - 1)
#define KLOAD(sl_) k_load_nope(k0, k1, KN_lds + (sl_) * SHM_KN, r32, hi)
#define VLOAD(sl_) pv_loadv(vf, vla0 + (sl_) * SHM_V, vlb0 + (sl_) * SHM_V)
#define WAIT_TILES2() do { if (wid < 4) { ATT_WAITV(6); } else { ATT_WAITV(4); } } while (0)
#define STEP(j_, Pn0, Pn1, alN, Po0, Po1, alO) do { const int sm1_ = SLOT_PREV(s0), sp1_ = SLOT_NEXT(s0); f32x2 s2_ = {0.f, 0.f}; float ma_, mb_; v6i v2_, v3_; \
    const LAS char* va_ = vla0 + sm1_ * SHM_V; const LAS char* vb_ = vlb0 + sm1_ * SHM_V; \
    SBAR(); k_load_pe(k0, k1, KR_lds + s0 * SHM_KR, r32, hi); SBAR(); \
    ATT_MFMA8_FIRST(Pn0, k0[0], qf[0]); SBAR(); fin_chunk<0>(Po0, Po1, s2_, pf); SBAR(); \
    ATT_MFMA8_FIRST(Pn1, k1[0], qf[0]); SBAR(); fin_chunk<1>(Po0, Po1, s2_, pf); SBAR(); \
    ATT_MFMA8(Pn0, k0[1], qf[1]); SBAR(); fin_chunk<2>(Po0, Po1, s2_, pf); SBAR(); \
    ATT_MFMA8(Pn1, k1[1], qf[1]); SBAR(); VLOAD(sm1_); fin_chunk<3>(Po0, Po1, s2_, pf); SBAR(); p_pack6(Po0, Po1, pf); SBAR();     \
    ATT_MFMA8(Pn0, k0[2], qf[2]); SBAR(); fin_tail(s2_, alO, l_reg); SBAR(); \
    ATT_MFMA8(Pn1, k1[2], qf[2]); SBAR(); \
    ATT_PVMFMA(o[0], vf[0]); SBAR(); v2_ = pv_ldv<2>(va_, vb_); v3_ = pv_ldv<3>(va_, vb_); part_max(Pn0, ma_, mb_, true); SBAR(); \
    ATT_PVMFMA(o[1], vf[1]); SBAR(); part_max(Pn1, ma_, mb_, false); KLOAD(sp1_); SBAR(); \
    ATT_PVMFMA(o[2], v2_); SBAR(); part_decide(ma_, mb_, Pn0, Pn1, nm, alN); SBAR(); \
    ATT_PVMFMA(o[3], v3_); SBAR(); \
    RESC(alN); \
    if ((j_) + 4 < NT) { WAIT_TILES2(); } else { ATT_WAITV(0); }        \
    ATT_BAR();                                                           \
    if ((j_) + 5 < NT) { ISSUE(sm1_, ((j_) + 5) * KVBLK); } \
    s0 = sp1_; } while (0)
  ISSUE(0, 0); ISSUE(1, KVBLK); ISSUE(2, 2 * KVBLK); ISSUE(3, 3 * KVBLK); ISSUE(4, 4 * KVBLK);
  if (wid < 4) { ATT_WAITV(9); } else { ATT_WAITV(6); }
  ATT_BAR();
  KLOAD(0); qk_mma(pA0, pA1, k0, k1, KR_lds, qf, nm, r32, hi, sc); ATT_MFMA_SETTLE(); SBAR(); KLOAD(1); partialSM(pA0, pA1, nm, alA, true);
  WAIT_TILES2(); ATT_BAR();
  ISSUE(5, 5 * KVBLK);
  int s0 = 1;
  for (int j = 1; j + 1 < NT; j += 2) {
    STEP(j, pB0, pB1, alB, pA0, pA1, alA);
    STEP(j + 1, pA0, pA1, alA, pB0, pB1, alB);
  }
  { const int sm1_ = SLOT_PREV(s0);
    SBAR(); qk_mma(pB0, pB1, k0, k1, KR_lds + s0 * SHM_KR, qf, nm, r32, hi, sc); VLOAD(sm1_); SBAR();
    finishSM(pA0, pA1, alA, l_reg, pf); SBAR();
    pv_mma(o, vf, vla0 + sm1_ * SHM_V, vlb0 + sm1_ * SHM_V, pf, sc); SBAR(); VLOAD(s0); partialSM(pB0, pB1, nm, alB, false);
    RESC(alB);
    finishSM(pB0, pB1, alB, l_reg, pf); SBAR();
    pv_mma(o, vf, vla0 + s0 * SHM_V, vlb0 + s0 * SHM_V, pf, sc); }
  asm volatile("s_nop 15\n\ts_nop 15" ::: "memory");
  if (hi == 0) li_l[r32] = l_reg; asm volatile("s_waitcnt lgkmcnt(0)" ::: "memory");
  float rli[16];
#pragma unroll
  for (int r = 0; r < 16; ++r) rli[r] = (OSCALE / VSC6) * __builtin_amdgcn_rcpf(li_l[crow(r, hi)]);
  unsigned char* Ow = Ob + (long)(wid * QBLK) * LDO;
#pragma unroll
  for (int r = 0; r < 16; ++r) { const int orow = crow(r, hi);
#pragma unroll
    for (int d0 = 0; d0 < 4; ++d0) Ow[(long)orow * LDO + d0 * 32 + r32] = (unsigned char)(__builtin_amdgcn_cvt_pk_fp8_f32(o[d0][r] * rli[r], 0.f, 0, false) & 0xff); }
  ATT_BAR();
#undef ISSUE
#undef STEP
#undef RESC
}
}

constexpr int RING_OFF = 0, RING_BYTES = 131072;
constexpr int LDSCTL_OFF = RING_BYTES, MISC_OFF = LDSCTL_OFF + 320;
constexpr int LDS_BYTES = 147456;
constexpr int NWAVES = 8;
static_assert(att::LDS_BYTES <= RING_BYTES, "attention LDS");

typedef GAS unsigned gu32;
#define RLX_AGENT __ATOMIC_RELAXED, __HIP_MEMORY_SCOPE_AGENT
#define LDS_WAIT() asm volatile("s_waitcnt lgkmcnt(0)" ::: "memory")
#define VM_WAIT() asm volatile("s_waitcnt vmcnt(0)" ::: "memory")

#define XB_TMO      128
#define XB_XCNT(j)  (256  + 64 * (j))
#define XB_XSUB(j)  (1280 + 64 * (j))
#define XB_XGEN(j)  (2304 + 64 * (j))
#define XB_TOP      3328
#define XB_TOPGEN   3392
#define XCD_BAR_WORDS 3456
#define XB_SPIN_CAP (1u << 22)

__device__ __forceinline__ unsigned xb_ld(unsigned* p)              { return __hip_atomic_load(p, __ATOMIC_RELAXED, __HIP_MEMORY_SCOPE_AGENT); }
__device__ __forceinline__ unsigned xb_add(unsigned* p, unsigned v) { return __hip_atomic_fetch_add(p, v, __ATOMIC_RELAXED, __HIP_MEMORY_SCOPE_AGENT); }
__device__ __forceinline__ unsigned xb_xcc_id() { return (unsigned)__builtin_amdgcn_s_getreg((3 << 11) | 20) & 0xFu; }
#define XB_SPIN(cond, bar) do { unsigned _sp = 0; while (cond) { __builtin_amdgcn_s_sleep(1); \
    if ((++_sp & 255u) == 0u) { if (xb_ld(&(bar)[XB_TMO])) break; if (_sp > XB_SPIN_CAP) { atomicAdd(&(bar)[XB_TMO], 1u); break; } } } } while (0)

struct XcdBarrier { unsigned* bar; unsigned x; volatile LAS unsigned* st; };

__device__ __forceinline__ XcdBarrier xcd_barrier_post(unsigned* bar, volatile LAS unsigned* st) {
    XcdBarrier b; b.bar = bar; b.x = xb_xcc_id(); b.st = st;
    if (threadIdx.x == 0) (void)xb_add(&bar[XB_XCNT(b.x)], 1u);
    return b;
}
__device__ __forceinline__ void xcd_barrier_complete(unsigned* bar, unsigned x, unsigned& nloc, unsigned& nx) {
    const unsigned G = gridDim.x * gridDim.y * gridDim.z;
    unsigned sum, cnt, mine, sp = 0u;
    for (;;) {
        sum = 0u; cnt = 0u; mine = 0u;
#pragma unroll
        for (unsigned j = 0; j < 16; ++j) { const unsigned c = xb_ld(&bar[XB_XCNT(j)]); sum += c; cnt += (c > 0u) ? 1u : 0u; mine = (j == x) ? c : mine; }
        if (sum == G) break;
        __builtin_amdgcn_s_sleep(1);
        if ((++sp & 255u) == 0u) { if (xb_ld(&bar[XB_TMO])) break; if (sp > XB_SPIN_CAP) { atomicAdd(&bar[XB_TMO], 1u); break; } }
    }
    nloc = mine > 0u ? mine : 1u; nx = cnt > 0u ? cnt : 1u;
}
__device__ __forceinline__ void xcd_barrier(const XcdBarrier& b, int tid) {
    asm volatile("s_waitcnt vmcnt(0)" ::: "memory");
    __syncthreads();
    if (tid == 0) {
        unsigned* bar = b.bar;
        __builtin_amdgcn_s_waitcnt(0);
        unsigned nloc = b.st[0], nx = b.st[1];
        if (nloc == 0u) { xcd_barrier_complete(bar, b.x, nloc, nx); b.st[0] = nloc; b.st[1] = nx; }
        const unsigned old = xb_add(&bar[XB_XSUB(b.x)], 1u);
        const unsigned gen = old / nloc;
        if (old + 1u == (gen + 1u) * nloc) {
            __builtin_amdgcn_fence(__ATOMIC_RELEASE, "agent");
            asm volatile("s_waitcnt vmcnt(0)" ::: "memory");
            const unsigned og = xb_add(&bar[XB_TOP], 1u);
            const unsigned tg = og / nx;
            if (og + 1u == (tg + 1u) * nx) xb_add(&bar[XB_TOPGEN], 1u);
            else XB_SPIN(xb_ld(&bar[XB_TOPGEN]) == tg, bar);
            __builtin_amdgcn_fence(__ATOMIC_ACQUIRE, "agent");
            xb_add(&bar[XB_XGEN(b.x)], 1u);
            asm volatile("s_waitcnt vmcnt(0)" ::: "memory");
        } else {
            XB_SPIN(xb_ld(&bar[XB_XGEN(b.x)]) == gen, bar);
            __builtin_amdgcn_fence(__ATOMIC_ACQUIRE, "agent");
            asm volatile("s_waitcnt vmcnt(0)" ::: "memory");
        }
    }
    __syncthreads();
}

struct Args {
    const float* x_prompt; const float* x_sample; const float* norm1; const float* w_in; const float* conv_w; const float* conv_b;
    const float* lru_wa; const float* lru_ba; const float* lru_wx; const float* lru_bx; const float* lru_lam;
    const float* q_norm; const float* w_q_up; const float* kv_norm; const float* w_kv_up; const float* w_lru_proj; const float* w_mla_proj; const float* w_out;
    const float* norm2; const float* w_up; const float* w_down; const float* norm_f;
    float* out; unsigned char* ws; int ph_lo, ph_hi, li, pad;
};

__device__ __forceinline__ float wave_sum(float v) {
    v += __builtin_bit_cast(float, __builtin_amdgcn_ds_swizzle(__builtin_bit_cast(int, v), (1 << 10) | 0x1f));
    v += __builtin_bit_cast(float, __builtin_amdgcn_ds_swizzle(__builtin_bit_cast(int, v), (2 << 10) | 0x1f));
    v += __builtin_bit_cast(float, __builtin_amdgcn_ds_swizzle(__builtin_bit_cast(int, v), (4 << 10) | 0x1f));
    v += __builtin_bit_cast(float, __builtin_amdgcn_ds_swizzle(__builtin_bit_cast(int, v), (8 << 10) | 0x1f));
    v += __builtin_bit_cast(float, __builtin_amdgcn_ds_swizzle(__builtin_bit_cast(int, v), (16 << 10) | 0x1f));
    { const auto rr = __builtin_amdgcn_permlane32_swap(__float_as_uint(v), __float_as_uint(v), false, false); v = __uint_as_float(rr[0]) + __uint_as_float(rr[1]); }
    return v;
}
__device__ __forceinline__ float wave_max(float v) {
    v = fmaxf(v, __builtin_bit_cast(float, __builtin_amdgcn_ds_swizzle(__builtin_bit_cast(int, v), (1 << 10) | 0x1f)));
    v = fmaxf(v, __builtin_bit_cast(float, __builtin_amdgcn_ds_swizzle(__builtin_bit_cast(int, v), (2 << 10) | 0x1f)));
    v = fmaxf(v, __builtin_bit_cast(float, __builtin_amdgcn_ds_swizzle(__builtin_bit_cast(int, v), (4 << 10) | 0x1f)));
    v = fmaxf(v, __builtin_bit_cast(float, __builtin_amdgcn_ds_swizzle(__builtin_bit_cast(int, v), (8 << 10) | 0x1f)));
    v = fmaxf(v, __builtin_bit_cast(float, __builtin_amdgcn_ds_swizzle(__builtin_bit_cast(int, v), (16 << 10) | 0x1f)));
    { const auto rr = __builtin_amdgcn_permlane32_swap(__float_as_uint(v), __float_as_uint(v), false, false); v = fmaxf(__uint_as_float(rr[0]), __uint_as_float(rr[1])); }
    return v;
}
__device__ __forceinline__ void transpose_item(const float* W, int ldw, int k0, int n0, bf16_t* WT, int ldt, int drow0, LAS float* scr, int lane) {
#pragma unroll 8
    for (int i = 0; i < 32; ++i) { const int kk = 2 * i + (lane >> 5); scr[kk * 33 + (lane & 31)] = W[(size_t)(k0 + kk) * ldw + n0 + (lane & 31)]; }
    LDS_WAIT(); asm volatile("" ::: "memory");
    const int c = lane & 7;
#pragma unroll
    for (int j = 0; j < 4; ++j) { const int n = (lane >> 3) + 8 * j; const LAS float* s = scr + (8 * c) * 33 + n;
        u32x4 o; o.x = cvt_pk_bf16(s[0 * 33], s[1 * 33]); o.y = cvt_pk_bf16(s[2 * 33], s[3 * 33]); o.z = cvt_pk_bf16(s[4 * 33], s[5 * 33]); o.w = cvt_pk_bf16(s[6 * 33], s[7 * 33]);
        *(u32x4*)(WT + (size_t)(drow0 + n) * ldt + k0 + 8 * c) = o; }
    LDS_WAIT(); asm volatile("" ::: "memory");
}
template <bool I8 = false> __device__ __forceinline__ void transpose_item_f8(const float* W, int ldw, int k0, int n0, unsigned char* WT, int ldt, int drow0, float mul, LAS float* scr, int lane) {
    float v_[32];
#pragma unroll
    for (int i = 0; i < 32; ++i) { const int kk = 2 * i + (lane >> 5); v_[i] = W[(size_t)(k0 + kk) * ldw + n0 + (lane & 31)]; }
#pragma unroll
    for (int i = 0; i < 32; ++i) { const int kk = 2 * i + (lane >> 5); scr[kk * 33 + (lane & 31)] = v_[i]; }
    LDS_WAIT(); asm volatile("" ::: "memory");
    const int c = lane & 7;
#pragma unroll
    for (int j = 0; j < 4; ++j) { const int n = (lane >> 3) + 8 * j; const LAS float* s = scr + (8 * c) * 33 + n;
        u32x2 o; if constexpr (I8) { o.x = pk4_i8(s[0 * 33], s[1 * 33], s[2 * 33], s[3 * 33], mul); o.y = pk4_i8(s[4 * 33], s[5 * 33], s[6 * 33], s[7 * 33], mul); }
        else { o.x = pk4_fp8(s[0 * 33] * mul, s[1 * 33] * mul, s[2 * 33] * mul, s[3 * 33] * mul); o.y = pk4_fp8(s[4 * 33] * mul, s[5 * 33] * mul, s[6 * 33] * mul, s[7 * 33] * mul); }
        *(u32x2*)(WT + (size_t)(drow0 + n) * ldt + k0 + 8 * c) = o; }
    LDS_WAIT(); asm volatile("" ::: "memory");
}
__device__ __forceinline__ void fwht64(float (&v)[64]) {
#pragma unroll
    for (int s_ = 1; s_ < 64; s_ <<= 1)
#pragma unroll
        for (int i = 0; i < 64; ++i) if ((i & s_) == 0) { const float a = v[i], b = v[i | s_]; v[i] = a + b; v[i | s_] = a - b; }
#pragma unroll
    for (int i = 0; i < 64; ++i) v[i] *= 0.125f;
}
__device__ __forceinline__ void transpose_item_h64_i8(const float* W, int ldw, int k0, int n0, unsigned char* WT, int ldt, int drow0, float qs, LAS float* scr, int lane) {
    float v_[32];
#pragma unroll
    for (int i = 0; i < 32; ++i) { const int kk = 2 * i + (lane >> 5); v_[i] = W[(size_t)(k0 + kk) * ldw + n0 + (lane & 31)]; }
#pragma unroll
    for (int i = 0; i < 32; ++i) { const int kk = 2 * i + (lane >> 5); scr[kk * 33 + (lane & 31)] = v_[i]; }
    LDS_WAIT(); asm volatile("" ::: "memory");
    if (lane < 32) {
        float c_[64];
#pragma unroll
        for (int k = 0; k < 64; ++k) c_[k] = scr[k * 33 + lane];
        fwht64(c_);
#pragma unroll
        for (int k = 0; k < 64; ++k) scr[k * 33 + lane] = c_[k];
    }
    LDS_WAIT(); asm volatile("" ::: "memory");
    const int c = lane & 7;
#pragma unroll
    for (int j = 0; j < 4; ++j) { const int n = (lane >> 3) + 8 * j; const LAS float* s = scr + (8 * c) * 33 + n;
        u32x2 o; o.x = pk4_i8(s[0 * 33], s[1 * 33], s[2 * 33], s[3 * 33], qs); o.y = pk4_i8(s[4 * 33], s[5 * 33], s[6 * 33], s[7 * 33], qs);
        *(u32x2*)(WT + (size_t)(drow0 + n) * ldt + k0 + 8 * c) = o; }
    LDS_WAIT(); asm volatile("" ::: "memory");
}
__device__ __forceinline__ void transpose_item_h32_i8(const float* W, int ldw, int k0, int n0, unsigned char* WT, int ldt, int drow0, float qs, LAS float* scr, int lane) {
    float v_[32];
#pragma unroll
    for (int i = 0; i < 32; ++i) { const int kk = 2 * i + (lane >> 5); v_[i] = W[(size_t)(k0 + kk) * ldw + n0 + (lane & 31)]; }
#pragma unroll
    for (int i = 0; i < 32; ++i) { const int kk = 2 * i + (lane >> 5); scr[kk * 33 + (lane & 31)] = v_[i]; }
    LDS_WAIT(); asm volatile("" ::: "memory");
    { const int n = lane & 31, kb = (lane >> 5) * 32;
      float c_[32];
#pragma unroll
      for (int k = 0; k < 32; ++k) c_[k] = scr[(kb + k) * 33 + n];
#pragma unroll
      for (int s_ = 1; s_ < 32; s_ <<= 1)
#pragma unroll
          for (int i = 0; i < 32; ++i) if ((i & s_) == 0) { const float a = c_[i], b = c_[i | s_]; c_[i] = a + b; c_[i | s_] = a - b; }
#pragma unroll
      for (int k = 0; k < 32; ++k) scr[(kb + k) * 33 + n] = c_[k] * 0.17677669529663689f; }
    LDS_WAIT(); asm volatile("" ::: "memory");
    const int c = lane & 7;
#pragma unroll
    for (int j = 0; j < 4; ++j) { const int n = (lane >> 3) + 8 * j; const LAS float* s = scr + (8 * c) * 33 + n;
        u32x2 o; o.x = pk4_i8(s[0 * 33], s[1 * 33], s[2 * 33], s[3 * 33], qs); o.y = pk4_i8(s[4 * 33], s[5 * 33], s[6 * 33], s[7 * 33], qs);
        *(u32x2*)(WT + (size_t)(drow0 + n) * ldt + k0 + 8 * c) = o; }
    LDS_WAIT(); asm volatile("" ::: "memory");
}
__device__ __forceinline__ void transpose_job(const float* W, int K, int N, bf16_t* WT, int r, LAS float* scr, int lane) {
    const int nblk = N / 32, kb = r / nblk, nb = r % nblk;
    transpose_item(W, N, 64 * kb, 32 * nb, WT, K, 32 * nb, scr, lane);
}

__device__ __forceinline__ void rms_row_to_bf16(const float* xrow, const float* g, bf16_t* orow, int lane, unsigned char* o8row = nullptr) {
    const f32x4* xr = (const f32x4*)xrow + lane; const f32x4* gr = (const f32x4*)g + lane;
    f32x4 v[16]; float s = 0.f;
#pragma unroll
    for (int j = 0; j < 16; ++j) { v[j] = xr[64 * j]; s += (v[j].x * v[j].x + v[j].y * v[j].y) + (v[j].z * v[j].z + v[j].w * v[j].w); }
    const float rstd = 1.0f / sqrtf(wave_sum(s) * (1.f / D) + EPS);
    u32x2* o8 = (u32x2*)orow + lane;
#pragma unroll
    for (int j = 0; j < 16; ++j) { const f32x4 gg = gr[64 * j]; const f32x4 y = v[j] * rstd * gg;
        if (orow) { u32x2 w; w.x = cvt_pk_bf16(y.x, y.y); w.y = cvt_pk_bf16(y.z, y.w); o8[64 * j] = w; }
        if (o8row) ((unsigned*)o8row)[lane + 64 * j] = pk4_i8(y.x, y.y, y.z, y.w, XN_QS); }
}
__device__ __forceinline__ void rms_row_inplace_f32(float* xrow, const float* g, int lane) {
    f32x4* xr = (f32x4*)xrow + lane; const f32x4* gr = (const f32x4*)g + lane;
    f32x4 v[16]; float s = 0.f;
#pragma unroll
    for (int j = 0; j < 16; ++j) { v[j] = xr[64 * j]; s += (v[j].x * v[j].x + v[j].y * v[j].y) + (v[j].z * v[j].z + v[j].w * v[j].w); }
    const float rstd = 1.0f / sqrtf(wave_sum(s) * (1.f / D) + EPS);
#pragma unroll
    for (int j = 0; j < 16; ++j) { const f32x4 gg = gr[64 * j]; xr[64 * j] = v[j] * rstd * gg; }
}

__device__ __forceinline__ void rms_row_from_bf16(const bf16_t* xrow, const float* g, bf16_t* obf, unsigned char* o8, float* of32, int lane) {
    f32x4 v[16]; float s = 0.f;
#pragma unroll
    for (int j = 0; j < 8; ++j) { pg8::unpack8(*(const u32x4*)(xrow + (lane + 64 * j) * 8), v[2 * j], v[2 * j + 1]); }
#pragma unroll
    for (int j = 0; j < 16; ++j) s += (v[j].x * v[j].x + v[j].y * v[j].y) + (v[j].z * v[j].z + v[j].w * v[j].w);
    const float rstd = 1.0f / sqrtf(wave_sum(s) * (1.f / D) + EPS);
#pragma unroll
    for (int j = 0; j < 8; ++j) { const int c = (lane + 64 * j) * 8; const f32x4 y0 = v[2 * j] * rstd * *(const f32x4*)(g + c), y1 = v[2 * j + 1] * rstd * *(const f32x4*)(g + c + 4);
        if (obf) *(u32x4*)(obf + c) = pg8::pack8(y0, y1);
        if (o8) *(u32x2*)(o8 + c) = (u32x2){pk4_i8(y0.x, y0.y, y0.z, y0.w, XN_QS), pk4_i8(y1.x, y1.y, y1.z, y1.w, XN_QS)};
        if (of32) { *(f32x4*)(of32 + c) = y0; *(f32x4*)(of32 + c + 4) = y1; } }
}
__device__ __forceinline__ void lru_gate(float lr, float li, float x, float sp8l2, float& la2, float& u) {
    const float r = fast_sigmoid(lr), i = fast_sigmoid(li);
    la2 = -r * sp8l2;
    const float a = __builtin_amdgcn_exp2f(la2);
    const float m = sqrtf(fmaxf(1.0f - a * a, 0.f));
    u = m * i * x;
}
constexpr int TB_SP8 = 0, TB_GBIAS = 2 * D, TB_NORM1 = TB_GBIAS + NG, TB_NORM2 = TB_NORM1 + D, TB_NORMF = TB_NORM2 + D, TB_CONVW = TB_NORMF + D, TB_CONVB = TB_CONVW + 4 * D,
              TB_QNORM = TB_CONVB + D, TB_KVNORM = TB_QNORM + 1024, TB_END = TB_KVNORM + 512;
static_assert(TB_END * 4 <= (int)MiB, "TAB region");
#ifndef PHMASK
#define PHMASK 0xffffu
#endif
#define EN(b) ((PHMASK >> (b)) & 1u)
#define CAS __attribute__((address_space(4)))
#define PHASE_BEGIN() int tid; asm volatile("v_mbcnt_lo_u32_b32 %0, -1, 0\n\tv_mbcnt_hi_u32_b32 %0, -1, %0" : "=v"(tid)); tid += wave0 * 64;     \
    const CAS Args* kp = (const CAS Args*)__builtin_amdgcn_kernarg_segment_ptr(); int G = G0, bx = bx0, vcu = vcu0; \
    asm volatile("" : "+v"(tid), "+s"(kp), "+s"(G), "+s"(bx), "+s"(vcu)); unsigned char* ws = kp->ws; const int NGW = G * NWAVES; (void)NGW; (void)bx; \
    const int lane = tid & 63, wave = __builtin_amdgcn_readfirstlane(tid >> 6), gw = vcu * NWAVES + wave; (void)lane; (void)wave; (void)gw; \
    float* TAB = (float*)(ws + WS_TAB); (void)TAB

__global__ void __launch_bounds__(NWAVES * 64, 2) fwd(Args args) {
    extern __shared__ __attribute__((aligned(16))) unsigned char lds_raw[];
    LAS unsigned char* lds = (LAS unsigned char*)lds_raw;
    volatile LAS unsigned* MISC = (volatile LAS unsigned*)(lds + MISC_OFF);
    const int wave0 = __builtin_amdgcn_readfirstlane((int)threadIdx.x >> 6);
    const int G0 = gridDim.x, bx0 = blockIdx.x;
    const int vcu0 = (G0 % 8 == 0) ? (bx0 % 8) * (G0 / 8) + bx0 / 8 : bx0;
    gu32* ctl = (gu32*)(args.ws + WS_CTL);
    for (int u = threadIdx.x; u < (LDS_BYTES - LDSCTL_OFF) / 4; u += NWAVES * 64) ((LAS unsigned*)(lds + LDSCTL_OFF))[u] = 0u;
    __syncthreads();
    XcdBarrier bar; bar.bar = (unsigned*)(ctl + CW_BAR) + args.li * XCD_BAR_WORDS; bar.x = 0; bar.st = nullptr;
    if (MK_N_LAUNCHES == 0) bar = xcd_barrier_post((unsigned*)(ctl + CW_BAR) + args.li * XCD_BAR_WORDS, MISC + 8);
    const int lo = args.ph_lo, hi = args.ph_hi;
#define IN(k) (lo <= (k) && (k) < hi)
#define SEAM(k) do { if ((k) + 1 < hi) { if (MK_N_LAUNCHES == 0) xcd_barrier(bar, tid); } } while (0)

    if (EN(0) && IN(0)) {
        PHASE_BEGIN();
        bf16_t* WIN_T = (bf16_t*)(ws + WS_WIN); bf16_t* WG_T = (bf16_t*)(ws + WS_WG);
        LAS float* scr = (LAS float*)(lds + RING_OFF + wave * 16384);
        constexpr int I_IN = (D / 64) * (IN_COLS / 32);
        constexpr int I_G = 64 * 32;
        constexpr int I_Q = (1024 / 64) * (NQ / 32);
        constexpr int I_KV = (512 / 64) * (NKV / 32);
        constexpr int I_SQ = (D / 64) * (D / 32);
        constexpr int I_UP = (D / 64) * (DFF / 32);
        constexpr int I_DN = (DFF / 64) * (D / 32);
        constexpr int NITEMS = I_IN + I_G + I_Q + I_KV + 3 * I_SQ + I_UP + I_DN;
        for (int it = gw; it < NITEMS; it += NGW) {
            int r = it;
            if (r < I_IN) { const int nblk = IN_COLS / 32, kb = r / nblk, nb = r % nblk, n0 = 32 * nb;
                transpose_item_f8<true>(kp->w_in, IN_COLS, 64 * kb, n0, (unsigned char*)WIN_T, D, n0 < SRC_GATE ? n0 : n0 + 192, WIN_QS, scr, lane);
                continue; } r -= I_IN;
            if (r < I_G) { const int mat = r >> 5, sub = r & 31, kb = sub >> 3, nb = sub & 7;
                const int isx = mat & 1, hb = (mat >> 1) & 15, dir = mat >> 5; const float* W = (isx ? kp->lru_wx : kp->lru_wa) + (size_t)(dir * 16 + hb) * 65536;
                transpose_item(W, 256, 64 * kb, 32 * nb, WG_T, 256, (hb * 4 + dir * 2 + (nb >> 2)) * 256 + isx * 128 + (nb & 3) * 32, scr, lane); continue; } r -= I_G;
            if (r < I_Q) { const int nblk = NQ / 32, kb = r / nblk, nb = r % nblk; transpose_item_f8(kp->w_q_up, NQ, 64 * kb, 32 * nb, (unsigned char*)(ws + WS_WQ), 1024, 32 * nb, 64.0f, scr, lane); continue; } r -= I_Q;
            if (r < I_KV) { const int nblk = NKV / 32, kb = r / nblk, nb = r % nblk; transpose_item_f8(kp->w_kv_up, NKV, 64 * kb, 32 * nb, (unsigned char*)(ws + WS_WKV), 512, 32 * nb, 64.0f, scr, lane); continue; } r -= I_KV;
            if (r < I_SQ) { const int nblk = D / 32, kb = r / nblk, nb = r % nblk; transpose_item_h64_i8(kp->w_lru_proj, D, 64 * kb, 32 * nb, (unsigned char*)(ws + WS_WLP), D, 32 * nb, WSQ_QS, scr, lane); continue; } r -= I_SQ;
            if (r < I_SQ) { const int nblk = D / 32, kb = r / nblk, nb = r % nblk; transpose_item_f8(kp->w_mla_proj, D, 64 * kb, 32 * nb, (unsigned char*)(ws + WS_WMP), D, 32 * nb, 64.0f, scr, lane); continue; } r -= I_SQ;
            if (r < I_SQ) { const int nblk = D / 32, kb = r / nblk, nb = r % nblk; transpose_item_h32_i8(kp->w_out, D, 64 * kb, 32 * nb, (unsigned char*)(ws + WS_WO), D, 32 * nb, WSQ_QS, scr, lane); continue; } r -= I_SQ;
            if (r < I_UP) { const int nblk = DFF / 32, kb = r / nblk, nb = r % nblk, n0 = 32 * nb;
                if (n0 < NUP8) transpose_item_f8<true>(kp->w_up, DFF, 64 * kb, n0, (unsigned char*)(ws + WS_WUP), D, n0, WSQ_QS, scr, lane);
                else transpose_item(kp->w_up, DFF, 64 * kb, n0, (bf16_t*)(ws + WS_WUPB), D, n0 - NUP8, scr, lane);
                continue; } r -= I_UP;
            transpose_job(kp->w_down, DFF, D, (bf16_t*)(ws + WS_WDN), r, scr, lane);
        }
        const int gt = vcu * (NWAVES * 64) + tid, NGT = G * NWAVES * 64;
        for (int i = gt; i < 192 * D / 16; i += NGT) *(u32x4*)(ws + WS_WIN + (size_t)SRC_GATE * D + (size_t)i * 16) = (u32x4){0u, 0u, 0u, 0u};
        f32x2* ROPE = (f32x2*)(ws + WS_ROPE);
        for (int i = gt; i < SEQ_P * 32; i += NGT) { const int pos = i >> 5, k = i & 31;
            const float inv = 1.0f / powf(10000.0f, (float)k * (1.0f / 32.0f)); const float ang = (float)pos * inv;
            const double rev = (double)ang * 0.15915494309189535; const float fr = (float)(rev - __builtin_rint(rev));
            ROPE[i] = (f32x2){__builtin_amdgcn_cosf(fr), __builtin_amdgcn_sinf(fr)}; }
        for (int i = gt; i < 2 * D; i += NGT) { const float lam = kp->lru_lam[i]; TAB[TB_SP8 + i] = 8.0f * 1.4426950408889634f * log1pf(expf(-lam)); }
        for (int i = gt; i < NG; i += NGT) { const int hb = i >> 10, gate = (i >> 8) & 3, j = i & 255, dir = gate >> 1, isx = gate & 1;
            TAB[TB_GBIAS + i] = (isx ? kp->lru_bx : kp->lru_ba)[(dir * 16 + hb) * 256 + j]; }
        for (int i = gt; i < D; i += NGT) { TAB[TB_NORM1 + i] = kp->norm1[i]; TAB[TB_NORM2 + i] = kp->norm2[i]; TAB[TB_NORMF + i] = kp->norm_f[i]; TAB[TB_CONVB + i] = kp->conv_b[i]; }
        for (int i = gt; i < 4 * D; i += NGT) TAB[TB_CONVW + i] = kp->conv_w[i];
        for (int i = gt; i < 1024; i += NGT) TAB[TB_QNORM + i] = kp->q_norm[i];
        for (int i = gt; i < 512; i += NGT) TAB[TB_KVNORM + i] = kp->kv_norm[i];
        { bf16_t* XN = (bf16_t*)(ws + WS_XN);
          for (int m = gw; m < MG; m += NGW) rms_row_to_bf16(kp->x_prompt + (size_t)m * D, kp->norm1, nullptr, lane, ws + WS_XN8 + (size_t)m * D); }
        SEAM(0);
    }

    for (int grp = 0; grp < NGROUP; ++grp) {
        const int pb = 1 + grp * 7;
        if (hi <= pb || lo >= pb + 7) continue;
        const int L = grp == 0 ? SEQ_P : SEQ_S;
#define XG() (grp == 0 ? kp->x_prompt : kp->x_sample + (size_t)(grp - 1) * MG * D)
#define OUTG() (kp->out + (size_t)grp * MG * D)
#define KVB() ((bf16_t*)OUTG())

        if (EN(2) && IN(pb + 0)) {
            PHASE_BEGIN();
            {
              pg8::Gemm g{(bf16_t*)(ws + WS_XN8), (bf16_t*)(ws + WS_WIN), MG, NZ, D / 2, D / 2, D / 2, 0, 0}; pg8::StaticOrder S; S.init(MG, NZ, G, bx);
              pg8::EpiZ E{(bf16_t*)(ws + WS_Z), NZ, 0, 1.0f / (XN_QS * WIN_QS)};
              pg8::gemm_phase<pg8::EpiZ, pg8::StaticOrder, true, true, 2>(lds + RING_OFF, g, S, E, tid); }
            SEAM(pb + 0);
        }
        if (EN(3) && IN(pb + 1)) {
            PHASE_BEGIN();
            const bf16_t* Z = (const bf16_t*)(ws + WS_Z); bf16_t* XC = (bf16_t*)(ws + WS_XC); bf16_t* CQN = (bf16_t*)(ws + WS_CQN); bf16_t* CKVN = (bf16_t*)(ws + WS_CKVN); bf16_t* KPE = (bf16_t*)(ws + WS_KPE);
            const f32x2* ROPE = (const f32x2*)(ws + WS_ROPE);
            for (int mb = gw; mb < MG / 4; mb += NGW) {
              const int m0 = mb * 4, pos0 = m0 % L;
#pragma unroll 1
              for (int j = 0; j < 8; ++j) { const int ch = lane * 8 + 512 * j;
                  float wgt[4][8], bia[8];
                  { const f32x4 b0 = *(const f32x4*)(TAB + TB_CONVB + ch), b1 = *(const f32x4*)(TAB + TB_CONVB + ch + 4);
                    bia[0] = b0.x; bia[1] = b0.y; bia[2] = b0.z; bia[3] = b0.w; bia[4] = b1.x; bia[5] = b1.y; bia[6] = b1.z; bia[7] = b1.w; }
#pragma unroll
                  for (int k = 0; k < 4; ++k) { const f32x4 w0 = *(const f32x4*)(TAB + TB_CONVW + k * D + ch), w1 = *(const f32x4*)(TAB + TB_CONVW + k * D + ch + 4);
                      wgt[k][0] = w0.x; wgt[k][1] = w0.y; wgt[k][2] = w0.z; wgt[k][3] = w0.w; wgt[k][4] = w1.x; wgt[k][5] = w1.y; wgt[k][6] = w1.z; wgt[k][7] = w1.w; }
                  u32x4 xr[7];
#pragma unroll
                  for (int i = 0; i < 7; ++i) { const int pp = pos0 + i - 2, pc = pp < 0 ? 0 : (pp >= L ? L - 1 : pp);
                      const u32x4 t_ = *(const u32x4*)(Z + (size_t)(m0 - pos0 + pc) * NZ + ch); const unsigned k_ = (pp >= 0 && pp < L) ? 0xffffffffu : 0u;
                      xr[i] = (u32x4){t_.x & k_, t_.y & k_, t_.z & k_, t_.w & k_}; }
#pragma unroll
                  for (int r = 0; r < 4; ++r) { float a[8];
#pragma unroll
                      for (int e = 0; e < 8; ++e) a[e] = bia[e];
#pragma unroll
                      for (int k = 0; k < 4; ++k) { const u32x4 xv = xr[r + k];
                          a[0] += wgt[k][0] * bf_lo(xv.x); a[1] += wgt[k][1] * bf_hi(xv.x); a[2] += wgt[k][2] * bf_lo(xv.y); a[3] += wgt[k][3] * bf_hi(xv.y);
                          a[4] += wgt[k][4] * bf_lo(xv.z); a[5] += wgt[k][5] * bf_hi(xv.z); a[6] += wgt[k][6] * bf_lo(xv.w); a[7] += wgt[k][7] * bf_hi(xv.w); }
                      u32x4 o; o.x = cvt_pk_bf16(a[0], a[1]); o.y = cvt_pk_bf16(a[2], a[3]); o.z = cvt_pk_bf16(a[4], a[5]); o.w = cvt_pk_bf16(a[6], a[7]);
                      *(u32x4*)(XC + (size_t)(m0 + r) * D + ch) = o; } }
#pragma unroll 1
              for (int r4 = 0; r4 < 4; ++r4) { const int m = m0 + r4, pos = pos0 + r4;
                const bf16_t* zr = Z + (size_t)m * NZ;
                {
                    f32x4 v[4]; float s = 0.f;
#pragma unroll
                    for (int j = 0; j < 2; ++j) { pg8::unpack8(*(const u32x4*)(zr + ZC_CQ + lane * 8 + 512 * j), v[2 * j], v[2 * j + 1]); }
#pragma unroll
                    for (int j = 0; j < 4; ++j) s += (v[j].x * v[j].x + v[j].y * v[j].y) + (v[j].z * v[j].z + v[j].w * v[j].w);
                    const float rstd = 1.0f / sqrtf(wave_sum(s) * (1.f / 1024.f) + EPS);
#pragma unroll
                    for (int j = 0; j < 2; ++j) { const int c = lane * 8 + 512 * j; const f32x4 g0 = *(const f32x4*)(TAB + TB_QNORM + c), g1 = *(const f32x4*)(TAB + TB_QNORM + c + 4);
                        const f32x4 y0 = v[2 * j] * rstd * g0, y1 = v[2 * j + 1] * rstd * g1;
                        *(u32x2*)((unsigned char*)CQN + (size_t)m * 1024 + c) = (u32x2){pk4_fp8(y0.x, y0.y, y0.z, y0.w), pk4_fp8(y1.x, y1.y, y1.z, y1.w)}; }
                }
                {
                    f32x4 v0, v1; pg8::unpack8(*(const u32x4*)(zr + ZC_CKV + lane * 8), v0, v1);
                    float s = (v0.x * v0.x + v0.y * v0.y) + (v0.z * v0.z + v0.w * v0.w) + (v1.x * v1.x + v1.y * v1.y) + (v1.z * v1.z + v1.w * v1.w);
                    const float rstd = 1.0f / sqrtf(wave_sum(s) * (1.f / 512.f) + EPS);
                    const int c = lane * 8; const f32x4 g0 = *(const f32x4*)(TAB + TB_KVNORM + c), g1 = *(const f32x4*)(TAB + TB_KVNORM + c + 4);
                    const f32x4 y0 = v0 * rstd * g0, y1 = v1 * rstd * g1;
                    *(u32x2*)((unsigned char*)CKVN + (size_t)m * 512 + c) = (u32x2){pk4_fp8(y0.x, y0.y, y0.z, y0.w), pk4_fp8(y1.x, y1.y, y1.z, y1.w)};
                }
                if (lane < 32) {
                    const float x1 = __uint_as_float(((unsigned)zr[ZC_KR + lane]) << 16), x2 = __uint_as_float(((unsigned)zr[ZC_KR + 32 + lane]) << 16);
                    const f32x2 cs = ROPE[(size_t)pos * 32 + lane];
                    ((unsigned char*)KPE)[(size_t)m * 64 + lane] = (unsigned char)(__builtin_amdgcn_cvt_pk_fp8_f32(x1 * cs.x - x2 * cs.y, 0.f, 0, false) & 0xff);
                    ((unsigned char*)KPE)[(size_t)m * 64 + 32 + lane] = (unsigned char)(__builtin_amdgcn_cvt_pk_fp8_f32(x1 * cs.y + x2 * cs.x, 0.f, 0, false) & 0xff);
                }
              }
            }
            SEAM(pb + 1);
        }
        if (EN(4) && IN(pb + 2)) {
            PHASE_BEGIN();
            { pg8::Gemm g{(bf16_t*)(ws + WS_XC), (bf16_t*)(ws + WS_WG), MG, NG, 256, D, 256, 2, 256}; pg8::StaticOrder S; S.init(MG, NG, G, bx);
              pg8::EpiLru E{(bf16_t*)(ws + WS_G), (const bf16_t*)(ws + WS_XC), TAB + TB_GBIAS, TAB + TB_SP8, (f32x2*)(ws + WS_SUM), (LAS f32x2*)(lds + LDSCTL_OFF + 2048)};
              pg8::gemm_phase<pg8::EpiLru, pg8::StaticOrder, true, false, 0, true>(lds + RING_OFF, g, S, E, tid); }
            { pg8::Gemm g{(bf16_t*)(ws + WS_CQN), (bf16_t*)(ws + WS_WQ), MG, NQ, 512, 512, 512, 0, 0}; pg8::StaticOrder S; S.init(MG, NQ, G, bx);
              pg8::EpiBf16<0> E{(bf16_t*)(ws + WS_Q), NQ, 1.0f / 64.0f};
              pg8::gemm_phase<pg8::EpiBf16<0>, pg8::StaticOrder, true, true, 1>(lds + RING_OFF, g, S, E, tid); }
            { pg8::Gemm g{(bf16_t*)(ws + WS_CKVN), (bf16_t*)(ws + WS_WKV), MG, NKV, 256, 256, 256, 0, 0}; pg8::StaticOrder S; S.init(MG, NKV, G, bx);
              pg8::EpiKV E{(unsigned char*)KVB(), (unsigned char*)KVB() + (size_t)MG * 4096, 1.0f / 64.0f};
              pg8::gemm_phase<pg8::EpiKV, pg8::StaticOrder, true, false, 1>(lds + RING_OFF, g, S, E, tid); }
            SEAM(pb + 2);
        }
        if (EN(6) && IN(pb + 3)) {
            PHASE_BEGIN();
            const bf16_t* GB = (const bf16_t*)(ws + WS_G); const f32x2* SUM = (const f32x2*)(ws + WS_SUM);
            const bf16_t* Z = (const bf16_t*)(ws + WS_Z); bf16_t* ALRU = (bf16_t*)(ws + WS_XN);
            const int ncs = L / CHUNK;
            for (int u = vcu; u < NCHUNK * 4; u += G) {
                const int c = u >> 2, cb = u & 3, ch = cb * 1024 + tid * 2, hb = ch >> 8, jj = ch & 255, t0 = c * CHUNK;
                const int c_lo = (c / ncs) * ncs, c_hi = c_lo + ncs;
                const bf16_t* gp = GB + (size_t)hb * 1024 + jj; const bf16_t* yp = Z + ZC_Y + ch; bf16_t* ap = ALRU + ch;
                float hf0 = 0.f, hf1 = 0.f, hr0 = 0.f, hr1 = 0.f;
#pragma unroll 4
                for (int cc = c_lo; cc < c; ++cc) { const f32x4 s = *(const f32x4*)(SUM + ((size_t)(cc * 2 + 0) * D + ch)); hf0 = s.x * hf0 + s.y; hf1 = s.z * hf1 + s.w; }
#pragma unroll 4
                for (int cc = c_hi - 1; cc > c; --cc) { const f32x4 s = *(const f32x4*)(SUM + ((size_t)(cc * 2 + 1) * D + ch)); hr0 = s.x * hr0 + s.y; hr1 = s.z * hr1 + s.w; }
                { unsigned wn[8][2], wc_[8][2];
#define P6F_LOAD(W, g_) _Pragma("unroll") for (int s_ = 0; s_ < 8; ++s_) { const size_t tf_ = (size_t)(t0 + 8 * (g_) + s_); W[s_][0] = *(const unsigned*)(gp + tf_ * NG); W[s_][1] = *(const unsigned*)(gp + tf_ * NG + 256); }
                  P6F_LOAD(wn, 0);
#pragma unroll 1
                  for (int g8 = 0; g8 < CHUNK / 8; ++g8) {
#pragma unroll
                    for (int s_ = 0; s_ < 8; ++s_) { wc_[s_][0] = wn[s_][0]; wc_[s_][1] = wn[s_][1]; }
                    if (g8 + 1 < CHUNK / 8) { P6F_LOAD(wn, g8 + 1); }
#pragma unroll
                    for (int s_ = 0; s_ < 8; ++s_) { const size_t tf = (size_t)(t0 + 8 * g8 + s_);
                        hf0 = __builtin_amdgcn_exp2f(bf_lo(wc_[s_][0])) * hf0 + bf_lo(wc_[s_][1]); hf1 = __builtin_amdgcn_exp2f(bf_hi(wc_[s_][0])) * hf1 + bf_hi(wc_[s_][1]);
                        *(unsigned*)(ap + tf * D) = cvt_pk_bf16(hf0, hf1); }
                  }
#undef P6F_LOAD
                }
                { unsigned wn[4][4], wc_[4][4];
#define P6R_LOAD(W, g_) _Pragma("unroll") for (int s_ = 0; s_ < 4; ++s_) { const size_t tr_ = (size_t)(t0 + CHUNK - 1 - 4 * (g_) - s_); W[s_][0] = *(const unsigned*)(gp + tr_ * NG + 512); W[s_][1] = *(const unsigned*)(gp + tr_ * NG + 768); \
                    W[s_][2] = *(const unsigned*)(yp + tr_ * NZ); W[s_][3] = *(const unsigned*)(ap + tr_ * D); }
                  P6R_LOAD(wn, 0);
#pragma unroll 1
                  for (int g4 = 0; g4 < CHUNK / 4; ++g4) {
#pragma unroll
                    for (int s_ = 0; s_ < 4; ++s_)
#pragma unroll
                        for (int q_ = 0; q_ < 4; ++q_) wc_[s_][q_] = wn[s_][q_];
                    if (g4 + 1 < CHUNK / 4) { P6R_LOAD(wn, g4 + 1); }
#pragma unroll
                    for (int s_ = 0; s_ < 4; ++s_) { const size_t tr = (size_t)(t0 + CHUNK - 1 - 4 * g4 - s_);
                        hr0 = __builtin_amdgcn_exp2f(bf_lo(wc_[s_][0])) * hr0 + bf_lo(wc_[s_][1]); hr1 = __builtin_amdgcn_exp2f(bf_hi(wc_[s_][0])) * hr1 + bf_hi(wc_[s_][1]);
                        *(unsigned*)(ap + tr * D) = cvt_pk_bf16((bf_lo(wc_[s_][3]) + hr0) * bf_lo(wc_[s_][2]), (bf_hi(wc_[s_][3]) + hr1) * bf_hi(wc_[s_][2])); }
                  }
#undef P6R_LOAD
                }
            }
            {
                const unsigned char* V8 = (const unsigned char*)KVB() + (size_t)MG * 4096; unsigned char* VP = (unsigned char*)KVB() + (size_t)MG * 8192;
                for (int idx = vcu * (NWAVES * 64) + tid; idx < (MG / 64) * 2048; idx += G * NWAVES * 64) {
                    const int T = idx >> 11, hi_ = (idx >> 10) & 1, cg = idx & 1023, h = cg >> 5, cl = (cg & 31) * 4;
                    const unsigned char* src = V8 + (size_t)(T * 64 + 4 * hi_) * 4096 + 4 * cg;
                    int wa[16], wb[16];
#pragma unroll
                    for (int r = 0; r < 16; ++r) { const int k_ = (r & 3) + 8 * (r >> 2); wa[r] = *(const int*)(src + (size_t)k_ * 4096); wb[r] = *(const int*)(src + (size_t)(32 + k_) * 4096); }
                    unsigned char* dst = VP + ((size_t)h * (MG / 64) + T) * 8192;
#define V6_COL(i) { f32x16 va_, vb_; \
                        _Pragma("unroll") for (int r = 0; r < 16; ++r) { va_[r] = att::VSC6 * __builtin_amdgcn_cvt_f32_fp8(wa[r], i); vb_[r] = att::VSC6 * __builtin_amdgcn_cvt_f32_fp8(wb[r], i); } \
                        att::v6i w6; asm("v_cvt_scalef32_2xpk16_fp6_f32 %0, %1, %2, 1.0" : "=&v"(w6) : "v"(va_), "v"(vb_)); const int c = cl + i, sw_ = (c >> 2) & 3; \
                        *(u32x4*)(dst + c * 64 + (((2 * hi_) ^ sw_) << 4)) = (u32x4){(unsigned)w6[0], (unsigned)w6[1], (unsigned)w6[2], (unsigned)w6[3]}; \
                        *(u32x4*)(dst + c * 64 + (((2 * hi_ + 1) ^ sw_) << 4)) = (u32x4){(unsigned)w6[4], (unsigned)w6[5], 0u, 0u}; }
                    V6_COL(0) V6_COL(1) V6_COL(2) V6_COL(3)
#undef V6_COL
                }
            }
            SEAM(pb + 3);
        }
        if (EN(7) && IN(pb + 4)) {
            PHASE_BEGIN();
            const bf16_t* QB = (const bf16_t*)(ws + WS_Q); const unsigned char* KPE = (const unsigned char*)(ws + WS_KPE); unsigned char* OB = (unsigned char*)(ws + WS_O);
            const unsigned char* KN8 = (const unsigned char*)KVB(); const unsigned char* VP = (const unsigned char*)KVB() + (size_t)MG * 8192;
            const f32x2* ROPE = (const f32x2*)(ws + WS_ROPE);
            const int nqb = L / 256;
            for (int u = vcu; u < (MG / 256) * 32; u += G) {
                const int sh = u / nqb, qb = u % nqb, sq = sh >> 5, h = sh & 31;
                const size_t row_s = (size_t)sq * L, row_q = row_s + (size_t)qb * 256;
                att::attn_unit(QB + row_q * NQ + h * 192, KN8 + row_s * 4096 + h * 128, VP + ((size_t)h * (MG / 4) + row_s / 4) * 512, KPE + row_s * 64,
                               OB + row_q * D + h * 128, ROPE, qb * 256, L, (LAS char*)(lds + RING_OFF), tid);
            }
            { const bf16_t* AL = (const bf16_t*)(ws + WS_XN); unsigned char* A8 = ws + WS_O + 32 * MiB; float* ROWS = (float*)(ws + WS_SUM);
              for (int m = gw; m < MG; m += NGW) {
                  float v_[64];
#pragma unroll
                  for (int j = 0; j < 8; ++j) { const u32x4 w = *(const u32x4*)(AL + (size_t)m * D + lane * 64 + j * 8);
                      v_[8 * j] = bf_lo(w.x); v_[8 * j + 1] = bf_hi(w.x); v_[8 * j + 2] = bf_lo(w.y); v_[8 * j + 3] = bf_hi(w.y); v_[8 * j + 4] = bf_lo(w.z); v_[8 * j + 5] = bf_hi(w.z); v_[8 * j + 6] = bf_lo(w.w); v_[8 * j + 7] = bf_hi(w.w); }
                  fwht64(v_);
                  float mx = 0.f;
#pragma unroll
                  for (int i = 0; i < 64; ++i) mx = fmaxf(mx, fabsf(v_[i]));
                  mx = wave_max(mx);
                  const float qs = mx > 0.f ? 127.0f / mx : 1.0f;
#pragma unroll
                  for (int j = 0; j < 4; ++j) *(u32x4*)(A8 + (size_t)m * D + lane * 64 + j * 16) =
                      (u32x4){pk4_i8(v_[16 * j], v_[16 * j + 1], v_[16 * j + 2], v_[16 * j + 3], qs), pk4_i8(v_[16 * j + 4], v_[16 * j + 5], v_[16 * j + 6], v_[16 * j + 7], qs),
                              pk4_i8(v_[16 * j + 8], v_[16 * j + 9], v_[16 * j + 10], v_[16 * j + 11], qs), pk4_i8(v_[16 * j + 12], v_[16 * j + 13], v_[16 * j + 14], v_[16 * j + 15], qs)};
                  if (lane == 0) ROWS[m] = 1.0f / qs;
              } }
            SEAM(pb + 4);
        }
        if (EN(9) && IN(pb + 5)) {
            PHASE_BEGIN();
            {
              pg8::Gemm g{(bf16_t*)(ws + WS_O + 32 * MiB), (bf16_t*)(ws + WS_WLP), MG, D, D / 2, D / 2, D / 2, 0, 0}; pg8::StaticOrder S; S.init(MG, D, G, bx);
              pg8::EpiGate<false> E{(bf16_t*)(ws + WS_XC), D, (const bf16_t*)(ws + WS_Z) + ZC_GATE, NZ, nullptr, 0, 1.0f / WSQ_QS, 0.f, (const float*)(ws + WS_SUM)};
              pg8::gemm_phase<pg8::EpiGate<false>, pg8::StaticOrder, true, true, 2>(lds + RING_OFF, g, S, E, tid); }
            pg8::Gemm g{(bf16_t*)(ws + WS_O), (bf16_t*)(ws + WS_WMP), MG, D, D / 2, D / 2, D / 2, 0, 0}; pg8::StaticOrder S; S.init(MG, D, G, bx);
            pg8::EpiGate<true, true> E{(bf16_t*)(ws + WS_XN), D, (const bf16_t*)(ws + WS_Z) + ZC_GATE + D, NZ, (const bf16_t*)(ws + WS_XC), D, 1.0f / (64.0f * att::OSCALE), MERGED_QS, nullptr};
            pg8::gemm_phase<pg8::EpiGate<true, true>, pg8::StaticOrder, true, true, 1>(lds + RING_OFF, g, S, E, tid);
            SEAM(pb + 5);
        }
        if (EN(10) && IN(pb + 6)) {
            PHASE_BEGIN();
            pg8::Gemm g{(bf16_t*)(ws + WS_XN), (bf16_t*)(ws + WS_WO), MG, D, D / 2, D / 2, D / 2, 0, 0}; pg8::StaticOrder S; S.init(MG, D, G, bx);
            pg8::EpiResBf<false> E{XG(), 0, 0, (bf16_t*)OUTG(), 0, 0, D, 1.0f / (MERGED_QS * WSQ_QS)};
            pg8::gemm_phase<pg8::EpiResBf<false>, pg8::StaticOrder, true, true, 2>(lds + RING_OFF, g, S, E, tid);
            if (grp + 1 < NGROUP) {
                const float* xn_src = kp->x_sample + (size_t)grp * MG * D; bf16_t* XN = (bf16_t*)(ws + WS_XN);
                for (int m = gw; m < MG; m += NGW) rms_row_to_bf16(xn_src + (size_t)m * D, TAB + TB_NORM1, nullptr, lane, ws + WS_XN8 + (size_t)m * D);
            }
            SEAM(pb + 6);
        }
    }
    {
        constexpr int pm_ = 1 + NGROUP * 7;
        if (EN(11) && IN(pm_ + 0)) {
            PHASE_BEGIN();
            const bf16_t* hb = (const bf16_t*)kp->out; bf16_t* N2 = (bf16_t*)(ws + WS_N2ALL);
            for (int m = gw; m < MTOT; m += NGW) rms_row_from_bf16(hb + (size_t)(m >> 13) * ((size_t)MG * D * 2) + (size_t)(m & (MG - 1)) * D, TAB + TB_NORM2, N2 + (size_t)m * D, ws + WS_N2I8 + (size_t)m * D, nullptr, lane);
            SEAM(pm_ + 0);
        }
        if (EN(12) && IN(pm_ + 1)) {
            PHASE_BEGIN();
            {
              pg8::Gemm g{(bf16_t*)(ws + WS_N2I8), (bf16_t*)(ws + WS_WUP), MTOT, NUP8, D / 2, D / 2, D / 2, 0, 0}; pg8::StaticOrder S; S.init(MTOT, NUP8, G, bx);
              pg8::EpiBf16<1> E{(bf16_t*)(ws + WS_HALL), DFF, 1.0f / (XN_QS * WSQ_QS)};
              pg8::gemm_phase<pg8::EpiBf16<1>, pg8::StaticOrder, true, true, 2>(lds + RING_OFF, g, S, E, tid); }
            {
              pg8::Gemm g{(bf16_t*)(ws + WS_N2ALL), (bf16_t*)(ws + WS_WUPB), MTOT, DFF - NUP8, D, D, D, 0, 0}; pg8::StaticOrder S; S.init(MTOT, DFF - NUP8, G, bx);
              pg8::EpiBf16<1> E{(bf16_t*)(ws + WS_HALL) + NUP8, DFF, 1.0f};
              pg8::gemm_phase<pg8::EpiBf16<1>, pg8::StaticOrder, true, true>(lds + RING_OFF, g, S, E, tid); }
            SEAM(pm_ + 1);
        }
        if (EN(13) && IN(pm_ + 2)) {
            PHASE_BEGIN();
            pg8::Gemm g{(bf16_t*)(ws + WS_HALL), (bf16_t*)(ws + WS_WDN), MTOT, D, DFF, DFF, DFF, 0, 0}; pg8::StaticOrder S; S.init(MTOT, D, G, bx, 1);
            pg8::EpiResBf<true> E{kp->out, MG, (size_t)MG * D * 2, (bf16_t*)(ws + WS_N2ALL), 0, 0, D, 1.0f};
            pg8::gemm_phase<pg8::EpiResBf<true>, pg8::StaticOrder, true, true>(lds + RING_OFF, g, S, E, tid);
            SEAM(pm_ + 2);
        }
        if (EN(14) && IN(pm_ + 3)) {
            PHASE_BEGIN();
            float* og = kp->out; const bf16_t* X2 = (const bf16_t*)(ws + WS_N2ALL);
            for (int m = gw; m < MTOT; m += NGW) rms_row_from_bf16(X2 + (size_t)m * D, TAB + TB_NORMF, nullptr, nullptr, og + (size_t)m * D, lane);
            SEAM(pm_ + 3);
        }
    }
#undef IN
#undef SEAM
}

constexpr int NPHASES = 1 + NGROUP * 7 + 4;
extern "C" void kernel_launch(void* const* d_in, const int* in_sizes, int n_in, void* d_out, int out_size, void* d_ws, size_t ws_size, hipStream_t stream) {
    static int grid = 0;
    if (grid == 0) {
        if (n_in != 22 || out_size != MTOT * D || ws_size < WS_END) { fprintf(stderr, "kernel_launch: shape/workspace mismatch (n_in %d out %d ws %zu need %zu)\n", n_in, out_size, ws_size, (size_t)WS_END); grid = -1; return; }
        int dev = 0, cus = 0;
        if (hipGetDevice(&dev) != hipSuccess || hipDeviceGetAttribute(&cus, hipDeviceAttributeMultiprocessorCount, dev) != hipSuccess) { grid = -1; return; }
        if (hipFuncSetAttribute((const void*)fwd, hipFuncAttributeMaxDynamicSharedMemorySize, LDS_BYTES) != hipSuccess) { fprintf(stderr, "kernel_launch: hipFuncSetAttribute failed\n"); grid = -1; return; }
        int per_cu = 0;
        if (hipOccupancyMaxActiveBlocksPerMultiprocessor(&per_cu, (const void*)fwd, NWAVES * 64, LDS_BYTES) != hipSuccess || per_cu < 1) fprintf(stderr, "kernel_launch: occupancy query says %d\n", per_cu);
        (void)hipGetLastError();
        grid = cus;
    }
    if (grid < 0) return;
    (void)hipMemsetAsync((char*)d_ws + WS_CTL, 0, CTL_ZERO_BYTES, stream);
    Args a{};
    a.x_prompt = (const float*)d_in[0]; a.x_sample = (const float*)d_in[1]; a.norm1 = (const float*)d_in[2]; a.w_in = (const float*)d_in[3]; a.conv_w = (const float*)d_in[4]; a.conv_b = (const float*)d_in[5];
    a.lru_wa = (const float*)d_in[6]; a.lru_ba = (const float*)d_in[7]; a.lru_wx = (const float*)d_in[8]; a.lru_bx = (const float*)d_in[9]; a.lru_lam = (const float*)d_in[10];
    a.q_norm = (const float*)d_in[11]; a.w_q_up = (const float*)d_in[12]; a.kv_norm = (const float*)d_in[13]; a.w_kv_up = (const float*)d_in[14]; a.w_lru_proj = (const float*)d_in[15];
    a.w_mla_proj = (const float*)d_in[16]; a.w_out = (const float*)d_in[17]; a.norm2 = (const float*)d_in[18]; a.w_up = (const float*)d_in[19]; a.w_down = (const float*)d_in[20]; a.norm_f = (const float*)d_in[21];
    a.out = (float*)d_out; a.ws = (unsigned char*)d_ws;
#if MK_N_LAUNCHES == 0
#ifdef PROBE_PHASE
    { int lo_[16], hi_[16], n = 0, start = 0;
      if (PROBE_PHASE == 0) { lo_[n] = 0; hi_[n++] = 1; lo_[n] = 0; hi_[n++] = 1; start = 1; }
      else if (PROBE_PHASE <= 7) for (int g = 0; g < NGROUP; ++g) { const int k = 1 + g * 7 + (PROBE_PHASE - 1); lo_[n] = start; hi_[n++] = k + PROBE_LEN; lo_[n] = k; hi_[n++] = k + PROBE_LEN; start = k + PROBE_LEN; }
      else { const int k = 1 + NGROUP * 7 + (PROBE_PHASE - 8); lo_[n] = start; hi_[n++] = k + PROBE_LEN; lo_[n] = k; hi_[n++] = k + PROBE_LEN; start = k + PROBE_LEN; }
      if (start < NPHASES) { lo_[n] = start; hi_[n++] = NPHASES; }
      for (int i = 0; i < n; ++i) { a.ph_lo = lo_[i]; a.ph_hi = hi_[i]; a.li = i; hipLaunchKernelGGL(fwd, dim3(grid), dim3(NWAVES * 64), LDS_BYTES, stream, a); } }
#else
    a.ph_lo = 0; a.ph_hi = NPHASES; a.li = 0;
    hipLaunchKernelGGL(fwd, dim3(grid), dim3(NWAVES * 64), LDS_BYTES, stream, a);
#endif
#else
    for (int p = 0; p < NPHASES; ++p) { a.ph_lo = p; a.ph_hi = p + 1; hipLaunchKernelGGL(fwd, dim3(grid), dim3(NWAVES * 64), LDS_BYTES, stream, a); }
#endif
    const hipError_t le = hipPeekAtLastError();
    if (le != hipSuccess) fprintf(stderr, "kernel_launch: launch failed: %s\n", hipGetErrorName(le));
}
```

```cpp
#include <hip/hip_runtime.h>
#include <cstdio>
#include <cstdint>

#ifndef MK_N_LAUNCHES
#define MK_N_LAUNCHES 0
#endif
#ifndef NAIVE_GEMM
#define NAIVE_GEMM 0
#endif

#define GAS __attribute__((address_space(1)))
#define LAS __attribute__((address_space(3)))
typedef unsigned short bf16_t;
typedef short bf16x8 __attribute__((ext_vector_type(8)));
typedef short s16x4 __attribute__((ext_vector_type(4)));
typedef float f32x2 __attribute__((ext_vector_type(2)));
typedef float f32x4 __attribute__((ext_vector_type(4)));
typedef float f32x16 __attribute__((ext_vector_type(16)));
typedef unsigned u32x2 __attribute__((ext_vector_type(2)));
typedef unsigned u32x4 __attribute__((ext_vector_type(4)));

__device__ __forceinline__ unsigned cvt_pk_bf16(float lo, float hi) { unsigned r; asm volatile("v_cvt_pk_bf16_f32 %0, %1, %2" : "=v"(r) : "v"(lo), "v"(hi)); return r; }
__device__ __forceinline__ unsigned pk4_fp8(float a, float b, float c, float d) { unsigned w;
    asm("v_cvt_pk_fp8_f32 %0, %1, %2" : "=v"(w) : "v"(a), "v"(b)); asm("v_cvt_pk_fp8_f32 %0, %1, %2 op_sel:[0,0,1]" : "+v"(w) : "v"(c), "v"(d)); return w; }
constexpr float XN_QS = 127.0f / 4.0f;
constexpr float WIN_QS = 127.0f * 64.0f / 4.0f;
constexpr float WSQ_QS = 127.0f * 64.0f / 4.0f;
constexpr float MERGED_QS = 127.0f / 1.2f;
__device__ __forceinline__ unsigned pk4_i8(float a, float b, float c, float d, float qs) {
    const int q0 = (int)__builtin_rintf(fminf(fmaxf(a * qs, -127.f), 127.f)), q1 = (int)__builtin_rintf(fminf(fmaxf(b * qs, -127.f), 127.f));
    const int q2 = (int)__builtin_rintf(fminf(fmaxf(c * qs, -127.f), 127.f)), q3 = (int)__builtin_rintf(fminf(fmaxf(d * qs, -127.f), 127.f));
    return ((unsigned)q0 & 0xffu) | (((unsigned)q1 & 0xffu) << 8) | (((unsigned)q2 & 0xffu) << 16) | ((unsigned)q3 << 24);
}
__device__ __forceinline__ float bf_lo(unsigned w) { return __uint_as_float(w << 16); }
__device__ __forceinline__ float bf_hi(unsigned w) { return __uint_as_float(w & 0xffff0000u); }
__device__ __forceinline__ float fast_sigmoid(float v) { return __builtin_amdgcn_rcpf(1.0f + __builtin_amdgcn_exp2f(-1.4426950408889634f * v)); }
__device__ __forceinline__ float gelu_tanh(float v) {
    const float y = 1.5957691216057308f * (v + 0.044715f * v * v * v);
    return v * fast_sigmoid(y);
}

constexpr int D = 4096, MG = 8192, NGROUP = 3, MTOT = 24576;
constexpr int SEQ_P = 8192, SEQ_S = 2048;
constexpr int NZ = 18176, NZ_BF = 8192, NZ_F8 = 9984;
constexpr int ZC_Y = 4096, ZC_CQ = 8192, ZC_CKV = 9216, ZC_KR = 9728, ZC_GATE = 9984;
constexpr int IN_COLS = 17984, SRC_GATE = 9792;
constexpr int NQ = 6144, NKV = 8192, DFF = 16384, NG = 16384;
constexpr float EPS = 1e-6f;
constexpr int CHUNK = 128, NCHUNK = MG / CHUNK;

constexpr size_t MiB = 1u << 20;
constexpr size_t WS_CTL = 0, CTL_ZERO_BYTES = 1 * MiB;
constexpr size_t WS_ROPE = 1 * MiB;
constexpr size_t WS_TAB = 3 * MiB;
constexpr int NUP8 = 8192;
constexpr size_t WS_WUP = 4 * MiB;
constexpr size_t WS_WUPB = WS_WUP + (size_t)NUP8 * 4096;
constexpr size_t WS_WDN = WS_WUP + 128 * MiB;
constexpr size_t WS_WIN = WS_WDN + 128 * MiB;
constexpr size_t WS_XN8 = WS_WIN + 78 * MiB;
constexpr size_t WS_WG = WS_XN8 + 64 * MiB;
constexpr size_t WS_WQ = WS_WG + 8 * MiB;
constexpr size_t WS_WKV = WS_WQ + 12 * MiB;
constexpr size_t WS_WLP = WS_WKV + 8 * MiB;
constexpr size_t WS_WMP = WS_WLP + 32 * MiB;
constexpr size_t WS_WO = WS_WMP + 32 * MiB;
constexpr size_t WS_XN = WS_WO + 32 * MiB;
constexpr size_t WS_Z = WS_XN + 64 * MiB;
constexpr size_t WS_XC = WS_Z + 284 * MiB;
constexpr size_t WS_CQN = WS_XC + 64 * MiB;
constexpr size_t WS_CKVN = WS_CQN + 16 * MiB;
constexpr size_t WS_KPE = WS_CKVN + 8 * MiB;
constexpr size_t WS_SUM = WS_KPE + 1 * MiB;
constexpr size_t WS_G = WS_SUM + 4 * MiB;
constexpr size_t WS_Q = WS_G + 256 * MiB;
constexpr size_t WS_O = WS_Q + 96 * MiB;
constexpr size_t WS_END = WS_O + 64 * MiB;
constexpr size_t WS_N2ALL = WS_WIN;
constexpr size_t WS_HALL = WS_N2ALL + 192 * MiB;
constexpr size_t WS_N2I8 = WS_HALL + 768 * MiB;
static_assert(WS_N2I8 + 96 * MiB <= WS_END, "MLP-stage overlay");

constexpr int CW_TMO = 0, CW_CODE = 1, CW_DIAG = 2, CW_BAR = 4096;

namespace pg8 {
constexpr int BM = 256, BK = 64, HALF = 128, HTB = HALF * BK * 2, STAGE_BYTES = 8 * HTB, NXCD = 8, WGM = 8;
__host__ __device__ __forceinline__ int lds_byte(int r, int c) { const int st = (r >> 4) * 2 + (c >> 5), rr = r & 15, cc = c & 31, ob = rr * 64 + cc * 2; return st * 1024 + (ob ^ (((ob >> 9) & 1) << 5)); }
__host__ __device__ __forceinline__ void stage_rc(int b, int& R, int& C) { const int st = b / 1024, sb = b % 1024, swz = sb ^ (((sb >> 9) & 1) << 5); R = (st >> 1) * 16 + swz / 64; C = (st & 1) * 32 + (swz % 64) / 2; }
__host__ __device__ __forceinline__ int perm32(int rho) { const int n = rho >> 4, i = rho & 15; return 8 * (i >> 2) + 4 * n + (i & 3); }

struct Unit { int pm, pn; };
struct Gemm { const bf16_t* A; const bf16_t* Bt; int M, N, K, lda, ldb, a_pn_shift, a_pn_stride; };

struct StaticOrder {
    int nM, nN, nwg, G, c, shared16;
    __host__ __device__ void init(int M, int N, int G_, int c_, int shared16_ = 0) { nM = M / BM; nN = N / BM; nwg = nM * nN; G = G_; c = c_; shared16 = shared16_ && G_ == 256 && nN == 16 && nM % 16 == 0; }
    __host__ __device__ bool next(int i, Unit& u) const {
        const long L = (long)i * G + c; if (L >= nwg) return false;
        if (shared16) {
            const int x = c & 7, j = c >> 3;
            u.pm = 16 * i + 8 * (x >> 2) + (j & 7); u.pn = 4 * (x & 3) + (j >> 3); return true; }
        int wgid = (int)L; { const int q = nwg / NXCD, r = nwg % NXCD, xcd = wgid % NXCD, off = wgid / NXCD; wgid = (xcd < r ? xcd * (q + 1) : r * (q + 1) + (xcd - r) * q) + off; }
        const int nig = WGM * nN, gid = wgid / nig, fm = gid * WGM, gsz = (nM - fm) < WGM ? (nM - fm) : WGM;
        u.pm = fm + ((wgid % nig) % gsz); u.pn = (wgid % nig) / gsz; return true;
    }
};

__device__ __forceinline__ u32x4 pack8(const f32x4 v0, const f32x4 v1) { u32x4 w; w.x = cvt_pk_bf16(v0[0], v0[1]); w.y = cvt_pk_bf16(v0[2], v0[3]); w.z = cvt_pk_bf16(v1[0], v1[1]); w.w = cvt_pk_bf16(v1[2], v1[3]); return w; }
__device__ __forceinline__ void unpack8(const u32x4 w, f32x4& v0, f32x4& v1) { v0 = (f32x4){bf_lo(w.x), bf_hi(w.x), bf_lo(w.y), bf_hi(w.y)}; v1 = (f32x4){bf_lo(w.z), bf_hi(w.z), bf_lo(w.w), bf_hi(w.w)}; }

struct EpiZ {
    static constexpr bool PERM = true;
    bf16_t* O; int ldc; int pn_off; float scale;
    __device__ __forceinline__ void operator()(const f32x4 (&acc)[2][2][4][2], const Unit& u, int wr, int wc, int fr, int fq) const {
        const int pn = u.pn + pn_off;
        const int row0 = u.pm * BM + wr * 64 + fr, col0 = pn * BM + wc * 32 + 8 * fq;
        const int act = (pn >= 16 && pn < 32) ? 1 : (pn >= 39 ? 2 : 0);
#pragma unroll
        for (int ai = 0; ai < 2; ++ai)
#pragma unroll
            for (int m = 0; m < 4; ++m) { bf16_t* rowp = O + (size_t)(row0 + ai * HALF + m * 16) * ldc + col0;
#pragma unroll
                for (int bj = 0; bj < 2; ++bj) { f32x4 v0 = acc[ai][bj][m][0] * scale, v1 = acc[ai][bj][m][1] * scale;
                    if (act == 1) {
#pragma unroll
                        for (int j = 0; j < 4; ++j) { v0[j] = gelu_tanh(v0[j]); v1[j] = gelu_tanh(v1[j]); } }
                    else if (act == 2) {
#pragma unroll
                        for (int j = 0; j < 4; ++j) { v0[j] = fast_sigmoid(v0[j]); v1[j] = fast_sigmoid(v1[j]); } }
                    *(u32x4*)(rowp + bj * HALF) = pack8(v0, v1); } }
    }
};
template <int ACT> struct EpiBf16 {
    static constexpr bool PERM = true;
    bf16_t* O; int ldc; float scale;
    __device__ __forceinline__ void operator()(const f32x4 (&acc)[2][2][4][2], const Unit& u, int wr, int wc, int fr, int fq) const {
        const int row0 = u.pm * BM + wr * 64 + fr, col0 = u.pn * BM + wc * 32 + 8 * fq;
#pragma unroll
        for (int ai = 0; ai < 2; ++ai)
#pragma unroll
            for (int m = 0; m < 4; ++m) { bf16_t* rowp = O + (size_t)(row0 + ai * HALF + m * 16) * ldc + col0;
#pragma unroll
                for (int bj = 0; bj < 2; ++bj) { f32x4 v0 = acc[ai][bj][m][0] * scale, v1 = acc[ai][bj][m][1] * scale;
                    if (ACT == 1) {
#pragma unroll
                        for (int j = 0; j < 4; ++j) { const float a = fmaxf(v0[j], 0.f), b = fmaxf(v1[j], 0.f); v0[j] = a * a; v1[j] = b * b; } }
                    *(u32x4*)(rowp + bj * HALF) = pack8(v0, v1); } }
    }
};
struct EpiLru {
    static constexpr bool PERM = true;
    bf16_t* G; const bf16_t* XC; const float* gbias; const float* sp8l2;
    f32x2* SUM; LAS f32x2* xch;
    template <int MB> static __device__ __forceinline__ void stage(float& A, float& H, bool mine_first) {
        const float pA = __builtin_bit_cast(float, __builtin_amdgcn_ds_swizzle(__builtin_bit_cast(int, A), (MB << 10) | 0x1f));
        const float pH = __builtin_bit_cast(float, __builtin_amdgcn_ds_swizzle(__builtin_bit_cast(int, H), (MB << 10) | 0x1f));
        H = mine_first ? __builtin_fmaf(pA, H, pH) : __builtin_fmaf(A, pH, H); A *= pA;
    }
    __device__ __forceinline__ void operator()(const f32x4 (&acc)[2][2][4][2], const Unit& u, int wr, int wc, int fr, int fq) const {
        const int hb = u.pn >> 2, dir = (u.pn >> 1) & 1, half = u.pn & 1, j0 = half * 128 + wc * 32 + 8 * fq, row0 = u.pm * BM + wr * 64 + 4 * fr;
        const float* bp = gbias + hb * 1024 + (2 * dir) * 256 + j0;
        const f32x4 br0 = *(const f32x4*)(bp), br1 = *(const f32x4*)(bp + 4), bi0 = *(const f32x4*)(bp + 256), bi1 = *(const f32x4*)(bp + 260);
        const f32x4 sp0 = *(const f32x4*)(sp8l2 + dir * 4096 + hb * 256 + j0), sp1 = *(const f32x4*)(sp8l2 + dir * 4096 + hb * 256 + j0 + 4);
        const bool fwd = dir == 0;
        const bool f1 = ((fr & 1) == 0) == fwd, f2 = ((fr & 2) == 0) == fwd, f4 = ((fr & 4) == 0) == fwd, f8 = ((fr & 8) == 0) == fwd;
        float Ar[2][8], Hr[2][8];
#pragma unroll
        for (int ai = 0; ai < 2; ++ai) {
#pragma unroll
            for (int m = 0; m < 4; ++m) { const size_t row = (size_t)(row0 + ai * HALF + m);
                f32x4 x0, x1; unpack8(*(const u32x4*)(XC + row * 4096 + hb * 256 + j0), x0, x1);
                f32x4 l0, l1, u0, u1; float As[8], Hs[8];
#pragma unroll
                for (int e = 0; e < 4; ++e) {
                    { const float r = fast_sigmoid(acc[ai][0][m][0][e] + br0[e]), i = fast_sigmoid(acc[ai][1][m][0][e] + bi0[e]); const float la = -r * sp0[e], a = __builtin_amdgcn_exp2f(la);
                      l0[e] = la; u0[e] = __builtin_amdgcn_sqrtf(__builtin_fmaf(-a, a, 1.0f)) * i * x0[e]; As[e] = a; Hs[e] = u0[e]; }
                    { const float r = fast_sigmoid(acc[ai][0][m][1][e] + br1[e]), i = fast_sigmoid(acc[ai][1][m][1][e] + bi1[e]); const float la = -r * sp1[e], a = __builtin_amdgcn_exp2f(la);
                      l1[e] = la; u1[e] = __builtin_amdgcn_sqrtf(__builtin_fmaf(-a, a, 1.0f)) * i * x1[e]; As[4 + e] = a; Hs[4 + e] = u1[e]; } }
                bf16_t* gp = G + row * 16384 + hb * 1024 + (2 * dir) * 256 + j0;
                *(u32x4*)(gp) = pack8(l0, l1); *(u32x4*)(gp + 256) = pack8(u0, u1);
#pragma unroll
                for (int e = 0; e < 8; ++e) {
                    if (m == 0) { Ar[ai][e] = As[e]; Hr[ai][e] = Hs[e]; }
                    else if (fwd) { Hr[ai][e] = __builtin_fmaf(As[e], Hr[ai][e], Hs[e]); Ar[ai][e] *= As[e]; }
                    else { Hr[ai][e] = __builtin_fmaf(Ar[ai][e], Hs[e], Hr[ai][e]); Ar[ai][e] *= As[e]; } } }
#pragma unroll
            for (int e = 0; e < 8; ++e) { stage<1>(Ar[ai][e], Hr[ai][e], f1); stage<2>(Ar[ai][e], Hr[ai][e], f2); stage<4>(Ar[ai][e], Hr[ai][e], f4); stage<8>(Ar[ai][e], Hr[ai][e], f8); }
        }
        if (fr == 0) {
#pragma unroll
            for (int ai = 0; ai < 2; ++ai)
#pragma unroll
                for (int e = 0; e < 8; ++e) xch[(wr * 2 + ai) * 128 + wc * 32 + 8 * fq + e] = (f32x2){Ar[ai][e], Hr[ai][e]}; }
        asm volatile("s_waitcnt lgkmcnt(0)" ::: "memory"); __builtin_amdgcn_s_barrier(); asm volatile("" ::: "memory");
        if (wr == 0 && fr == 0) {
#pragma unroll
            for (int ai = 0; ai < 2; ++ai)
#pragma unroll
                for (int e = 0; e < 8; ++e) { const f32x2 o_ = xch[(2 + ai) * 128 + wc * 32 + 8 * fq + e];
                    const float A0 = Ar[ai][e], H0 = Hr[ai][e];
                    const float Hh = fwd ? __builtin_fmaf(o_.x, H0, o_.y) : __builtin_fmaf(A0, o_.y, H0);
                    SUM[(size_t)((2 * u.pm + ai) * 2 + dir) * 4096 + hb * 256 + j0 + e] = (f32x2){A0 * o_.x, Hh}; } }
    }
};
struct EpiKV {
    static constexpr bool PERM = true;
    unsigned char* K8; unsigned char* V; float scale;
    __device__ __forceinline__ void operator()(const f32x4 (&acc)[2][2][4][2], const Unit& u, int wr, int wc, int fr, int fq) const {
        const int row0 = u.pm * BM + wr * 64 + fr, col = u.pn * 128 + wc * 32 + 8 * fq;
#pragma unroll
        for (int ai = 0; ai < 2; ++ai)
#pragma unroll
            for (int m = 0; m < 4; ++m) { const size_t row = (size_t)(row0 + ai * HALF + m * 16);
                { const f32x4 v0 = acc[ai][0][m][0] * scale, v1 = acc[ai][0][m][1] * scale;
                  *(u32x2*)(K8 + row * 4096 + col) = (u32x2){pk4_fp8(v0[0], v0[1], v0[2], v0[3]), pk4_fp8(v1[0], v1[1], v1[2], v1[3])}; }
                { const f32x4 v0 = acc[ai][1][m][0] * scale, v1 = acc[ai][1][m][1] * scale;
                  *(u32x2*)(V + row * 4096 + col) = (u32x2){pk4_fp8(v0[0], v0[1], v0[2], v0[3]), pk4_fp8(v1[0], v1[1], v1[2], v1[3])}; } }
    }
};
template <bool ADD, bool OUT_I8 = false> struct EpiGate {
    static constexpr bool PERM = true;
    bf16_t* O; int ldc; const bf16_t* gate; int ldg; const bf16_t* add; int ldadd; float scale; float qs; const float* rowscale;
    __device__ __forceinline__ void operator()(const f32x4 (&acc)[2][2][4][2], const Unit& u, int wr, int wc, int fr, int fq) const {
        const int row0 = u.pm * BM + wr * 64 + fr, col0 = u.pn * BM + wc * 32 + 8 * fq;
#pragma unroll
        for (int ai = 0; ai < 2; ++ai)
#pragma unroll
            for (int m = 0; m < 4; ++m) { const size_t row = (size_t)(row0 + ai * HALF + m * 16); const float sc_ = rowscale ? scale * rowscale[row] : scale;
#pragma unroll
                for (int bj = 0; bj < 2; ++bj) { const int col = col0 + bj * HALF;
                    f32x4 g0, g1; unpack8(*(const u32x4*)(gate + row * ldg + col), g0, g1);
                    f32x4 v0 = acc[ai][bj][m][0] * (g0 * sc_), v1 = acc[ai][bj][m][1] * (g1 * sc_);
                    if (ADD) { f32x4 a0, a1; unpack8(*(const u32x4*)(add + row * ldadd + col), a0, a1); v0 += a0; v1 += a1; }
                    if constexpr (OUT_I8) {
                        float h_[8] = {v0[0], v0[1], v0[2], v0[3], v1[0], v1[1], v1[2], v1[3]};
#pragma unroll
                        for (int s_ = 1; s_ < 8; s_ <<= 1)
#pragma unroll
                            for (int i = 0; i < 8; ++i) if ((i & s_) == 0) { const float a = h_[i], b = h_[i | s_]; h_[i] = a + b; h_[i | s_] = a - b; }
#pragma unroll
                        for (int i = 0; i < 8; ++i) { const float p = __builtin_bit_cast(float, __builtin_amdgcn_ds_swizzle(__builtin_bit_cast(int, h_[i]), (16 << 10) | 0x1f)); h_[i] = (fq & 1) ? p - h_[i] : h_[i] + p; }
#pragma unroll
                        for (int i = 0; i < 8; ++i) { const auto rr = __builtin_amdgcn_permlane32_swap(__float_as_uint(h_[i]), __float_as_uint(h_[i]), false, false);
                            const float p = __uint_as_float((fq & 2) ? rr[0] : rr[1]); h_[i] = (fq & 2) ? p - h_[i] : h_[i] + p; }
                        const float q_ = qs * 0.17677669529663689f;
                        *(u32x2*)((unsigned char*)O + row * ldc + col) = (u32x2){pk4_i8(h_[0], h_[1], h_[2], h_[3], q_), pk4_i8(h_[4], h_[5], h_[6], h_[7], q_)}; }
                    else *(u32x4*)(O + row * ldc + col) = pack8(v0, v1); } }
    }
};
template <bool BASE_BF> struct EpiResBf {
    static constexpr bool PERM = true;
    const void* base; int base_grp_rows; size_t base_grp_stride; bf16_t* out; int out_grp_rows; size_t out_grp_stride; int ldc; float scale;
    __device__ __forceinline__ void operator()(const f32x4 (&acc)[2][2][4][2], const Unit& u, int wr, int wc, int fr, int fq) const {
        const int row0 = u.pm * BM + wr * 64 + fr, col0 = u.pn * BM + wc * 32 + 8 * fq;
#pragma unroll
        for (int ai = 0; ai < 2; ++ai)
#pragma unroll
            for (int m = 0; m < 4; ++m) { const int row = row0 + ai * HALF + m * 16;
                const size_t bo = base_grp_rows ? (size_t)(row / base_grp_rows) * base_grp_stride + (size_t)(row % base_grp_rows) * ldc : (size_t)row * ldc;
                const size_t oo = out_grp_rows ? (size_t)(row / out_grp_rows) * out_grp_stride + (size_t)(row % out_grp_rows) * ldc : (size_t)row * ldc;
#pragma unroll
                for (int bj = 0; bj < 2; ++bj) { const int col = col0 + bj * HALF;
                    f32x4 b0, b1;
                    if constexpr (BASE_BF) unpack8(*(const u32x4*)((const bf16_t*)base + bo + col), b0, b1);
                    else { b0 = *(const f32x4*)((const float*)base + bo + col); b1 = *(const f32x4*)((const float*)base + bo + col + 4); }
                    *(u32x4*)(out + oo + col) = pack8(b0 + acc[ai][bj][m][0] * scale, b1 + acc[ai][bj][m][1] * scale); } }
    }
};
struct EpiResF32 {
    static constexpr bool PERM = false;
    const float* base; float* out; int ldc; float scale;
    __device__ __forceinline__ void operator()(const f32x4 (&acc)[2][2][4][2], const Unit& u, int wr, int wc, int fr, int fq) const {
        const int row0 = u.pm * BM + wr * 64 + fr, col0 = u.pn * BM + wc * 32 + 4 * fq;
#pragma unroll
        for (int ai = 0; ai < 2; ++ai)
#pragma unroll
            for (int m = 0; m < 4; ++m) { const size_t off = (size_t)(row0 + ai * HALF + m * 16) * ldc + col0;
#pragma unroll
                for (int bj = 0; bj < 2; ++bj)
#pragma unroll
                    for (int n = 0; n < 2; ++n) { const f32x4 bs = *(const f32x4*)(base + off + bj * HALF + n * 16); *(f32x4*)(out + off + bj * HALF + n * 16) = bs + acc[ai][bj][m][n] * scale; } }
    }
};

#if NAIVE_GEMM
template <class Epi, class Sched, bool ALIGN_EPI = false, bool SP2 = false>
__device__ __forceinline__ void gemm_phase(LAS unsigned char* lds, const Gemm g, const Sched& S, const Epi& E, int tid_in) {
    const int tid = tid_in, wid = __builtin_amdgcn_readfirstlane(tid >> 6), lane = tid & 63, wr = wid >> 2, wc = wid & 3, fr = lane & 15, fq = lane >> 4;
    Unit cur;
    for (int ui = 0; S.next(ui, cur); ++ui) {
        f32x4 acc[2][2][4][2];
#pragma unroll
        for (int a = 0; a < 2; ++a)
#pragma unroll
            for (int b = 0; b < 2; ++b)
#pragma unroll
                for (int m = 0; m < 4; ++m)
#pragma unroll
                    for (int n = 0; n < 2; ++n) acc[a][b][m][n] = (f32x4){0.f, 0.f, 0.f, 0.f};
        const bf16_t* Ab = g.A + (size_t)cur.pm * BM * g.lda + (size_t)(cur.pn >> g.a_pn_shift) * g.a_pn_stride;
        const bf16_t* Bb = g.Bt + (size_t)cur.pn * BM * g.ldb;
        for (int kk = 0; kk < g.K; kk += 32) {
#pragma unroll
            for (int ai = 0; ai < 2; ++ai)
#pragma unroll
                for (int bj = 0; bj < 2; ++bj)
#pragma unroll
                    for (int m = 0; m < 4; ++m)
#pragma unroll
                        for (int n = 0; n < 2; ++n) {
                            const int ar = ai * HALF + wr * 64 + m * 16 + fr;
                            const int slot = n * 16 + fr, bc = bj * HALF + wc * 32 + (Epi::PERM ? perm32(slot) : slot);
                            const bf16x8 af = *(const bf16x8*)(Ab + (size_t)ar * g.lda + kk + fq * 8);
                            const bf16x8 bf = *(const bf16x8*)(Bb + (size_t)bc * g.ldb + kk + fq * 8);
                            acc[ai][bj][m][n] = __builtin_amdgcn_mfma_f32_16x16x32_bf16(bf, af, acc[ai][bj][m][n], 0, 0, 0);
                        }
        }
        E(acc, cur, wr, wc, fr, fq);
    }
}
#else
template <class Epi, class Sched, bool ALIGN_EPI = false, bool SP2 = false, int LOWP = 0, bool APERM = false>
__device__ __forceinline__ void gemm_phase(LAS unsigned char* lds, const Gemm g, const Sched& S, const Epi& E, int tid_in) {
    constexpr bool F8 = (LOWP == 1), I8 = (LOWP == 2);
    int tid = tid_in; int lda = g.lda, ldb = g.ldb;
    asm volatile("" : "+v"(tid), "+s"(lda), "+s"(ldb));
    const int wid = __builtin_amdgcn_readfirstlane(tid >> 6), lane = tid & 63, wr = wid >> 2, wc = wid & 3, fr = lane & 15, fq = lane >> 4;
    const int K = g.K, nt = K / BK;
    unsigned voffA[2], voffB[2];
#pragma unroll
    for (int i = 0; i < 2; ++i) { int R, C; stage_rc(tid * 16 + i * 8192, R, C); const int Rb = Epi::PERM ? ((R & ~31) + perm32(R & 31)) : R;
        const int Ra = APERM ? ((R & ~63) + 4 * (R & 15) + ((R >> 4) & 3)) : R;
        voffA[i] = (unsigned)(Ra * lda + C) * 2u; voffB[i] = (unsigned)(Rb * ldb + C) * 2u; }
    const size_t kstep = (size_t)(BK * 2);
    const size_t hstepA = (size_t)HALF * lda * 2, hstepB = (size_t)HALF * ldb * 2;
    const size_t tstepA = 2 * hstepA, tstepB = 2 * hstepB;
    const unsigned ldsw = (unsigned)wid * 1024u;
    const int aoff = lds_byte(wr * 64 + fr, fq * 8), boff = lds_byte(wc * 32 + fr, fq * 8);
#define PG8_SA(b, h) (((b) * 2 + (h)) * HTB)
#define PG8_SB(b, h) ((4 + (b) * 2 + (h)) * HTB)
#define PG8_STAGE(bufoff, gbase, voff) do { _Pragma("unroll") for (int _i = 0; _i < 2; ++_i) \
        __builtin_amdgcn_global_load_lds((const unsigned*)((const char*)(gbase) + (voff)[_i]), (LAS unsigned*)(lds + (bufoff) + ldsw + _i * 8192), 16, 0, 0); } while (0)
#define PG8_LDA(dst, b, h) do { _Pragma("unroll") for (int m = 0; m < 4; ++m) _Pragma("unroll") for (int k = 0; k < 2; ++k) dst[m][k] = *(const LAS bf16x8*)(lds + PG8_SA(b, h) + aoff + m * 2048 + k * 1024); } while (0)
#define PG8_LDB(dst, b, h) do { _Pragma("unroll") for (int n = 0; n < 2; ++n) _Pragma("unroll") for (int k = 0; k < 2; ++k) dst[n][k] = *(const LAS bf16x8*)(lds + PG8_SB(b, h) + boff + n * 2048 + k * 1024); } while (0)
#define PG8_MMA(ai, bj, At, Bt) do { __builtin_amdgcn_s_setprio(1); _Pragma("unroll") for (int m = 0; m < 4; ++m) _Pragma("unroll") for (int n = 0; n < 2; ++n) { \
        if constexpr (F8) { typedef int v8i_ __attribute__((ext_vector_type(8))); typedef int v4i_ __attribute__((ext_vector_type(4))); \
            const v4i_ b0_ = __builtin_bit_cast(v4i_, Bt[n][0]), b1_ = __builtin_bit_cast(v4i_, Bt[n][1]), a0_ = __builtin_bit_cast(v4i_, At[m][0]), a1_ = __builtin_bit_cast(v4i_, At[m][1]); \
            const v8i_ bb_ = __builtin_shufflevector(b0_, b1_, 0, 1, 2, 3, 4, 5, 6, 7), aa_ = __builtin_shufflevector(a0_, a1_, 0, 1, 2, 3, 4, 5, 6, 7); \
            asm volatile("v_mfma_f32_16x16x128_f8f6f4 %0, %1, %2, %0" : "+v"(acc[ai][bj][m][n]) : "v"(bb_), "v"(aa_)); (void)f8scale_; } \
        else if constexpr (I8) { typedef int v4i_ __attribute__((ext_vector_type(4))); v4i_ c_ = __builtin_bit_cast(v4i_, acc[ai][bj][m][n]); \
            _Pragma("unroll") for (int k = 0; k < 2; ++k) c_ = __builtin_amdgcn_mfma_i32_16x16x64_i8(__builtin_bit_cast(v4i_, Bt[n][k]), __builtin_bit_cast(v4i_, At[m][k]), c_, 0, 0, 0); \
            acc[ai][bj][m][n] = __builtin_bit_cast(f32x4, c_); } \
        else { _Pragma("unroll") for (int k = 0; k < 2; ++k) acc[ai][bj][m][n] = __builtin_amdgcn_mfma_f32_16x16x32_bf16(Bt[n][k], At[m][k], acc[ai][bj][m][n], 0, 0, 0); } } \
        __builtin_amdgcn_s_setprio(0); } while (0)
#define PG8_WAIT_V(n) asm volatile("s_waitcnt vmcnt(" #n ")" ::: "memory")
#define PG8_WAIT_L(n) asm volatile("s_waitcnt lgkmcnt(" #n ")" ::: "memory")
#define PG8_BAR __builtin_amdgcn_s_barrier()
#define PG8_SCHED __builtin_amdgcn_sched_barrier(0)
#define PG8_ABASE(u) ((const char*)g.A + (size_t)(u).pm * tstepA + (size_t)((u).pn >> g.a_pn_shift) * (size_t)g.a_pn_stride * 2)
    Unit cur, nxt; int ui = 0;
    if (!S.next(0, cur)) return;
    int f8scale_ = 0x7f7f7f7f; asm volatile("" : "+v"(f8scale_));
    f32x4 acc[2][2][4][2];
#pragma unroll
    for (int a = 0; a < 2; ++a)
#pragma unroll
        for (int b = 0; b < 2; ++b)
#pragma unroll
            for (int m = 0; m < 4; ++m)
#pragma unroll
                for (int n = 0; n < 2; ++n) acc[a][b][m][n] = (f32x4){0.f, 0.f, 0.f, 0.f};
    bf16x8 At[4][2], B0[2][2], B1[2][2];
    const char* cA = PG8_ABASE(cur); const char* cB = (const char*)g.Bt + (size_t)cur.pn * tstepB;
    if constexpr (SP2) {
        PG8_STAGE(PG8_SB(0, 0), cB, voffB); PG8_STAGE(PG8_SB(0, 1), cB + hstepB, voffB); PG8_STAGE(PG8_SA(0, 0), cA, voffA); PG8_STAGE(PG8_SA(0, 1), cA + hstepA, voffA);
        if (wr == 1) PG8_BAR;
        PG8_WAIT_V(2); PG8_BAR;
        PG8_STAGE(PG8_SB(1, 0), cB + kstep, voffB); PG8_STAGE(PG8_SA(1, 0), cA + kstep, voffA); PG8_STAGE(PG8_SB(1, 1), cB + hstepB + kstep, voffB);
        PG8_WAIT_V(6); PG8_BAR;
    } else {
        PG8_STAGE(PG8_SB(0, 0), cB, voffB); PG8_STAGE(PG8_SA(0, 0), cA, voffA); PG8_STAGE(PG8_SB(0, 1), cB + hstepB, voffB); PG8_STAGE(PG8_SA(0, 1), cA + hstepA, voffA);
        if (wr == 1) PG8_BAR;
        PG8_WAIT_V(4); PG8_BAR;
        PG8_STAGE(PG8_SB(1, 0), cB + kstep, voffB); PG8_STAGE(PG8_SA(1, 0), cA + kstep, voffA); PG8_STAGE(PG8_SB(1, 1), cB + hstepB + kstep, voffB);
        PG8_WAIT_V(6); PG8_BAR;
    }
    for (;;) {
        const bool has_next = S.next(ui + 1, nxt);
        const char* nA = has_next ? PG8_ABASE(nxt) : cA; const char* nB = has_next ? (const char*)g.Bt + (size_t)nxt.pn * tstepB : cB;
#pragma unroll 1
        for (int t = 0; t < nt; t += 2) {
            const bool last = (t == nt - 2);
            const char* a1 = cA + (size_t)(t + 1) * kstep;
            const char* a2 = last ? nA : cA + (size_t)(t + 2) * kstep; const char* b2 = last ? nB : cB + (size_t)(t + 2) * kstep;
            const char* a3 = a2 + kstep; const char* b3 = b2 + kstep;
            if constexpr (SP2) {
            PG8_LDB(B0, 0, 0); PG8_LDB(B1, 0, 1); PG8_SCHED; PG8_LDA(At, 0, 0); PG8_STAGE(PG8_SA(1, 1), a1 + hstepA, voffA);
            PG8_WAIT_V(8); PG8_WAIT_L(0); PG8_BAR; PG8_MMA(0, 0, At, B0); PG8_MMA(0, 1, At, B1); PG8_BAR; PG8_SCHED;
            PG8_LDA(At, 0, 1); PG8_STAGE(PG8_SB(0, 0), b2, voffB); PG8_STAGE(PG8_SB(0, 1), b2 + hstepB, voffB); PG8_STAGE(PG8_SA(0, 0), a2, voffA);
            PG8_WAIT_V(8); PG8_WAIT_L(0); PG8_BAR; PG8_MMA(1, 0, At, B0); PG8_MMA(1, 1, At, B1); PG8_BAR; PG8_SCHED;
            PG8_LDB(B0, 1, 0); PG8_LDB(B1, 1, 1); PG8_SCHED; PG8_LDA(At, 1, 0); PG8_STAGE(PG8_SA(0, 1), a2 + hstepA, voffA);
            PG8_WAIT_V(8); PG8_WAIT_L(0); PG8_BAR; PG8_MMA(0, 0, At, B0); PG8_MMA(0, 1, At, B1); PG8_BAR; PG8_SCHED;
            PG8_LDA(At, 1, 1); PG8_STAGE(PG8_SB(1, 0), b3, voffB); PG8_STAGE(PG8_SB(1, 1), b3 + hstepB, voffB); PG8_STAGE(PG8_SA(1, 0), a3, voffA);
            PG8_WAIT_V(8); PG8_WAIT_L(0); PG8_BAR; PG8_MMA(1, 0, At, B0); PG8_MMA(1, 1, At, B1); PG8_BAR; PG8_SCHED;
            } else {
            PG8_LDB(B0, 0, 0); PG8_SCHED; PG8_LDA(At, 0, 0); PG8_STAGE(PG8_SA(1, 1), a1 + hstepA, voffA);
            PG8_WAIT_L(8); PG8_BAR; PG8_WAIT_L(0); PG8_MMA(0, 0, At, B0); PG8_BAR; PG8_SCHED;
            PG8_LDB(B1, 0, 1); PG8_STAGE(PG8_SB(0, 0), b2, voffB);
            PG8_BAR; PG8_WAIT_L(0); PG8_MMA(0, 1, At, B1); PG8_BAR;
            PG8_LDA(At, 0, 1); PG8_STAGE(PG8_SA(0, 0), a2, voffA);
            PG8_BAR; PG8_WAIT_L(0); PG8_MMA(1, 0, At, B0); PG8_BAR; PG8_SCHED;
            PG8_STAGE(PG8_SB(0, 1), b2 + hstepB, voffB);
            PG8_WAIT_V(6); PG8_BAR; PG8_MMA(1, 1, At, B1); PG8_BAR;
            PG8_LDB(B0, 1, 0); PG8_SCHED; PG8_LDA(At, 1, 0); PG8_STAGE(PG8_SA(0, 1), a2 + hstepA, voffA);
            PG8_WAIT_L(8); PG8_BAR; PG8_WAIT_L(0); PG8_MMA(0, 0, At, B0); PG8_BAR; PG8_SCHED;
            PG8_LDB(B1, 1, 1); PG8_STAGE(PG8_SB(1, 0), b3, voffB);
            PG8_BAR; PG8_WAIT_L(0); PG8_MMA(0, 1, At, B1); PG8_BAR;
            PG8_LDA(At, 1, 1); PG8_STAGE(PG8_SA(1, 0), a3, voffA);
            PG8_BAR; PG8_WAIT_L(0); PG8_MMA(1, 0, At, B0); PG8_BAR; PG8_SCHED;
            PG8_STAGE(PG8_SB(1, 1), b3 + hstepB, voffB);
            PG8_WAIT_V(6); PG8_BAR; PG8_MMA(1, 1, At, B1); PG8_BAR;
            }
        }
        if constexpr (ALIGN_EPI) { if (wr == 0) PG8_BAR; }
        if constexpr (I8) { typedef int v4i_ __attribute__((ext_vector_type(4)));
#pragma unroll
            for (int a = 0; a < 2; ++a)
#pragma unroll
                for (int b = 0; b < 2; ++b)
#pragma unroll
                    for (int m = 0; m < 4; ++m)
#pragma unroll
                        for (int n = 0; n < 2; ++n) { const v4i_ c_ = __builtin_bit_cast(v4i_, acc[a][b][m][n]); acc[a][b][m][n] = (f32x4){(float)c_[0], (float)c_[1], (float)c_[2], (float)c_[3]}; } }
        if constexpr (F8) asm volatile("s_nop 15\n\ts_nop 15" ::: "memory");
        E(acc, cur, wr, wc, fr, fq);
        if (!has_next) break;
#pragma unroll
        for (int a = 0; a < 2; ++a)
#pragma unroll
            for (int b = 0; b < 2; ++b)
#pragma unroll
                for (int m = 0; m < 4; ++m)
#pragma unroll
                    for (int n = 0; n < 2; ++n) acc[a][b][m][n] = (f32x4){0.f, 0.f, 0.f, 0.f};
        cur = nxt; cA = nA; cB = nB; ++ui;
        if constexpr (ALIGN_EPI) { if (wr == 1) PG8_BAR; }
    }
    PG8_WAIT_V(0);
    if constexpr (!ALIGN_EPI) { if (wr == 0) PG8_BAR; }
    PG8_BAR;
#undef PG8_SA
#undef PG8_SB
#undef PG8_STAGE
#undef PG8_LDA
#undef PG8_LDB
#undef PG8_MMA
#undef PG8_WAIT_V
#undef PG8_WAIT_L
#undef PG8_BAR
#undef PG8_SCHED
#undef PG8_ABASE
}
#endif
}

namespace att {
constexpr int NW = 8, QBLK = 32, KVBLK = 64;
constexpr int LDQ = NQ, LDKN8 = D, LDO = D, LDKP8 = 64;
constexpr float SCALE = 0.07216878364870322f;
constexpr float THR = 5.f;
constexpr float OSCALE = 32.f;
constexpr int SHM_V = KVBLK * 128, SHM_KN = KVBLK * 128, SHM_KR = KVBLK * 64, NSLOT = 6;
constexpr int OFF_V = 0, OFF_KN = NSLOT * SHM_V, OFF_KR = OFF_KN + NSLOT * SHM_KN, OFF_WS = OFF_KR + NSLOT * SHM_KR, LDS_BYTES = OFF_WS + NW * 64 * 4;
#define KN8SW(row, c) ((row) * 128 + ((((c) ^ (((row) >> 1) & 7))) << 4))
#define KR8SW(row, c) ((row) * 64 + ((((c) ^ (((row) >> 2) & 3))) << 4))
typedef int v8i __attribute__((ext_vector_type(8)));
typedef int v4i __attribute__((ext_vector_type(4)));
typedef int v6i __attribute__((ext_vector_type(6)));
typedef int v2i_ __attribute__((ext_vector_type(2)));
#define SBAR() __builtin_amdgcn_sched_barrier(0)
__device__ __forceinline__ int crow(int r, int hi) { return (r & 3) + 8 * (r >> 2) + 4 * hi; }

constexpr float QC = SCALE * 1.4426950408889634f;
constexpr float THR6 = 2.0f, SEED6 = 1.8073549220576042f, THRP = THR6 * 1.4426950408889634f + SEED6, VSC6 = 1.75f;
__device__ __forceinline__ void sm_raise(f32x16& p0, f32x16& p1, f32x16& nm, float delta) {
  const f32x2 d2 = {delta, delta};
#pragma unroll
  for (int r = 0; r < 16; r += 2) { const f32x2 t = (f32x2){p0[r], p0[r + 1]} - d2; p0[r] = t.x; p0[r + 1] = t.y; const f32x2 w = (f32x2){p1[r], p1[r + 1]} - d2; p1[r] = w.x; p1[r + 1] = w.y;
    const f32x2 n_ = (f32x2){nm[r], nm[r + 1]} - d2; nm[r] = n_.x; nm[r + 1] = n_.y; }
}
__device__ __forceinline__ void partialSM(f32x16& p0, f32x16& p1, f32x16& nm, float& alpha, bool first) {
  float pmax, pmb;
  asm("v_max3_f32 %0, %1, %2, %3" : "=v"(pmax) : "v"(p0[0]), "v"(p0[1]), "v"(p1[0]));
  asm("v_max3_f32 %0, %1, %2, %3" : "=v"(pmb) : "v"(p0[2]), "v"(p0[3]), "v"(p1[1]));
  asm("v_max3_f32 %0, %1, %2, %3" : "=v"(pmax) : "v"(pmax), "v"(p1[2]), "v"(p1[3]));
#pragma unroll
  for (int r = 4; r < 16; r += 4) {
    asm("v_max3_f32 %0, %1, %2, %3" : "=v"(pmax) : "v"(pmax), "v"(p0[r]), "v"(p0[r + 1]));
    asm("v_max3_f32 %0, %1, %2, %3" : "=v"(pmb) : "v"(pmb), "v"(p0[r + 2]), "v"(p0[r + 3]));
    asm("v_max3_f32 %0, %1, %2, %3" : "=v"(pmax) : "v"(pmax), "v"(p1[r]), "v"(p1[r + 1]));
    asm("v_max3_f32 %0, %1, %2, %3" : "=v"(pmb) : "v"(pmb), "v"(p1[r + 2]), "v"(p1[r + 3])); }
  pmax = fmaxf(pmax, pmb);
  { auto rr = __builtin_amdgcn_permlane32_swap(__float_as_uint(pmax), __float_as_uint(pmax), false, false);
    pmax = fmaxf(__uint_as_float(rr[0]), __uint_as_float(rr[1])); }
  if (first) { alpha = 1.f; sm_raise(p0, p1, nm, pmax - SEED6); }
  else if (__builtin_expect(__all(pmax <= THRP), 1)) alpha = 1.f;
  else { const float delta = fmaxf(pmax - SEED6, 0.f); alpha = __builtin_amdgcn_exp2f(-delta); sm_raise(p0, p1, nm, delta); }
}
__device__ __forceinline__ void p_pack6(const f32x16& p0, const f32x16& p1, v6i& pf) {
  asm("v_cvt_scalef32_2xpk16_bf6_f32 %0, %1, %2, 1.0" : "=&v"(pf) : "v"(p0), "v"(p1));
}
__device__ __forceinline__ void finishSM(f32x16& p0, f32x16& p1, float alpha, float& l_reg, v6i& pf) {
#pragma unroll
  for (int r = 0; r < 16; ++r) p0[r] = __builtin_amdgcn_exp2f(p0[r]);
#pragma unroll
  for (int r = 0; r < 16; ++r) p1[r] = __builtin_amdgcn_exp2f(p1[r]);
  f32x2 s2a = {p0[0], p0[1]}, s2b = {p1[0], p1[1]};
#pragma unroll
  for (int r = 2; r < 16; r += 2) { s2a += (f32x2){p0[r], p0[r + 1]}; s2b += (f32x2){p1[r], p1[r + 1]}; }
  s2a += s2b; float ps = s2a.x + s2a.y;
  { auto rr = __builtin_amdgcn_permlane32_swap(__float_as_uint(ps), __float_as_uint(ps), false, false);
    ps = __uint_as_float(rr[0]) + __uint_as_float(rr[1]); }
  l_reg = l_reg * alpha + ps;
  p_pack6(p0, p1, pf);
}
template <int C_> __device__ __forceinline__ void fin_chunk(f32x16& p0, f32x16& p1, f32x2& s2, v6i& pf) {
  f32x16& p = (C_ < 2) ? p0 : p1; constexpr int r0 = 8 * (C_ & 1), g0 = (C_ < 2 ? 0 : 4) + 2 * (C_ & 1);
#pragma unroll
  for (int r = r0; r < r0 + 8; ++r) p[r] = __builtin_amdgcn_exp2f(p[r]);
#pragma unroll
  for (int r = r0; r < r0 + 8; r += 2) s2 += (f32x2){p[r], p[r + 1]};
  (void)pf; (void)g0;
}
__device__ __forceinline__ void fin_tail(const f32x2& s2, float alpha, float& l_reg) {
  float ps = s2.x + s2.y;
  { auto rr = __builtin_amdgcn_permlane32_swap(__float_as_uint(ps), __float_as_uint(ps), false, false);
    ps = __uint_as_float(rr[0]) + __uint_as_float(rr[1]); }
  l_reg = l_reg * alpha + ps;
}
__device__ __forceinline__ void part_max(const f32x16& p, float& a, float& b, bool first) {
  if (first) { asm("v_max3_f32 %0, %1, %2, %3" : "=v"(a) : "v"(p[0]), "v"(p[1]), "v"(p[2])); asm("v_max3_f32 %0, %1, %2, %3" : "=v"(b) : "v"(p[3]), "v"(p[4]), "v"(p[5]));
    asm("v_max3_f32 %0, %1, %2, %3" : "=v"(a) : "v"(a), "v"(p[6]), "v"(p[7])); asm("v_max3_f32 %0, %1, %2, %3" : "=v"(b) : "v"(b), "v"(p[8]), "v"(p[9]));
    asm("v_max3_f32 %0, %1, %2, %3" : "=v"(a) : "v"(a), "v"(p[10]), "v"(p[11])); asm("v_max3_f32 %0, %1, %2, %3" : "=v"(b) : "v"(b), "v"(p[12]), "v"(p[13]));
    asm("v_max3_f32 %0, %1, %2, %3" : "=v"(a) : "v"(a), "v"(p[14]), "v"(p[15])); }
  else {
#pragma unroll
    for (int r = 0; r < 16; r += 4) { asm("v_max3_f32 %0, %1, %2, %3" : "=v"(a) : "v"(a), "v"(p[r]), "v"(p[r + 1])); asm("v_max3_f32 %0, %1, %2, %3" : "=v"(b) : "v"(b), "v"(p[r + 2]), "v"(p[r + 3])); } }
}
__device__ __forceinline__ void part_decide(float a, float b, f32x16& p0, f32x16& p1, f32x16& nm, float& alpha) {
  float pmax = fmaxf(a, b);
  { auto rr = __builtin_amdgcn_permlane32_swap(__float_as_uint(pmax), __float_as_uint(pmax), false, false);
    pmax = fmaxf(__uint_as_float(rr[0]), __uint_as_float(rr[1])); }
  if (__builtin_expect(__all(pmax <= THRP), 1)) alpha = 1.f;
  else { const float delta = fmaxf(pmax - SEED6, 0.f); alpha = __builtin_amdgcn_exp2f(-delta); sm_raise(p0, p1, nm, delta); }
}
#define ATT_MFMA8_FIRST(P, KF, QF) asm volatile("v_mfma_f32_32x32x64_f8f6f4 %0, %1, %2, %3" : "=&v"(P) : "v"(KF), "v"(QF), "v"(nm))
#define ATT_MFMA8(P, KF, QF) asm volatile("v_mfma_f32_32x32x64_f8f6f4 %0, %1, %2, %0" : "+v"(P) : "v"(KF), "v"(QF))
__device__ __forceinline__ void k_load_nope(v8i* k0, v8i* k1, const LAS char* Kn, int r32, int hi) {
#pragma unroll
  for (int s_ = 0; s_ < 2; ++s_) { const int c = 4 * s_ + 2 * hi;
    k0[s_] = __builtin_shufflevector(*(const LAS v4i*)(Kn + KN8SW(r32, c)), *(const LAS v4i*)(Kn + KN8SW(r32, c + 1)), 0, 1, 2, 3, 4, 5, 6, 7);
    k1[s_] = __builtin_shufflevector(*(const LAS v4i*)(Kn + KN8SW(32 + r32, c)), *(const LAS v4i*)(Kn + KN8SW(32 + r32, c + 1)), 0, 1, 2, 3, 4, 5, 6, 7); }
}
__device__ __forceinline__ void k_load_pe(v8i* k0, v8i* k1, const LAS char* Kr, int r32, int hi) {
  const int c = 2 * hi;
  k0[2] = __builtin_shufflevector(*(const LAS v4i*)(Kr + KR8SW(r32, c)), *(const LAS v4i*)(Kr + KR8SW(r32, c + 1)), 0, 1, 2, 3, 4, 5, 6, 7);
  k1[2] = __builtin_shufflevector(*(const LAS v4i*)(Kr + KR8SW(32 + r32, c)), *(const LAS v4i*)(Kr + KR8SW(32 + r32, c + 1)), 0, 1, 2, 3, 4, 5, 6, 7);
}
__device__ __forceinline__ void qk_mma(f32x16& p0, f32x16& p1, v8i* k0, v8i* k1, const LAS char* Kr, const v8i* qf, const f32x16& nm, int r32, int hi, int sc) {
  k_load_pe(k0, k1, Kr, r32, hi);
  asm volatile("s_waitcnt lgkmcnt(4)" ::: "memory");
  ATT_MFMA8_FIRST(p0, k0[0], qf[0]); ATT_MFMA8_FIRST(p1, k1[0], qf[0]);
  ATT_MFMA8(p0, k0[1], qf[1]); ATT_MFMA8(p1, k1[1], qf[1]);
  asm volatile("s_waitcnt lgkmcnt(0)" ::: "memory");
  ATT_MFMA8(p0, k0[2], qf[2]); ATT_MFMA8(p1, k1[2], qf[2]);
}
#define ATT_MFMA_SETTLE() asm volatile("s_nop 15\n\ts_nop 15" ::: "memory")
template <int D0> __device__ __forceinline__ v6i pv_ldv(const LAS char* va, const LAS char* vb) {
  const v4i a_ = *(const LAS v4i*)(va + D0 * 2048); const v2i_ b_ = *(const LAS v2i_*)(vb + D0 * 2048);
  return (v6i){a_[0], a_[1], a_[2], a_[3], b_[0], b_[1]};
}
#define ATT_PVMFMA(OD, VF) asm volatile("v_mfma_f32_32x32x64_f8f6f4 %0, %1, %2, %0 cbsz:3 blgp:2" : "+v"(OD) : "v"(pf), "v"(VF))
__device__ __forceinline__ void pv_loadv(v6i* vf, const LAS char* va, const LAS char* vb) { vf[0] = pv_ldv<0>(va, vb); vf[1] = pv_ldv<1>(va, vb); }
__device__ __forceinline__ void pv_mma(f32x16* o, const v6i* vf, const LAS char* va, const LAS char* vb, const v6i& pf, int sc) {
  asm volatile("s_nop 4\n\ts_waitcnt lgkmcnt(0)" ::: "memory");
  ATT_PVMFMA(o[0], vf[0]); ATT_PVMFMA(o[1], vf[1]);
  { const v6i v2 = pv_ldv<2>(va, vb), v3 = pv_ldv<3>(va, vb);
    asm volatile("s_waitcnt lgkmcnt(0)" ::: "memory");
    ATT_PVMFMA(o[2], v2); ATT_PVMFMA(o[3], v3); }
}

#define ATT_GLDS(g, l) __builtin_amdgcn_global_load_lds((const unsigned*)(g), (LAS unsigned*)(l), 16, 0, 0)
#define ATT_BAR() asm volatile("s_waitcnt lgkmcnt(0)\n\ts_barrier" ::: "memory")
#define ATT_WAITV(n) asm volatile("s_waitcnt vmcnt(" #n ")" ::: "memory")
__device__ __forceinline__ void attn_unit(const bf16_t* __restrict__ Qb, const unsigned char* __restrict__ Kn, const unsigned char* __restrict__ Vp, const unsigned char* __restrict__ Kp,
                                          unsigned char* __restrict__ Ob, const f32x2* __restrict__ rope, int pos0, int seq, LAS char* lds, int tid_in) {
  int tid = tid_in; asm volatile("" : "+v"(tid));
  const int wid = __builtin_amdgcn_readfirstlane(tid >> 6), lane = tid & 63, r32 = lane & 31, hi = lane >> 5;
  LAS char* V_lds = lds + OFF_V; LAS char* KN_lds = lds + OFF_KN; LAS char* KR_lds = lds + OFF_KR;
  LAS float* ws = (LAS float*)(lds + OFF_WS) + wid * 64; LAS float* li_l = ws; LAS float* al_l = ws + 32;
  float l_reg = 0; f32x16 o[4] = {}; f32x16 nm = {SEED6, SEED6, SEED6, SEED6, SEED6, SEED6, SEED6, SEED6, SEED6, SEED6, SEED6, SEED6, SEED6, SEED6, SEED6, SEED6}; v8i qf[3];
  int sc = 0x7f7f7f7f; asm volatile("" : "+v"(sc));
  {
    const bf16_t* Qw = Qb + (long)(wid * QBLK + r32) * LDQ;
#pragma unroll
    for (int s_ = 0; s_ < 2; ++s_) {
      u32x4 w[4];
#pragma unroll
      for (int j = 0; j < 4; ++j) w[j] = *(const u32x4*)(Qw + 64 * s_ + 32 * hi + 8 * j);
      v8i f;
#pragma unroll
      for (int j = 0; j < 4; ++j) { f[2 * j] = (int)pk4_fp8(QC * bf_lo(w[j].x), QC * bf_hi(w[j].x), QC * bf_lo(w[j].y), QC * bf_hi(w[j].y)); f[2 * j + 1] = (int)pk4_fp8(QC * bf_lo(w[j].z), QC * bf_hi(w[j].z), QC * bf_lo(w[j].w), QC * bf_hi(w[j].w)); }
      qf[s_] = f;
    }
    const f32x2* rp = rope + (size_t)(pos0 + wid * QBLK + r32) * 32;
    v8i f;
#pragma unroll
    for (int j = 0; j < 4; ++j) {
      const u32x4 xa = *(const u32x4*)(Qw + 128 + 8 * j), xb = *(const u32x4*)(Qw + 160 + 8 * j);
      float r_[8];
#pragma unroll
      for (int e = 0; e < 8; ++e) { const f32x2 cs = rp[8 * j + e];
        const unsigned wa = e < 2 ? xa.x : e < 4 ? xa.y : e < 6 ? xa.z : xa.w, wb = e < 2 ? xb.x : e < 4 ? xb.y : e < 6 ? xb.z : xb.w;
        const float x1 = (e & 1) ? bf_hi(wa) : bf_lo(wa), x2 = (e & 1) ? bf_hi(wb) : bf_lo(wb);
        r_[e] = QC * (hi ? (x1 * cs.y + x2 * cs.x) : (x1 * cs.x - x2 * cs.y)); }
      f[2 * j] = (int)pk4_fp8(r_[0], r_[1], r_[2], r_[3]); f[2 * j + 1] = (int)pk4_fp8(r_[4], r_[5], r_[6], r_[7]);
    }
    qf[2] = f;
  }
  unsigned oK, oP; const unsigned oV = (unsigned)(wid * 1024 + lane * 16);
  { const int row = 8 * wid + (lane >> 3), c = (lane & 7) ^ ((row >> 1) & 7); oK = (unsigned)(row * LDKN8 + c * 16); }
  { const int row = 16 * (wid & 3) + (lane >> 2), c = (lane & 3) ^ ((row >> 2) & 3); oP = (unsigned)(row * LDKP8 + c * 16); }
#define ISSUE(b, k0) do { const char* vsrc_ = (const char*)Vp + (size_t)(k0) * 128; const char* ksrc_ = (const char*)Kn + (size_t)(k0) * LDKN8; const char* psrc_ = (const char*)Kp + (size_t)(k0) * LDKP8; \
    ATT_GLDS(vsrc_ + oV, V_lds + (b) * SHM_V + wid * 1024); \
    ATT_GLDS(ksrc_ + oK, KN_lds + (b) * SHM_KN + wid * 1024); \
    if (wid < 4) ATT_GLDS(psrc_ + oP, KR_lds + (b) * SHM_KR + wid * 1024); } while (0)
  const LAS char* vla0 = V_lds + r32 * 64 + (((2 * hi) ^ ((r32 >> 2) & 3)) << 4);
  const LAS char* vlb0 = V_lds + r32 * 64 + (((2 * hi + 1) ^ ((r32 >> 2) & 3)) << 4);
#define RESC(a) do { if (__any((a) < 1.f)) { if (hi == 0) al_l[r32] = (a); asm volatile("s_nop 15\n\ts_nop 15\n\ts_waitcnt lgkmcnt(0)" ::: "memory");   \
    _Pragma("unroll") for (int d = 0; d < 4; ++d) _Pragma("unroll") for (int r = 0; r < 16; ++r) o[d][r] *= al_l[crow(r, hi)]; asm volatile("s_nop 4" ::: "memory"); } } while (0)
  f32x16 pA0, pA1, pB0, pB1; float alA, alB; v6i pf; const int NT = seq / KVBLK;
  v8i k0[3], k1[3]; v6i vf[2];
#define SLOT_NEXT(x) ((x) == NSLOT - 1 ? 0 : (x) + 1)
#define SLOT_PREV(x) ((x) == 0 ? NSLOT - 1 : (x) - 1)
#define KLOAD(sl_) k_load_nope(k0, k1, KN_lds + (sl_) * SHM_KN, r32, hi)
#define VLOAD(sl_) pv_loadv(vf, vla0 + (sl_) * SHM_V, vlb0 + (sl_) * SHM_V)
#define WAIT_TILES2() do { if (wid < 4) { ATT_WAITV(6); } else { ATT_WAITV(4); } } while (0)
#define STEP(j_, Pn0, Pn1, alN, Po0, Po1, alO) do { const int sm1_ = SLOT_PREV(s0), sp1_ = SLOT_NEXT(s0); f32x2 s2_ = {0.f, 0.f}; float ma_, mb_; v6i v2_, v3_; \
    const LAS char* va_ = vla0 + sm1_ * SHM_V; const LAS char* vb_ = vlb0 + sm1_ * SHM_V; \
    SBAR(); k_load_pe(k0, k1, KR_lds + s0 * SHM_KR, r32, hi); SBAR(); \
    ATT_MFMA8_FIRST(Pn0, k0[0], qf[0]); SBAR(); fin_chunk<0>(Po0, Po1, s2_, pf); SBAR(); \
    ATT_MFMA8_FIRST(Pn1, k1[0], qf[0]); SBAR(); fin_chunk<1>(Po0, Po1, s2_, pf); SBAR(); \
    ATT_MFMA8(Pn0, k0[1], qf[1]); SBAR(); fin_chunk<2>(Po0, Po1, s2_, pf); SBAR(); \
    ATT_MFMA8(Pn1, k1[1], qf[1]); SBAR(); VLOAD(sm1_); fin_chunk<3>(Po0, Po1, s2_, pf); SBAR(); p_pack6(Po0, Po1, pf); SBAR();     \
    ATT_MFMA8(Pn0, k0[2], qf[2]); SBAR(); fin_tail(s2_, alO, l_reg); SBAR(); \
    ATT_MFMA8(Pn1, k1[2], qf[2]); SBAR(); \
    ATT_PVMFMA(o[0], vf[0]); SBAR(); v2_ = pv_ldv<2>(va_, vb_); v3_ = pv_ldv<3>(va_, vb_); part_max(Pn0, ma_, mb_, true); SBAR(); \
    ATT_PVMFMA(o[1], vf[1]); SBAR(); part_max(Pn1, ma_, mb_, false); KLOAD(sp1_); SBAR(); \
    ATT_PVMFMA(o[2], v2_); SBAR(); part_decide(ma_, mb_, Pn0, Pn1, nm, alN); SBAR(); \
    ATT_PVMFMA(o[3], v3_); SBAR(); \
    RESC(alN); \
    if ((j_) + 4 < NT) { WAIT_TILES2(); } else { ATT_WAITV(0); }        \
    ATT_BAR();                                                           \
    if ((j_) + 5 < NT) { ISSUE(sm1_, ((j_) + 5) * KVBLK); } \
    s0 = sp1_; } while (0)
  ISSUE(0, 0); ISSUE(1, KVBLK); ISSUE(2, 2 * KVBLK); ISSUE(3, 3 * KVBLK); ISSUE(4, 4 * KVBLK);
  if (wid < 4) { ATT_WAITV(9); } else { ATT_WAITV(6); }
  ATT_BAR();
  KLOAD(0); qk_mma(pA0, pA1, k0, k1, KR_lds, qf, nm, r32, hi, sc); ATT_MFMA_SETTLE(); SBAR(); KLOAD(1); partialSM(pA0, pA1, nm, alA, true);
  WAIT_TILES2(); ATT_BAR();
  ISSUE(5, 5 * KVBLK);
  int s0 = 1;
  for (int j = 1; j + 1 < NT; j += 2) {
    STEP(j, pB0, pB1, alB, pA0, pA1, alA);
    STEP(j + 1, pA0, pA1, alA, pB0, pB1, alB);
  }
  { const int sm1_ = SLOT_PREV(s0);
    SBAR(); qk_mma(pB0, pB1, k0, k1, KR_lds + s0 * SHM_KR, qf, nm, r32, hi, sc); VLOAD(sm1_); SBAR();
    finishSM(pA0, pA1, alA, l_reg, pf); SBAR();
    pv_mma(o, vf, vla0 + sm1_ * SHM_V, vlb0 + sm1_ * SHM_V, pf, sc); SBAR(); VLOAD(s0); partialSM(pB0, pB1, nm, alB, false);
    RESC(alB);
    finishSM(pB0, pB1, alB, l_reg, pf); SBAR();
    pv_mma(o, vf, vla0 + s0 * SHM_V, vlb0 + s0 * SHM_V, pf, sc); }
  asm volatile("s_nop 15\n\ts_nop 15" ::: "memory");
  if (hi == 0) li_l[r32] = l_reg; asm volatile("s_waitcnt lgkmcnt(0)" ::: "memory");
  float rli[16];
#pragma unroll
  for (int r = 0; r < 16; ++r) rli[r] = (OSCALE / VSC6) * __builtin_amdgcn_rcpf(li_l[crow(r, hi)]);
  unsigned char* Ow = Ob + (long)(wid * QBLK) * LDO;
#pragma unroll
  for (int r = 0; r < 16; ++r) { const int orow = crow(r, hi);
#pragma unroll
    for (int d0 = 0; d0 < 4; ++d0) Ow[(long)orow * LDO + d0 * 32 + r32] = (unsigned char)(__builtin_amdgcn_cvt_pk_fp8_f32(o[d0][r] * rli[r], 0.f, 0, false) & 0xff); }
  ATT_BAR();
#undef ISSUE
#undef STEP
#undef RESC
}
}

constexpr int RING_OFF = 0, RING_BYTES = 131072;
constexpr int LDSCTL_OFF = RING_BYTES, MISC_OFF = LDSCTL_OFF + 320;
constexpr int LDS_BYTES = 147456;
constexpr int NWAVES = 8;
static_assert(att::LDS_BYTES <= RING_BYTES, "attention LDS");

typedef GAS unsigned gu32;
#define RLX_AGENT __ATOMIC_RELAXED, __HIP_MEMORY_SCOPE_AGENT
#define LDS_WAIT() asm volatile("s_waitcnt lgkmcnt(0)" ::: "memory")
#define VM_WAIT() asm volatile("s_waitcnt vmcnt(0)" ::: "memory")

#define XB_TMO      128
#define XB_XCNT(j)  (256  + 64 * (j))
#define XB_XSUB(j)  (1280 + 64 * (j))
#define XB_XGEN(j)  (2304 + 64 * (j))
#define XB_TOP      3328
#define XB_TOPGEN   3392
#define XCD_BAR_WORDS 3456
#define XB_SPIN_CAP (1u << 22)

__device__ __forceinline__ unsigned xb_ld(unsigned* p)              { return __hip_atomic_load(p, __ATOMIC_RELAXED, __HIP_MEMORY_SCOPE_AGENT); }
__device__ __forceinline__ unsigned xb_add(unsigned* p, unsigned v) { return __hip_atomic_fetch_add(p, v, __ATOMIC_RELAXED, __HIP_MEMORY_SCOPE_AGENT); }
__device__ __forceinline__ unsigned xb_xcc_id() { return (unsigned)__builtin_amdgcn_s_getreg((3 << 11) | 20) & 0xFu; }
#define XB_SPIN(cond, bar) do { unsigned _sp = 0; while (cond) { __builtin_amdgcn_s_sleep(1); \
    if ((++_sp & 255u) == 0u) { if (xb_ld(&(bar)[XB_TMO])) break; if (_sp > XB_SPIN_CAP) { atomicAdd(&(bar)[XB_TMO], 1u); break; } } } } while (0)

struct XcdBarrier { unsigned* bar; unsigned x; volatile LAS unsigned* st; };

__device__ __forceinline__ XcdBarrier xcd_barrier_post(unsigned* bar, volatile LAS unsigned* st) {
    XcdBarrier b; b.bar = bar; b.x = xb_xcc_id(); b.st = st;
    if (threadIdx.x == 0) (void)xb_add(&bar[XB_XCNT(b.x)], 1u);
    return b;
}
__device__ __forceinline__ void xcd_barrier_complete(unsigned* bar, unsigned x, unsigned& nloc, unsigned& nx) {
    const unsigned G = gridDim.x * gridDim.y * gridDim.z;
    unsigned sum, cnt, mine, sp = 0u;
    for (;;) {
        sum = 0u; cnt = 0u; mine = 0u;
#pragma unroll
        for (unsigned j = 0; j < 16; ++j) { const unsigned c = xb_ld(&bar[XB_XCNT(j)]); sum += c; cnt += (c > 0u) ? 1u : 0u; mine = (j == x) ? c : mine; }
        if (sum == G) break;
        __builtin_amdgcn_s_sleep(1);
        if ((++sp & 255u) == 0u) { if (xb_ld(&bar[XB_TMO])) break; if (sp > XB_SPIN_CAP) { atomicAdd(&bar[XB_TMO], 1u); break; } }
    }
    nloc = mine > 0u ? mine : 1u; nx = cnt > 0u ? cnt : 1u;
}
__device__ __forceinline__ void xcd_barrier(const XcdBarrier& b, int tid) {
    asm volatile("s_waitcnt vmcnt(0)" ::: "memory");
    __syncthreads();
    if (tid == 0) {
        unsigned* bar = b.bar;
        __builtin_amdgcn_s_waitcnt(0);
        unsigned nloc = b.st[0], nx = b.st[1];
        if (nloc == 0u) { xcd_barrier_complete(bar, b.x, nloc, nx); b.st[0] = nloc; b.st[1] = nx; }
        const unsigned old = xb_add(&bar[XB_XSUB(b.x)], 1u);
        const unsigned gen = old / nloc;
        if (old + 1u == (gen + 1u) * nloc) {
            __builtin_amdgcn_fence(__ATOMIC_RELEASE, "agent");
            asm volatile("s_waitcnt vmcnt(0)" ::: "memory");
            const unsigned og = xb_add(&bar[XB_TOP], 1u);
            const unsigned tg = og / nx;
            if (og + 1u == (tg + 1u) * nx) xb_add(&bar[XB_TOPGEN], 1u);
            else XB_SPIN(xb_ld(&bar[XB_TOPGEN]) == tg, bar);
            __builtin_amdgcn_fence(__ATOMIC_ACQUIRE, "agent");
            xb_add(&bar[XB_XGEN(b.x)], 1u);
            asm volatile("s_waitcnt vmcnt(0)" ::: "memory");
        } else {
            XB_SPIN(xb_ld(&bar[XB_XGEN(b.x)]) == gen, bar);
            __builtin_amdgcn_fence(__ATOMIC_ACQUIRE, "agent");
            asm volatile("s_waitcnt vmcnt(0)" ::: "memory");
        }
    }
    __syncthreads();
}

struct Args {
    const float* x_prompt; const float* x_sample; const float* norm1; const float* w_in; const float* conv_w; const float* conv_b;
    const float* lru_wa; const float* lru_ba; const float* lru_wx; const float* lru_bx; const float* lru_lam;
    const float* q_norm; const float* w_q_up; const float* kv_norm; const float* w_kv_up; const float* w_lru_proj; const float* w_mla_proj; const float* w_out;
    const float* norm2; const float* w_up; const float* w_down; const float* norm_f;
    float* out; unsigned char* ws; int ph_lo, ph_hi, li, pad;
};

__device__ __forceinline__ float wave_sum(float v) {
    v += __builtin_bit_cast(float, __builtin_amdgcn_ds_swizzle(__builtin_bit_cast(int, v), (1 << 10) | 0x1f));
    v += __builtin_bit_cast(float, __builtin_amdgcn_ds_swizzle(__builtin_bit_cast(int, v), (2 << 10) | 0x1f));
    v += __builtin_bit_cast(float, __builtin_amdgcn_ds_swizzle(__builtin_bit_cast(int, v), (4 << 10) | 0x1f));
    v += __builtin_bit_cast(float, __builtin_amdgcn_ds_swizzle(__builtin_bit_cast(int, v), (8 << 10) | 0x1f));
    v += __builtin_bit_cast(float, __builtin_amdgcn_ds_swizzle(__builtin_bit_cast(int, v), (16 << 10) | 0x1f));
    { const auto rr = __builtin_amdgcn_permlane32_swap(__float_as_uint(v), __float_as_uint(v), false, false); v = __uint_as_float(rr[0]) + __uint_as_float(rr[1]); }
    return v;
}
__device__ __forceinline__ float wave_max(float v) {
    v = fmaxf(v, __builtin_bit_cast(float, __builtin_amdgcn_ds_swizzle(__builtin_bit_cast(int, v), (1 << 10) | 0x1f)));
    v = fmaxf(v, __builtin_bit_cast(float, __builtin_amdgcn_ds_swizzle(__builtin_bit_cast(int, v), (2 << 10) | 0x1f)));
    v = fmaxf(v, __builtin_bit_cast(float, __builtin_amdgcn_ds_swizzle(__builtin_bit_cast(int, v), (4 << 10) | 0x1f)));
    v = fmaxf(v, __builtin_bit_cast(float, __builtin_amdgcn_ds_swizzle(__builtin_bit_cast(int, v), (8 << 10) | 0x1f)));
    v = fmaxf(v, __builtin_bit_cast(float, __builtin_amdgcn_ds_swizzle(__builtin_bit_cast(int, v), (16 << 10) | 0x1f)));
    { const auto rr = __builtin_amdgcn_permlane32_swap(__float_as_uint(v), __float_as_uint(v), false, false); v = fmaxf(__uint_as_float(rr[0]), __uint_as_float(rr[1])); }
    return v;
}
__device__ __forceinline__ void transpose_item(const float* W, int ldw, int k0, int n0, bf16_t* WT, int ldt, int drow0, LAS float* scr, int lane) {
#pragma unroll 8
    for (int i = 0; i < 32; ++i) { const int kk = 2 * i + (lane >> 5); scr[kk * 33 + (lane & 31)] = W[(size_t)(k0 + kk) * ldw + n0 + (lane & 31)]; }
    LDS_WAIT(); asm volatile("" ::: "memory");
    const int c = lane & 7;
#pragma unroll
    for (int j = 0; j < 4; ++j) { const int n = (lane >> 3) + 8 * j; const LAS float* s = scr + (8 * c) * 33 + n;
        u32x4 o; o.x = cvt_pk_bf16(s[0 * 33], s[1 * 33]); o.y = cvt_pk_bf16(s[2 * 33], s[3 * 33]); o.z = cvt_pk_bf16(s[4 * 33], s[5 * 33]); o.w = cvt_pk_bf16(s[6 * 33], s[7 * 33]);
        *(u32x4*)(WT + (size_t)(drow0 + n) * ldt + k0 + 8 * c) = o; }
    LDS_WAIT(); asm volatile("" ::: "memory");
}
template <bool I8 = false> __device__ __forceinline__ void transpose_item_f8(const float* W, int ldw, int k0, int n0, unsigned char* WT, int ldt, int drow0, float mul, LAS float* scr, int lane) {
    float v_[32];
#pragma unroll
    for (int i = 0; i < 32; ++i) { const int kk = 2 * i + (lane >> 5); v_[i] = W[(size_t)(k0 + kk) * ldw + n0 + (lane & 31)]; }
#pragma unroll
    for (int i = 0; i < 32; ++i) { const int kk = 2 * i + (lane >> 5); scr[kk * 33 + (lane & 31)] = v_[i]; }
    LDS_WAIT(); asm volatile("" ::: "memory");
    const int c = lane & 7;
#pragma unroll
    for (int j = 0; j < 4; ++j) { const int n = (lane >> 3) + 8 * j; const LAS float* s = scr + (8 * c) * 33 + n;
        u32x2 o; if constexpr (I8) { o.x = pk4_i8(s[0 * 33], s[1 * 33], s[2 * 33], s[3 * 33], mul); o.y = pk4_i8(s[4 * 33], s[5 * 33], s[6 * 33], s[7 * 33], mul); }
        else { o.x = pk4_fp8(s[0 * 33] * mul, s[1 * 33] * mul, s[2 * 33] * mul, s[3 * 33] * mul); o.y = pk4_fp8(s[4 * 33] * mul, s[5 * 33] * mul, s[6 * 33] * mul, s[7 * 33] * mul); }
        *(u32x2*)(WT + (size_t)(drow0 + n) * ldt + k0 + 8 * c) = o; }
    LDS_WAIT(); asm volatile("" ::: "memory");
}
__device__ __forceinline__ void fwht64(float (&v)[64]) {
#pragma unroll
    for (int s_ = 1; s_ < 64; s_ <<= 1)
#pragma unroll
        for (int i = 0; i < 64; ++i) if ((i & s_) == 0) { const float a = v[i], b = v[i | s_]; v[i] = a + b; v[i | s_] = a - b; }
#pragma unroll
    for (int i = 0; i < 64; ++i) v[i] *= 0.125f;
}
__device__ __forceinline__ void transpose_item_h64_i8(const float* W, int ldw, int k0, int n0, unsigned char* WT, int ldt, int drow0, float qs, LAS float* scr, int lane) {
    float v_[32];
#pragma unroll
    for (int i = 0; i < 32; ++i) { const int kk = 2 * i + (lane >> 5); v_[i] = W[(size_t)(k0 + kk) * ldw + n0 + (lane & 31)]; }
#pragma unroll
    for (int i = 0; i < 32; ++i) { const int kk = 2 * i + (lane >> 5); scr[kk * 33 + (lane & 31)] = v_[i]; }
    LDS_WAIT(); asm volatile("" ::: "memory");
    if (lane < 32) {
        float c_[64];
#pragma unroll
        for (int k = 0; k < 64; ++k) c_[k] = scr[k * 33 + lane];
        fwht64(c_);
#pragma unroll
        for (int k = 0; k < 64; ++k) scr[k * 33 + lane] = c_[k];
    }
    LDS_WAIT(); asm volatile("" ::: "memory");
    const int c = lane & 7;
#pragma unroll
    for (int j = 0; j < 4; ++j) { const int n = (lane >> 3) + 8 * j; const LAS float* s = scr + (8 * c) * 33 + n;
        u32x2 o; o.x = pk4_i8(s[0 * 33], s[1 * 33], s[2 * 33], s[3 * 33], qs); o.y = pk4_i8(s[4 * 33], s[5 * 33], s[6 * 33], s[7 * 33], qs);
        *(u32x2*)(WT + (size_t)(drow0 + n) * ldt + k0 + 8 * c) = o; }
    LDS_WAIT(); asm volatile("" ::: "memory");
}
__device__ __forceinline__ void transpose_item_h32_i8(const float* W, int ldw, int k0, int n0, unsigned char* WT, int ldt, int drow0, float qs, LAS float* scr, int lane) {
    float v_[32];
#pragma unroll
    for (int i = 0; i < 32; ++i) { const int kk = 2 * i + (lane >> 5); v_[i] = W[(size_t)(k0 + kk) * ldw + n0 + (lane & 31)]; }
#pragma unroll
    for (int i = 0; i < 32; ++i) { const int kk = 2 * i + (lane >> 5); scr[kk * 33 + (lane & 31)] = v_[i]; }
    LDS_WAIT(); asm volatile("" ::: "memory");
    { const int n = lane & 31, kb = (lane >> 5) * 32;
      float c_[32];
#pragma unroll
      for (int k = 0; k < 32; ++k) c_[k] = scr[(kb + k) * 33 + n];
#pragma unroll
      for (int s_ = 1; s_ < 32; s_ <<= 1)
#pragma unroll
          for (int i = 0; i < 32; ++i) if ((i & s_) == 0) { const float a = c_[i], b = c_[i | s_]; c_[i] = a + b; c_[i | s_] = a - b; }
#pragma unroll
      for (int k = 0; k < 32; ++k) scr[(kb + k) * 33 + n] = c_[k] * 0.17677669529663689f; }
    LDS_WAIT(); asm volatile("" ::: "memory");
    const int c = lane & 7;
#pragma unroll
    for (int j = 0; j < 4; ++j) { const int n = (lane >> 3) + 8 * j; const LAS float* s = scr + (8 * c) * 33 + n;
        u32x2 o; o.x = pk4_i8(s[0 * 33], s[1 * 33], s[2 * 33], s[3 * 33], qs); o.y = pk4_i8(s[4 * 33], s[5 * 33], s[6 * 33], s[7 * 33], qs);
        *(u32x2*)(WT + (size_t)(drow0 + n) * ldt + k0 + 8 * c) = o; }
    LDS_WAIT(); asm volatile("" ::: "memory");
}
__device__ __forceinline__ void transpose_job(const float* W, int K, int N, bf16_t* WT, int r, LAS float* scr, int lane) {
    const int nblk = N / 32, kb = r / nblk, nb = r % nblk;
    transpose_item(W, N, 64 * kb, 32 * nb, WT, K, 32 * nb, scr, lane);
}

__device__ __forceinline__ void rms_row_to_bf16(const float* xrow, const float* g, bf16_t* orow, int lane, unsigned char* o8row = nullptr) {
    const f32x4* xr = (const f32x4*)xrow + lane; const f32x4* gr = (const f32x4*)g + lane;
    f32x4 v[16]; float s = 0.f;
#pragma unroll
    for (int j = 0; j < 16; ++j) { v[j] = xr[64 * j]; s += (v[j].x * v[j].x + v[j].y * v[j].y) + (v[j].z * v[j].z + v[j].w * v[j].w); }
    const float rstd = 1.0f / sqrtf(wave_sum(s) * (1.f / D) + EPS);
    u32x2* o8 = (u32x2*)orow + lane;
#pragma unroll
    for (int j = 0; j < 16; ++j) { const f32x4 gg = gr[64 * j]; const f32x4 y = v[j] * rstd * gg;
        if (orow) { u32x2 w; w.x = cvt_pk_bf16(y.x, y.y); w.y = cvt_pk_bf16(y.z, y.w); o8[64 * j] = w; }
        if (o8row) ((unsigned*)o8row)[lane + 64 * j] = pk4_i8(y.x, y.y, y.z, y.w, XN_QS); }
}
__device__ __forceinline__ void rms_row_inplace_f32(float* xrow, const float* g, int lane) {
    f32x4* xr = (f32x4*)xrow + lane; const f32x4* gr = (const f32x4*)g + lane;
    f32x4 v[16]; float s = 0.f;
#pragma unroll
    for (int j = 0; j < 16; ++j) { v[j] = xr[64 * j]; s += (v[j].x * v[j].x + v[j].y * v[j].y) + (v[j].z * v[j].z + v[j].w * v[j].w); }
    const float rstd = 1.0f / sqrtf(wave_sum(s) * (1.f / D) + EPS);
#pragma unroll
    for (int j = 0; j < 16; ++j) { const f32x4 gg = gr[64 * j]; xr[64 * j] = v[j] * rstd * gg; }
}

__device__ __forceinline__ void rms_row_from_bf16(const bf16_t* xrow, const float* g, bf16_t* obf, unsigned char* o8, float* of32, int lane) {
    f32x4 v[16]; float s = 0.f;
#pragma unroll
    for (int j = 0; j < 8; ++j) { pg8::unpack8(*(const u32x4*)(xrow + (lane + 64 * j) * 8), v[2 * j], v[2 * j + 1]); }
#pragma unroll
    for (int j = 0; j < 16; ++j) s += (v[j].x * v[j].x + v[j].y * v[j].y) + (v[j].z * v[j].z + v[j].w * v[j].w);
    const float rstd = 1.0f / sqrtf(wave_sum(s) * (1.f / D) + EPS);
#pragma unroll
    for (int j = 0; j < 8; ++j) { const int c = (lane + 64 * j) * 8; const f32x4 y0 = v[2 * j] * rstd * *(const f32x4*)(g + c), y1 = v[2 * j + 1] * rstd * *(const f32x4*)(g + c + 4);
        if (obf) *(u32x4*)(obf + c) = pg8::pack8(y0, y1);
        if (o8) *(u32x2*)(o8 + c) = (u32x2){pk4_i8(y0.x, y0.y, y0.z, y0.w, XN_QS), pk4_i8(y1.x, y1.y, y1.z, y1.w, XN_QS)};
        if (of32) { *(f32x4*)(of32 + c) = y0; *(f32x4*)(of32 + c + 4) = y1; } }
}
__device__ __forceinline__ void lru_gate(float lr, float li, float x, float sp8l2, float& la2, float& u) {
    const float r = fast_sigmoid(lr), i = fast_sigmoid(li);
    la2 = -r * sp8l2;
    const float a = __builtin_amdgcn_exp2f(la2);
    const float m = sqrtf(fmaxf(1.0f - a * a, 0.f));
    u = m * i * x;
}
constexpr int TB_SP8 = 0, TB_GBIAS = 2 * D, TB_NORM1 = TB_GBIAS + NG, TB_NORM2 = TB_NORM1 + D, TB_NORMF = TB_NORM2 + D, TB_CONVW = TB_NORMF + D, TB_CONVB = TB_CONVW + 4 * D,
              TB_QNORM = TB_CONVB + D, TB_KVNORM = TB_QNORM + 1024, TB_END = TB_KVNORM + 512;
static_assert(TB_END * 4 <= (int)MiB, "TAB region");
#ifndef PHMASK
#define PHMASK 0xffffu
#endif
#define EN(b) ((PHMASK >> (b)) & 1u)
#define CAS __attribute__((address_space(4)))
#define PHASE_BEGIN() int tid; asm volatile("v_mbcnt_lo_u32_b32 %0, -1, 0\n\tv_mbcnt_hi_u32_b32 %0, -1, %0" : "=v"(tid)); tid += wave0 * 64;     \
    const CAS Args* kp = (const CAS Args*)__builtin_amdgcn_kernarg_segment_ptr(); int G = G0, bx = bx0, vcu = vcu0; \
    asm volatile("" : "+v"(tid), "+s"(kp), "+s"(G), "+s"(bx), "+s"(vcu)); unsigned char* ws = kp->ws; const int NGW = G * NWAVES; (void)NGW; (void)bx; \
    const int lane = tid & 63, wave = __builtin_amdgcn_readfirstlane(tid >> 6), gw = vcu * NWAVES + wave; (void)lane; (void)wave; (void)gw; \
    float* TAB = (float*)(ws + WS_TAB); (void)TAB

__global__ void __launch_bounds__(NWAVES * 64, 2) fwd(Args args) {
    extern __shared__ __attribute__((aligned(16))) unsigned char lds_raw[];
    LAS unsigned char* lds = (LAS unsigned char*)lds_raw;
    volatile LAS unsigned* MISC = (volatile LAS unsigned*)(lds + MISC_OFF);
    const int wave0 = __builtin_amdgcn_readfirstlane((int)threadIdx.x >> 6);
    const int G0 = gridDim.x, bx0 = blockIdx.x;
    const int vcu0 = (G0 % 8 == 0) ? (bx0 % 8) * (G0 / 8) + bx0 / 8 : bx0;
    gu32* ctl = (gu32*)(args.ws + WS_CTL);
    for (int u = threadIdx.x; u < (LDS_BYTES - LDSCTL_OFF) / 4; u += NWAVES * 64) ((LAS unsigned*)(lds + LDSCTL_OFF))[u] = 0u;
    __syncthreads();
    XcdBarrier bar; bar.bar = (unsigned*)(ctl + CW_BAR) + args.li * XCD_BAR_WORDS; bar.x = 0; bar.st = nullptr;
    if (MK_N_LAUNCHES == 0) bar = xcd_barrier_post((unsigned*)(ctl + CW_BAR) + args.li * XCD_BAR_WORDS, MISC + 8);
    const int lo = args.ph_lo, hi = args.ph_hi;
#define IN(k) (lo <= (k) && (k) < hi)
#define SEAM(k) do { if ((k) + 1 < hi) { if (MK_N_LAUNCHES == 0) xcd_barrier(bar, tid); } } while (0)

    if (EN(0) && IN(0)) {
        PHASE_BEGIN();
        bf16_t* WIN_T = (bf16_t*)(ws + WS_WIN); bf16_t* WG_T = (bf16_t*)(ws + WS_WG);
        LAS float* scr = (LAS float*)(lds + RING_OFF + wave * 16384);
        constexpr int I_IN = (D / 64) * (IN_COLS / 32);
        constexpr int I_G = 64 * 32;
        constexpr int I_Q = (1024 / 64) * (NQ / 32);
        constexpr int I_KV = (512 / 64) * (NKV / 32);
        constexpr int I_SQ = (D / 64) * (D / 32);
        constexpr int I_UP = (D / 64) * (DFF / 32);
        constexpr int I_DN = (DFF / 64) * (D / 32);
        constexpr int NITEMS = I_IN + I_G + I_Q + I_KV + 3 * I_SQ + I_UP + I_DN;
        for (int it = gw; it < NITEMS; it += NGW) {
            int r = it;
            if (r < I_IN) { const int nblk = IN_COLS / 32, kb = r / nblk, nb = r % nblk, n0 = 32 * nb;
                transpose_item_f8<true>(kp->w_in, IN_COLS, 64 * kb, n0, (unsigned char*)WIN_T, D, n0 < SRC_GATE ? n0 : n0 + 192, WIN_QS, scr, lane);
                continue; } r -= I_IN;
            if (r < I_G) { const int mat = r >> 5, sub = r & 31, kb = sub >> 3, nb = sub & 7;
                const int isx = mat & 1, hb = (mat >> 1) & 15, dir = mat >> 5; const float* W = (isx ? kp->lru_wx : kp->lru_wa) + (size_t)(dir * 16 + hb) * 65536;
                transpose_item(W, 256, 64 * kb, 32 * nb, WG_T, 256, (hb * 4 + dir * 2 + (nb >> 2)) * 256 + isx * 128 + (nb & 3) * 32, scr, lane); continue; } r -= I_G;
            if (r < I_Q) { const int nblk = NQ / 32, kb = r / nblk, nb = r % nblk; transpose_item_f8(kp->w_q_up, NQ, 64 * kb, 32 * nb, (unsigned char*)(ws + WS_WQ), 1024, 32 * nb, 64.0f, scr, lane); continue; } r -= I_Q;
            if (r < I_KV) { const int nblk = NKV / 32, kb = r / nblk, nb = r % nblk; transpose_item_f8(kp->w_kv_up, NKV, 64 * kb, 32 * nb, (unsigned char*)(ws + WS_WKV), 512, 32 * nb, 64.0f, scr, lane); continue; } r -= I_KV;
            if (r < I_SQ) { const int nblk = D / 32, kb = r / nblk, nb = r % nblk; transpose_item_h64_i8(kp->w_lru_proj, D, 64 * kb, 32 * nb, (unsigned char*)(ws + WS_WLP), D, 32 * nb, WSQ_QS, scr, lane); continue; } r -= I_SQ;
            if (r < I_SQ) { const int nblk = D / 32, kb = r / nblk, nb = r % nblk; transpose_item_f8(kp->w_mla_proj, D, 64 * kb, 32 * nb, (unsigned char*)(ws + WS_WMP), D, 32 * nb, 64.0f, scr, lane); continue; } r -= I_SQ;
            if (r < I_SQ) { const int nblk = D / 32, kb = r / nblk, nb = r % nblk; transpose_item_h32_i8(kp->w_out, D, 64 * kb, 32 * nb, (unsigned char*)(ws + WS_WO), D, 32 * nb, WSQ_QS, scr, lane); continue; } r -= I_SQ;
            if (r < I_UP) { const int nblk = DFF / 32, kb = r / nblk, nb = r % nblk, n0 = 32 * nb;
                if (n0 < NUP8) transpose_item_f8<true>(kp->w_up, DFF, 64 * kb, n0, (unsigned char*)(ws + WS_WUP), D, n0, WSQ_QS, scr, lane);
                else transpose_item(kp->w_up, DFF, 64 * kb, n0, (bf16_t*)(ws + WS_WUPB), D, n0 - NUP8, scr, lane);
                continue; } r -= I_UP;
            transpose_job(kp->w_down, DFF, D, (bf16_t*)(ws + WS_WDN), r, scr, lane);
        }
        const int gt = vcu * (NWAVES * 64) + tid, NGT = G * NWAVES * 64;
        for (int i = gt; i < 192 * D / 16; i += NGT) *(u32x4*)(ws + WS_WIN + (size_t)SRC_GATE * D + (size_t)i * 16) = (u32x4){0u, 0u, 0u, 0u};
        f32x2* ROPE = (f32x2*)(ws + WS_ROPE);
        for (int i = gt; i < SEQ_P * 32; i += NGT) { const int pos = i >> 5, k = i & 31;
            const float inv = 1.0f / powf(10000.0f, (float)k * (1.0f / 32.0f)); const float ang = (float)pos * inv;
            const double rev = (double)ang * 0.15915494309189535; const float fr = (float)(rev - __builtin_rint(rev));
            ROPE[i] = (f32x2){__builtin_amdgcn_cosf(fr), __builtin_amdgcn_sinf(fr)}; }
        for (int i = gt; i < 2 * D; i += NGT) { const float lam = kp->lru_lam[i]; TAB[TB_SP8 + i] = 8.0f * 1.4426950408889634f * log1pf(expf(-lam)); }
        for (int i = gt; i < NG; i += NGT) { const int hb = i >> 10, gate = (i >> 8) & 3, j = i & 255, dir = gate >> 1, isx = gate & 1;
            TAB[TB_GBIAS + i] = (isx ? kp->lru_bx : kp->lru_ba)[(dir * 16 + hb) * 256 + j]; }
        for (int i = gt; i < D; i += NGT) { TAB[TB_NORM1 + i] = kp->norm1[i]; TAB[TB_NORM2 + i] = kp->norm2[i]; TAB[TB_NORMF + i] = kp->norm_f[i]; TAB[TB_CONVB + i] = kp->conv_b[i]; }
        for (int i = gt; i < 4 * D; i += NGT) TAB[TB_CONVW + i] = kp->conv_w[i];
        for (int i = gt; i < 1024; i += NGT) TAB[TB_QNORM + i] = kp->q_norm[i];
        for (int i = gt; i < 512; i += NGT) TAB[TB_KVNORM + i] = kp->kv_norm[i];
        { bf16_t* XN = (bf16_t*)(ws + WS_XN);
          for (int m = gw; m < MG; m += NGW) rms_row_to_bf16(kp->x_prompt + (size_t)m * D, kp->norm1, nullptr, lane, ws + WS_XN8 + (size_t)m * D); }
        SEAM(0);
    }

    for (int grp = 0; grp < NGROUP; ++grp) {
        const int pb = 1 + grp * 7;
        if (hi <= pb || lo >= pb + 7) continue;
        const int L = grp == 0 ? SEQ_P : SEQ_S;
#define XG() (grp == 0 ? kp->x_prompt : kp->x_sample + (size_t)(grp - 1) * MG * D)
#define OUTG() (kp->out + (size_t)grp * MG * D)
#define KVB() ((bf16_t*)OUTG())

        if (EN(2) && IN(pb + 0)) {
            PHASE_BEGIN();
            {
              pg8::Gemm g{(bf16_t*)(ws + WS_XN8), (bf16_t*)(ws + WS_WIN), MG, NZ, D / 2, D / 2, D / 2, 0, 0}; pg8::StaticOrder S; S.init(MG, NZ, G, bx);
              pg8::EpiZ E{(bf16_t*)(ws + WS_Z), NZ, 0, 1.0f / (XN_QS * WIN_QS)};
              pg8::gemm_phase<pg8::EpiZ, pg8::StaticOrder, true, true, 2>(lds + RING_OFF, g, S, E, tid); }
            SEAM(pb + 0);
        }
        if (EN(3) && IN(pb + 1)) {
            PHASE_BEGIN();
            const bf16_t* Z = (const bf16_t*)(ws + WS_Z); bf16_t* XC = (bf16_t*)(ws + WS_XC); bf16_t* CQN = (bf16_t*)(ws + WS_CQN); bf16_t* CKVN = (bf16_t*)(ws + WS_CKVN); bf16_t* KPE = (bf16_t*)(ws + WS_KPE);
            const f32x2* ROPE = (const f32x2*)(ws + WS_ROPE);
            for (int mb = gw; mb < MG / 4; mb += NGW) {
              const int m0 = mb * 4, pos0 = m0 % L;
#pragma unroll 1
              for (int j = 0; j < 8; ++j) { const int ch = lane * 8 + 512 * j;
                  float wgt[4][8], bia[8];
                  { const f32x4 b0 = *(const f32x4*)(TAB + TB_CONVB + ch), b1 = *(const f32x4*)(TAB + TB_CONVB + ch + 4);
                    bia[0] = b0.x; bia[1] = b0.y; bia[2] = b0.z; bia[3] = b0.w; bia[4] = b1.x; bia[5] = b1.y; bia[6] = b1.z; bia[7] = b1.w; }
#pragma unroll
                  for (int k = 0; k < 4; ++k) { const f32x4 w0 = *(const f32x4*)(TAB + TB_CONVW + k * D + ch), w1 = *(const f32x4*)(TAB + TB_CONVW + k * D + ch + 4);
                      wgt[k][0] = w0.x; wgt[k][1] = w0.y; wgt[k][2] = w0.z; wgt[k][3] = w0.w; wgt[k][4] = w1.x; wgt[k][5] = w1.y; wgt[k][6] = w1.z; wgt[k][7] = w1.w; }
                  u32x4 xr[7];
#pragma unroll
                  for (int i = 0; i < 7; ++i) { const int pp = pos0 + i - 2, pc = pp < 0 ? 0 : (pp >= L ? L - 1 : pp);
                      const u32x4 t_ = *(const u32x4*)(Z + (size_t)(m0 - pos0 + pc) * NZ + ch); const unsigned k_ = (pp >= 0 && pp < L) ? 0xffffffffu : 0u;
                      xr[i] = (u32x4){t_.x & k_, t_.y & k_, t_.z & k_, t_.w & k_}; }
#pragma unroll
                  for (int r = 0; r < 4; ++r) { float a[8];
#pragma unroll
                      for (int e = 0; e < 8; ++e) a[e] = bia[e];
#pragma unroll
                      for (int k = 0; k < 4; ++k) { const u32x4 xv = xr[r + k];
                          a[0] += wgt[k][0] * bf_lo(xv.x); a[1] += wgt[k][1] * bf_hi(xv.x); a[2] += wgt[k][2] * bf_lo(xv.y); a[3] += wgt[k][3] * bf_hi(xv.y);
                          a[4] += wgt[k][4] * bf_lo(xv.z); a[5] += wgt[k][5] * bf_hi(xv.z); a[6] += wgt[k][6] * bf_lo(xv.w); a[7] += wgt[k][7] * bf_hi(xv.w); }
                      u32x4 o; o.x = cvt_pk_bf16(a[0], a[1]); o.y = cvt_pk_bf16(a[2], a[3]); o.z = cvt_pk_bf16(a[4], a[5]); o.w = cvt_pk_bf16(a[6], a[7]);
                      *(u32x4*)(XC + (size_t)(m0 + r) * D + ch) = o; } }
#pragma unroll 1
              for (int r4 = 0; r4 < 4; ++r4) { const int m = m0 + r4, pos = pos0 + r4;
                const bf16_t* zr = Z + (size_t)m * NZ;
                {
                    f32x4 v[4]; float s = 0.f;
#pragma unroll
                    for (int j = 0; j < 2; ++j) { pg8::unpack8(*(const u32x4*)(zr + ZC_CQ + lane * 8 + 512 * j), v[2 * j], v[2 * j + 1]); }
#pragma unroll
                    for (int j = 0; j < 4; ++j) s += (v[j].x * v[j].x + v[j].y * v[j].y) + (v[j].z * v[j].z + v[j].w * v[j].w);
                    const float rstd = 1.0f / sqrtf(wave_sum(s) * (1.f / 1024.f) + EPS);
#pragma unroll
                    for (int j = 0; j < 2; ++j) { const int c = lane * 8 + 512 * j; const f32x4 g0 = *(const f32x4*)(TAB + TB_QNORM + c), g1 = *(const f32x4*)(TAB + TB_QNORM + c + 4);
                        const f32x4 y0 = v[2 * j] * rstd * g0, y1 = v[2 * j + 1] * rstd * g1;
                        *(u32x2*)((unsigned char*)CQN + (size_t)m * 1024 + c) = (u32x2){pk4_fp8(y0.x, y0.y, y0.z, y0.w), pk4_fp8(y1.x, y1.y, y1.z, y1.w)}; }
                }
                {
                    f32x4 v0, v1; pg8::unpack8(*(const u32x4*)(zr + ZC_CKV + lane * 8), v0, v1);
                    float s = (v0.x * v0.x + v0.y * v0.y) + (v0.z * v0.z + v0.w * v0.w) + (v1.x * v1.x + v1.y * v1.y) + (v1.z * v1.z + v1.w * v1.w);
                    const float rstd = 1.0f / sqrtf(wave_sum(s) * (1.f / 512.f) + EPS);
                    const int c = lane * 8; const f32x4 g0 = *(const f32x4*)(TAB + TB_KVNORM + c), g1 = *(const f32x4*)(TAB + TB_KVNORM + c + 4);
                    const f32x4 y0 = v0 * rstd * g0, y1 = v1 * rstd * g1;
                    *(u32x2*)((unsigned char*)CKVN + (size_t)m * 512 + c) = (u32x2){pk4_fp8(y0.x, y0.y, y0.z, y0.w), pk4_fp8(y1.x, y1.y, y1.z, y1.w)};
                }
                if (lane < 32) {
                    const float x1 = __uint_as_float(((unsigned)zr[ZC_KR + lane]) << 16), x2 = __uint_as_float(((unsigned)zr[ZC_KR + 32 + lane]) << 16);
                    const f32x2 cs = ROPE[(size_t)pos * 32 + lane];
                    ((unsigned char*)KPE)[(size_t)m * 64 + lane] = (unsigned char)(__builtin_amdgcn_cvt_pk_fp8_f32(x1 * cs.x - x2 * cs.y, 0.f, 0, false) & 0xff);
                    ((unsigned char*)KPE)[(size_t)m * 64 + 32 + lane] = (unsigned char)(__builtin_amdgcn_cvt_pk_fp8_f32(x1 * cs.y + x2 * cs.x, 0.f, 0, false) & 0xff);
                }
              }
            }
            SEAM(pb + 1);
        }
        if (EN(4) && IN(pb + 2)) {
            PHASE_BEGIN();
            { pg8::Gemm g{(bf16_t*)(ws + WS_XC), (bf16_t*)(ws + WS_WG), MG, NG, 256, D, 256, 2, 256}; pg8::StaticOrder S; S.init(MG, NG, G, bx);
              pg8::EpiLru E{(bf16_t*)(ws + WS_G), (const bf16_t*)(ws + WS_XC), TAB + TB_GBIAS, TAB + TB_SP8, (f32x2*)(ws + WS_SUM), (LAS f32x2*)(lds + LDSCTL_OFF + 2048)};
              pg8::gemm_phase<pg8::EpiLru, pg8::StaticOrder, true, false, 0, true>(lds + RING_OFF, g, S, E, tid); }
            { pg8::Gemm g{(bf16_t*)(ws + WS_CQN), (bf16_t*)(ws + WS_WQ), MG, NQ, 512, 512, 512, 0, 0}; pg8::StaticOrder S; S.init(MG, NQ, G, bx);
              pg8::EpiBf16<0> E{(bf16_t*)(ws + WS_Q), NQ, 1.0f / 64.0f};
              pg8::gemm_phase<pg8::EpiBf16<0>, pg8::StaticOrder, true, true, 1>(lds + RING_OFF, g, S, E, tid); }
            { pg8::Gemm g{(bf16_t*)(ws + WS_CKVN), (bf16_t*)(ws + WS_WKV), MG, NKV, 256, 256, 256, 0, 0}; pg8::StaticOrder S; S.init(MG, NKV, G, bx);
              pg8::EpiKV E{(unsigned char*)KVB(), (unsigned char*)KVB() + (size_t)MG * 4096, 1.0f / 64.0f};
              pg8::gemm_phase<pg8::EpiKV, pg8::StaticOrder, true, false, 1>(lds + RING_OFF, g, S, E, tid); }
            SEAM(pb + 2);
        }
        if (EN(6) && IN(pb + 3)) {
            PHASE_BEGIN();
            const bf16_t* GB = (const bf16_t*)(ws + WS_G); const f32x2* SUM = (const f32x2*)(ws + WS_SUM);
            const bf16_t* Z = (const bf16_t*)(ws + WS_Z); bf16_t* ALRU = (bf16_t*)(ws + WS_XN);
            const int ncs = L / CHUNK;
            for (int u = vcu; u < NCHUNK * 4; u += G) {
                const int c = u >> 2, cb = u & 3, ch = cb * 1024 + tid * 2, hb = ch >> 8, jj = ch & 255, t0 = c * CHUNK;
                const int c_lo = (c / ncs) * ncs, c_hi = c_lo + ncs;
                const bf16_t* gp = GB + (size_t)hb * 1024 + jj; const bf16_t* yp = Z + ZC_Y + ch; bf16_t* ap = ALRU + ch;
                float hf0 = 0.f, hf1 = 0.f, hr0 = 0.f, hr1 = 0.f;
#pragma unroll 4
                for (int cc = c_lo; cc < c; ++cc) { const f32x4 s = *(const f32x4*)(SUM + ((size_t)(cc * 2 + 0) * D + ch)); hf0 = s.x * hf0 + s.y; hf1 = s.z * hf1 + s.w; }
#pragma unroll 4
                for (int cc = c_hi - 1; cc > c; --cc) { const f32x4 s = *(const f32x4*)(SUM + ((size_t)(cc * 2 + 1) * D + ch)); hr0 = s.x * hr0 + s.y; hr1 = s.z * hr1 + s.w; }
                { unsigned wn[8][2], wc_[8][2];
#define P6F_LOAD(W, g_) _Pragma("unroll") for (int s_ = 0; s_ < 8; ++s_) { const size_t tf_ = (size_t)(t0 + 8 * (g_) + s_); W[s_][0] = *(const unsigned*)(gp + tf_ * NG); W[s_][1] = *(const unsigned*)(gp + tf_ * NG + 256); }
                  P6F_LOAD(wn, 0);
#pragma unroll 1
                  for (int g8 = 0; g8 < CHUNK / 8; ++g8) {
#pragma unroll
                    for (int s_ = 0; s_ < 8; ++s_) { wc_[s_][0] = wn[s_][0]; wc_[s_][1] = wn[s_][1]; }
                    if (g8 + 1 < CHUNK / 8) { P6F_LOAD(wn, g8 + 1); }
#pragma unroll
                    for (int s_ = 0; s_ < 8; ++s_) { const size_t tf = (size_t)(t0 + 8 * g8 + s_);
                        hf0 = __builtin_amdgcn_exp2f(bf_lo(wc_[s_][0])) * hf0 + bf_lo(wc_[s_][1]); hf1 = __builtin_amdgcn_exp2f(bf_hi(wc_[s_][0])) * hf1 + bf_hi(wc_[s_][1]);
                        *(unsigned*)(ap + tf * D) = cvt_pk_bf16(hf0, hf1); }
                  }
#undef P6F_LOAD
                }
                { unsigned wn[4][4], wc_[4][4];
#define P6R_LOAD(W, g_) _Pragma("unroll") for (int s_ = 0; s_ < 4; ++s_) { const size_t tr_ = (size_t)(t0 + CHUNK - 1 - 4 * (g_) - s_); W[s_][0] = *(const unsigned*)(gp + tr_ * NG + 512); W[s_][1] = *(const unsigned*)(gp + tr_ * NG + 768); \
                    W[s_][2] = *(const unsigned*)(yp + tr_ * NZ); W[s_][3] = *(const unsigned*)(ap + tr_ * D); }
                  P6R_LOAD(wn, 0);
#pragma unroll 1
                  for (int g4 = 0; g4 < CHUNK / 4; ++g4) {
#pragma unroll
                    for (int s_ = 0; s_ < 4; ++s_)
#pragma unroll
                        for (int q_ = 0; q_ < 4; ++q_) wc_[s_][q_] = wn[s_][q_];
                    if (g4 + 1 < CHUNK / 4) { P6R_LOAD(wn, g4 + 1); }
#pragma unroll
                    for (int s_ = 0; s_ < 4; ++s_) { const size_t tr = (size_t)(t0 + CHUNK - 1 - 4 * g4 - s_);
                        hr0 = __builtin_amdgcn_exp2f(bf_lo(wc_[s_][0])) * hr0 + bf_lo(wc_[s_][1]); hr1 = __builtin_amdgcn_exp2f(bf_hi(wc_[s_][0])) * hr1 + bf_hi(wc_[s_][1]);
                        *(unsigned*)(ap + tr * D) = cvt_pk_bf16((bf_lo(wc_[s_][3]) + hr0) * bf_lo(wc_[s_][2]), (bf_hi(wc_[s_][3]) + hr1) * bf_hi(wc_[s_][2])); }
                  }
#undef P6R_LOAD
                }
            }
            {
                const unsigned char* V8 = (const unsigned char*)KVB() + (size_t)MG * 4096; unsigned char* VP = (unsigned char*)KVB() + (size_t)MG * 8192;
                for (int idx = vcu * (NWAVES * 64) + tid; idx < (MG / 64) * 2048; idx += G * NWAVES * 64) {
                    const int T = idx >> 11, hi_ = (idx >> 10) & 1, cg = idx & 1023, h = cg >> 5, cl = (cg & 31) * 4;
                    const unsigned char* src = V8 + (size_t)(T * 64 + 4 * hi_) * 4096 + 4 * cg;
                    int wa[16], wb[16];
#pragma unroll
                    for (int r = 0; r < 16; ++r) { const int k_ = (r & 3) + 8 * (r >> 2); wa[r] = *(const int*)(src + (size_t)k_ * 4096); wb[r] = *(const int*)(src + (size_t)(32 + k_) * 4096); }
                    unsigned char* dst = VP + ((size_t)h * (MG / 64) + T) * 8192;
#define V6_COL(i) { f32x16 va_, vb_; \
                        _Pragma("unroll") for (int r = 0; r < 16; ++r) { va_[r] = att::VSC6 * __builtin_amdgcn_cvt_f32_fp8(wa[r], i); vb_[r] = att::VSC6 * __builtin_amdgcn_cvt_f32_fp8(wb[r], i); } \
                        att::v6i w6; asm("v_cvt_scalef32_2xpk16_fp6_f32 %0, %1, %2, 1.0" : "=&v"(w6) : "v"(va_), "v"(vb_)); const int c = cl + i, sw_ = (c >> 2) & 3; \
                        *(u32x4*)(dst + c * 64 + (((2 * hi_) ^ sw_) << 4)) = (u32x4){(unsigned)w6[0], (unsigned)w6[1], (unsigned)w6[2], (unsigned)w6[3]}; \
                        *(u32x4*)(dst + c * 64 + (((2 * hi_ + 1) ^ sw_) << 4)) = (u32x4){(unsigned)w6[4], (unsigned)w6[5], 0u, 0u}; }
                    V6_COL(0) V6_COL(1) V6_COL(2) V6_COL(3)
#undef V6_COL
                }
            }
            SEAM(pb + 3);
        }
        if (EN(7) && IN(pb + 4)) {
            PHASE_BEGIN();
            const bf16_t* QB = (const bf16_t*)(ws + WS_Q); const unsigned char* KPE = (const unsigned char*)(ws + WS_KPE); unsigned char* OB = (unsigned char*)(ws + WS_O);
            const unsigned char* KN8 = (const unsigned char*)KVB(); const unsigned char* VP = (const unsigned char*)KVB() + (size_t)MG * 8192;
            const f32x2* ROPE = (const f32x2*)(ws + WS_ROPE);
            const int nqb = L / 256;
            for (int u = vcu; u < (MG / 256) * 32; u += G) {
                const int sh = u / nqb, qb = u % nqb, sq = sh >> 5, h = sh & 31;
                const size_t row_s = (size_t)sq * L, row_q = row_s + (size_t)qb * 256;
                att::attn_unit(QB + row_q * NQ + h * 192, KN8 + row_s * 4096 + h * 128, VP + ((size_t)h * (MG / 4) + row_s / 4) * 512, KPE + row_s * 64,
                               OB + row_q * D + h * 128, ROPE, qb * 256, L, (LAS char*)(lds + RING_OFF), tid);
            }
            { const bf16_t* AL = (const bf16_t*)(ws + WS_XN); unsigned char* A8 = ws + WS_O + 32 * MiB; float* ROWS = (float*)(ws + WS_SUM);
              for (int m = gw; m < MG; m += NGW) {
                  float v_[64];
#pragma unroll
                  for (int j = 0; j < 8; ++j) { const u32x4 w = *(const u32x4*)(AL + (size_t)m * D + lane * 64 + j * 8);
                      v_[8 * j] = bf_lo(w.x); v_[8 * j + 1] = bf_hi(w.x); v_[8 * j + 2] = bf_lo(w.y); v_[8 * j + 3] = bf_hi(w.y); v_[8 * j + 4] = bf_lo(w.z); v_[8 * j + 5] = bf_hi(w.z); v_[8 * j + 6] = bf_lo(w.w); v_[8 * j + 7] = bf_hi(w.w); }
                  fwht64(v_);
                  float mx = 0.f;
#pragma unroll
                  for (int i = 0; i < 64; ++i) mx = fmaxf(mx, fabsf(v_[i]));
                  mx = wave_max(mx);
                  const float qs = mx > 0.f ? 127.0f / mx : 1.0f;
#pragma unroll
                  for (int j = 0; j < 4; ++j) *(u32x4*)(A8 + (size_t)m * D + lane * 64 + j * 16) =
                      (u32x4){pk4_i8(v_[16 * j], v_[16 * j + 1], v_[16 * j + 2], v_[16 * j + 3], qs), pk4_i8(v_[16 * j + 4], v_[16 * j + 5], v_[16 * j + 6], v_[16 * j + 7], qs),
                              pk4_i8(v_[16 * j + 8], v_[16 * j + 9], v_[16 * j + 10], v_[16 * j + 11], qs), pk4_i8(v_[16 * j + 12], v_[16 * j + 13], v_[16 * j + 14], v_[16 * j + 15], qs)};
                  if (lane == 0) ROWS[m] = 1.0f / qs;
              } }
            SEAM(pb + 4);
        }
        if (EN(9) && IN(pb + 5)) {
            PHASE_BEGIN();
            {
              pg8::Gemm g{(bf16_t*)(ws + WS_O + 32 * MiB), (bf16_t*)(ws + WS_WLP), MG, D, D / 2, D / 2, D / 2, 0, 0}; pg8::StaticOrder S; S.init(MG, D, G, bx, 1);
              pg8::EpiGate<false> E{(bf16_t*)(ws + WS_XC), D, (const bf16_t*)(ws + WS_Z) + ZC_GATE, NZ, nullptr, 0, 1.0f / WSQ_QS, 0.f, (const float*)(ws + WS_SUM)};
              pg8::gemm_phase<pg8::EpiGate<false>, pg8::StaticOrder, true, true, 2>(lds + RING_OFF, g, S, E, tid); }
            pg8::Gemm g{(bf16_t*)(ws + WS_O), (bf16_t*)(ws + WS_WMP), MG, D, D / 2, D / 2, D / 2, 0, 0}; pg8::StaticOrder S; S.init(MG, D, G, bx, 1);
            pg8::EpiGate<true, true> E{(bf16_t*)(ws + WS_XN), D, (const bf16_t*)(ws + WS_Z) + ZC_GATE + D, NZ, (const bf16_t*)(ws + WS_XC), D, 1.0f / (64.0f * att::OSCALE), MERGED_QS, nullptr};
            pg8::gemm_phase<pg8::EpiGate<true, true>, pg8::StaticOrder, true, true, 1>(lds + RING_OFF, g, S, E, tid);
            SEAM(pb + 5);
        }
        if (EN(10) && IN(pb + 6)) {
            PHASE_BEGIN();
            pg8::Gemm g{(bf16_t*)(ws + WS_XN), (bf16_t*)(ws + WS_WO), MG, D, D / 2, D / 2, D / 2, 0, 0}; pg8::StaticOrder S; S.init(MG, D, G, bx, 1);
            pg8::EpiResBf<false> E{XG(), 0, 0, (bf16_t*)OUTG(), 0, 0, D, 1.0f / (MERGED_QS * WSQ_QS)};
            pg8::gemm_phase<pg8::EpiResBf<false>, pg8::StaticOrder, true, true, 2>(lds + RING_OFF, g, S, E, tid);
            if (grp + 1 < NGROUP) {
                const float* xn_src = kp->x_sample + (size_t)grp * MG * D; bf16_t* XN = (bf16_t*)(ws + WS_XN);
                for (int m = gw; m < MG; m += NGW) rms_row_to_bf16(xn_src + (size_t)m * D, TAB + TB_NORM1, nullptr, lane, ws + WS_XN8 + (size_t)m * D);
            }
            SEAM(pb + 6);
        }
    }
    {
        constexpr int pm_ = 1 + NGROUP * 7;
        if (EN(11) && IN(pm_ + 0)) {
            PHASE_BEGIN();
            const bf16_t* hb = (const bf16_t*)kp->out; bf16_t* N2 = (bf16_t*)(ws + WS_N2ALL);
            for (int m = gw; m < MTOT; m += NGW) rms_row_from_bf16(hb + (size_t)(m >> 13) * ((size_t)MG * D * 2) + (size_t)(m & (MG - 1)) * D, TAB + TB_NORM2, N2 + (size_t)m * D, ws + WS_N2I8 + (size_t)m * D, nullptr, lane);
            SEAM(pm_ + 0);
        }
        if (EN(12) && IN(pm_ + 1)) {
            PHASE_BEGIN();
            {
              pg8::Gemm g{(bf16_t*)(ws + WS_N2I8), (bf16_t*)(ws + WS_WUP), MTOT, NUP8, D / 2, D / 2, D / 2, 0, 0}; pg8::StaticOrder S; S.init(MTOT, NUP8, G, bx);
              pg8::EpiBf16<1> E{(bf16_t*)(ws + WS_HALL), DFF, 1.0f / (XN_QS * WSQ_QS)};
              pg8::gemm_phase<pg8::EpiBf16<1>, pg8::StaticOrder, true, true, 2>(lds + RING_OFF, g, S, E, tid); }
            {
              pg8::Gemm g{(bf16_t*)(ws + WS_N2ALL), (bf16_t*)(ws + WS_WUPB), MTOT, DFF - NUP8, D, D, D, 0, 0}; pg8::StaticOrder S; S.init(MTOT, DFF - NUP8, G, bx);
              pg8::EpiBf16<1> E{(bf16_t*)(ws + WS_HALL) + NUP8, DFF, 1.0f};
              pg8::gemm_phase<pg8::EpiBf16<1>, pg8::StaticOrder, true, true>(lds + RING_OFF, g, S, E, tid); }
            SEAM(pm_ + 1);
        }
        if (EN(13) && IN(pm_ + 2)) {
            PHASE_BEGIN();
            pg8::Gemm g{(bf16_t*)(ws + WS_HALL), (bf16_t*)(ws + WS_WDN), MTOT, D, DFF, DFF, DFF, 0, 0}; pg8::StaticOrder S; S.init(MTOT, D, G, bx, 1);
            pg8::EpiResBf<true> E{kp->out, MG, (size_t)MG * D * 2, (bf16_t*)(ws + WS_N2ALL), 0, 0, D, 1.0f};
            pg8::gemm_phase<pg8::EpiResBf<true>, pg8::StaticOrder, true, true>(lds + RING_OFF, g, S, E, tid);
            SEAM(pm_ + 2);
        }
        if (EN(14) && IN(pm_ + 3)) {
            PHASE_BEGIN();
            float* og = kp->out; const bf16_t* X2 = (const bf16_t*)(ws + WS_N2ALL);
            for (int m = gw; m < MTOT; m += NGW) rms_row_from_bf16(X2 + (size_t)m * D, TAB + TB_NORMF, nullptr, nullptr, og + (size_t)m * D, lane);
            SEAM(pm_ + 3);
        }
    }
#undef IN
#undef SEAM
}

constexpr int NPHASES = 1 + NGROUP * 7 + 4;
extern "C" void kernel_launch(void* const* d_in, const int* in_sizes, int n_in, void* d_out, int out_size, void* d_ws, size_t ws_size, hipStream_t stream) {
    static int grid = 0;
    if (grid == 0) {
        if (n_in != 22 || out_size != MTOT * D || ws_size < WS_END) { fprintf(stderr, "kernel_launch: shape/workspace mismatch (n_in %d out %d ws %zu need %zu)\n", n_in, out_size, ws_size, (size_t)WS_END); grid = -1; return; }
        int dev = 0, cus = 0;
        if (hipGetDevice(&dev) != hipSuccess || hipDeviceGetAttribute(&cus, hipDeviceAttributeMultiprocessorCount, dev) != hipSuccess) { grid = -1; return; }
        if (hipFuncSetAttribute((const void*)fwd, hipFuncAttributeMaxDynamicSharedMemorySize, LDS_BYTES) != hipSuccess) { fprintf(stderr, "kernel_launch: hipFuncSetAttribute failed\n"); grid = -1; return; }
        int per_cu = 0;
        if (hipOccupancyMaxActiveBlocksPerMultiprocessor(&per_cu, (const void*)fwd, NWAVES * 64, LDS_BYTES) != hipSuccess || per_cu < 1) fprintf(stderr, "kernel_launch: occupancy query says %d\n", per_cu);
        (void)hipGetLastError();
        grid = cus;
    }
    if (grid < 0) return;
    (void)hipMemsetAsync((char*)d_ws + WS_CTL, 0, CTL_ZERO_BYTES, stream);
    Args a{};
    a.x_prompt = (const float*)d_in[0]; a.x_sample = (const float*)d_in[1]; a.norm1 = (const float*)d_in[2]; a.w_in = (const float*)d_in[3]; a.conv_w = (const float*)d_in[4]; a.conv_b = (const float*)d_in[5];
    a.lru_wa = (const float*)d_in[6]; a.lru_ba = (const float*)d_in[7]; a.lru_wx = (const float*)d_in[8]; a.lru_bx = (const float*)d_in[9]; a.lru_lam = (const float*)d_in[10];
    a.q_norm = (const float*)d_in[11]; a.w_q_up = (const float*)d_in[12]; a.kv_norm = (const float*)d_in[13]; a.w_kv_up = (const float*)d_in[14]; a.w_lru_proj = (const float*)d_in[15];
    a.w_mla_proj = (const float*)d_in[16]; a.w_out = (const float*)d_in[17]; a.norm2 = (const float*)d_in[18]; a.w_up = (const float*)d_in[19]; a.w_down = (const float*)d_in[20]; a.norm_f = (const float*)d_in[21];
    a.out = (float*)d_out; a.ws = (unsigned char*)d_ws;
#if MK_N_LAUNCHES == 0
#ifdef PROBE_PHASE
    { int lo_[16], hi_[16], n = 0, start = 0;
      if (PROBE_PHASE == 0) { lo_[n] = 0; hi_[n++] = 1; lo_[n] = 0; hi_[n++] = 1; start = 1; }
      else if (PROBE_PHASE <= 7) for (int g = 0; g < NGROUP; ++g) { const int k = 1 + g * 7 + (PROBE_PHASE - 1); lo_[n] = start; hi_[n++] = k + PROBE_LEN; lo_[n] = k; hi_[n++] = k + PROBE_LEN; start = k + PROBE_LEN; }
      else { const int k = 1 + NGROUP * 7 + (PROBE_PHASE - 8); lo_[n] = start; hi_[n++] = k + PROBE_LEN; lo_[n] = k; hi_[n++] = k + PROBE_LEN; start = k + PROBE_LEN; }
      if (start < NPHASES) { lo_[n] = start; hi_[n++] = NPHASES; }
      for (int i = 0; i < n; ++i) { a.ph_lo = lo_[i]; a.ph_hi = hi_[i]; a.li = i; hipLaunchKernelGGL(fwd, dim3(grid), dim3(NWAVES * 64), LDS_BYTES, stream, a); } }
#else
    a.ph_lo = 0; a.ph_hi = NPHASES; a.li = 0;
    hipLaunchKernelGGL(fwd, dim3(grid), dim3(NWAVES * 64), LDS_BYTES, stream, a);
#endif
#else
    for (int p = 0; p < NPHASES; ++p) { a.ph_lo = p; a.ph_hi = p + 1; hipLaunchKernelGGL(fwd, dim3(grid), dim3(NWAVES * 64), LDS_BYTES, stream, a); }
#endif
    const hipError_t le = hipPeekAtLastError();
    if (le != hipSuccess) fprintf(stderr, "kernel_launch: launch failed: %s\n", hipGetErrorName(le));
}
```

```cpp
#include <hip/hip_runtime.h>
#include <cstdio>
#include <cstdint>

#ifndef MK_N_LAUNCHES
#define MK_N_LAUNCHES 0
#endif
#ifndef NAIVE_GEMM
#define NAIVE_GEMM 0
#endif

#define GAS __attribute__((address_space(1)))
#define LAS __attribute__((address_space(3)))
typedef unsigned short bf16_t;
typedef short bf16x8 __attribute__((ext_vector_type(8)));
typedef short s16x4 __attribute__((ext_vector_type(4)));
typedef float f32x2 __attribute__((ext_vector_type(2)));
typedef float f32x4 __attribute__((ext_vector_type(4)));
typedef float f32x16 __attribute__((ext_vector_type(16)));
typedef unsigned u32x2 __attribute__((ext_vector_type(2)));
typedef unsigned u32x4 __attribute__((ext_vector_type(4)));

__device__ __forceinline__ unsigned cvt_pk_bf16(float lo, float hi) { unsigned r; asm volatile("v_cvt_pk_bf16_f32 %0, %1, %2" : "=v"(r) : "v"(lo), "v"(hi)); return r; }
__device__ __forceinline__ unsigned pk4_fp8(float a, float b, float c, float d) { unsigned w;
    asm("v_cvt_pk_fp8_f32 %0, %1, %2" : "=v"(w) : "v"(a), "v"(b)); asm("v_cvt_pk_fp8_f32 %0, %1, %2 op_sel:[0,0,1]" : "+v"(w) : "v"(c), "v"(d)); return w; }
constexpr float XN_QS = 127.0f / 4.0f;
constexpr float WIN_QS = 127.0f * 64.0f / 4.0f;
constexpr float WSQ_QS = 127.0f * 64.0f / 4.0f;
constexpr float MERGED_QS = 127.0f / 1.2f;
__device__ __forceinline__ unsigned pk4_i8(float a, float b, float c, float d, float qs) {
    const int q0 = (int)__builtin_rintf(fminf(fmaxf(a * qs, -127.f), 127.f)), q1 = (int)__builtin_rintf(fminf(fmaxf(b * qs, -127.f), 127.f));
    const int q2 = (int)__builtin_rintf(fminf(fmaxf(c * qs, -127.f), 127.f)), q3 = (int)__builtin_rintf(fminf(fmaxf(d * qs, -127.f), 127.f));
    return ((unsigned)q0 & 0xffu) | (((unsigned)q1 & 0xffu) << 8) | (((unsigned)q2 & 0xffu) << 16) | ((unsigned)q3 << 24);
}
__device__ __forceinline__ float bf_lo(unsigned w) { return __uint_as_float(w << 16); }
__device__ __forceinline__ float bf_hi(unsigned w) { return __uint_as_float(w & 0xffff0000u); }
__device__ __forceinline__ float fast_sigmoid(float v) { return __builtin_amdgcn_rcpf(1.0f + __builtin_amdgcn_exp2f(-1.4426950408889634f * v)); }
__device__ __forceinline__ float gelu_tanh(float v) {
    const float y = 1.5957691216057308f * (v + 0.044715f * v * v * v);
    return v * fast_sigmoid(y);
}

constexpr int D = 4096, MG = 8192, NGROUP = 3, MTOT = 24576;
constexpr int SEQ_P = 8192, SEQ_S = 2048;
constexpr int NZ = 18176, NZ_BF = 8192, NZ_F8 = 9984;
constexpr int ZC_Y = 4096, ZC_CQ = 8192, ZC_CKV = 9216, ZC_KR = 9728, ZC_GATE = 9984;
constexpr int IN_COLS = 17984, SRC_GATE = 9792;
constexpr int NQ = 6144, NKV = 8192, DFF = 16384, NG = 16384;
constexpr float EPS = 1e-6f;
constexpr int CHUNK = 128, NCHUNK = MG / CHUNK;

constexpr size_t MiB = 1u << 20;
constexpr size_t WS_CTL = 0, CTL_ZERO_BYTES = 1 * MiB;
constexpr size_t WS_ROPE = 1 * MiB;
constexpr size_t WS_TAB = 3 * MiB;
constexpr int NUP8 = 8192;
constexpr size_t WS_WUP = 4 * MiB;
constexpr size_t WS_WUPB = WS_WUP + (size_t)NUP8 * 4096;
constexpr size_t WS_WDN = WS_WUP + 128 * MiB;
constexpr size_t WS_WIN = WS_WDN + 128 * MiB;
constexpr size_t WS_XN8 = WS_WIN + 78 * MiB;
constexpr size_t WS_WG = WS_XN8 + 64 * MiB;
constexpr size_t WS_WQ = WS_WG + 8 * MiB;
constexpr size_t WS_WKV = WS_WQ + 12 * MiB;
constexpr size_t WS_WLP = WS_WKV + 8 * MiB;
constexpr size_t WS_WMP = WS_WLP + 32 * MiB;
constexpr size_t WS_WO = WS_WMP + 32 * MiB;
constexpr size_t WS_XN = WS_WO + 32 * MiB;
constexpr size_t WS_Z = WS_XN + 64 * MiB;
constexpr size_t WS_XC = WS_Z + 284 * MiB;
constexpr size_t WS_CQN = WS_XC + 64 * MiB;
constexpr size_t WS_CKVN = WS_CQN + 16 * MiB;
constexpr size_t WS_KPE = WS_CKVN + 8 * MiB;
constexpr size_t WS_SUM = WS_KPE + 1 * MiB;
constexpr size_t WS_G = WS_SUM + 4 * MiB;
constexpr size_t WS_Q = WS_G + 256 * MiB;
constexpr size_t WS_O = WS_Q + 96 * MiB;
constexpr size_t WS_END = WS_O + 64 * MiB;
constexpr size_t WS_N2ALL = WS_WIN;
constexpr size_t WS_HALL = WS_N2ALL + 192 * MiB;
constexpr size_t WS_N2I8 = WS_HALL + 768 * MiB;
static_assert(WS_N2I8 + 96 * MiB <= WS_END, "MLP-stage overlay");

constexpr int CW_TMO = 0, CW_CODE = 1, CW_DIAG = 2, CW_BAR = 4096;

namespace pg8 {
constexpr int BM = 256, BK = 64, HALF = 128, HTB = HALF * BK * 2, STAGE_BYTES = 8 * HTB, NXCD = 8, WGM = 8;
__host__ __device__ __forceinline__ int lds_byte(int r, int c) { const int st = (r >> 4) * 2 + (c >> 5), rr = r & 15, cc = c & 31, ob = rr * 64 + cc * 2; return st * 1024 + (ob ^ (((ob >> 9) & 1) << 5)); }
__host__ __device__ __forceinline__ void stage_rc(int b, int& R, int& C) { const int st = b / 1024, sb = b % 1024, swz = sb ^ (((sb >> 9) & 1) << 5); R = (st >> 1) * 16 + swz / 64; C = (st & 1) * 32 + (swz % 64) / 2; }
__host__ __device__ __forceinline__ int perm32(int rho) { const int n = rho >> 4, i = rho & 15; return 8 * (i >> 2) + 4 * n + (i & 3); }

struct Unit { int pm, pn; };
struct Gemm { const bf16_t* A; const bf16_t* Bt; int M, N, K, lda, ldb, a_pn_shift, a_pn_stride; };

struct StaticOrder {
    int nM, nN, nwg, G, c, shared16;
    __host__ __device__ void init(int M, int N, int G_, int c_, int shared16_ = 0) { nM = M / BM; nN = N / BM; nwg = nM * nN; G = G_; c = c_; shared16 = shared16_ && G_ == 256 && nN == 16 && nM % 16 == 0; }
    __host__ __device__ bool next(int i, Unit& u) const {
        const long L = (long)i * G + c; if (L >= nwg) return false;
        if (shared16) {
            const int x = c & 7, j = c >> 3;
            u.pm = 16 * i + 8 * (x & 1) + (j & 7); u.pn = 4 * (x >> 1) + (j >> 3); return true; }
        int wgid = (int)L; { const int q = nwg / NXCD, r = nwg % NXCD, xcd = wgid % NXCD, off = wgid / NXCD; wgid = (xcd < r ? xcd * (q + 1) : r * (q + 1) + (xcd - r) * q) + off; }
        const int nig = WGM * nN, gid = wgid / nig, fm = gid * WGM, gsz = (nM - fm) < WGM ? (nM - fm) : WGM;
        u.pm = fm + ((wgid % nig) % gsz); u.pn = (wgid % nig) / gsz; return true;
    }
};

__device__ __forceinline__ u32x4 pack8(const f32x4 v0, const f32x4 v1) { u32x4 w; w.x = cvt_pk_bf16(v0[0], v0[1]); w.y = cvt_pk_bf16(v0[2], v0[3]); w.z = cvt_pk_bf16(v1[0], v1[1]); w.w = cvt_pk_bf16(v1[2], v1[3]); return w; }
__device__ __forceinline__ void unpack8(const u32x4 w, f32x4& v0, f32x4& v1) { v0 = (f32x4){bf_lo(w.x), bf_hi(w.x), bf_lo(w.y), bf_hi(w.y)}; v1 = (f32x4){bf_lo(w.z), bf_hi(w.z), bf_lo(w.w), bf_hi(w.w)}; }

struct EpiZ {
    static constexpr bool PERM = true;
    bf16_t* O; int ldc; int pn_off; float scale;
    __device__ __forceinline__ void operator()(const f32x4 (&acc)[2][2][4][2], const Unit& u, int wr, int wc, int fr, int fq) const {
        const int pn = u.pn + pn_off;
        const int row0 = u.pm * BM + wr * 64 + fr, col0 = pn * BM + wc * 32 + 8 * fq;
        const int act = (pn >= 16 && pn < 32) ? 1 : (pn >= 39 ? 2 : 0);
#pragma unroll
        for (int ai = 0; ai < 2; ++ai)
#pragma unroll
            for (int m = 0; m < 4; ++m) { bf16_t* rowp = O + (size_t)(row0 + ai * HALF + m * 16) * ldc + col0;
#pragma unroll
                for (int bj = 0; bj < 2; ++bj) { f32x4 v0 = acc[ai][bj][m][0] * scale, v1 = acc[ai][bj][m][1] * scale;
                    if (act == 1) {
#pragma unroll
                        for (int j = 0; j < 4; ++j) { v0[j] = gelu_tanh(v0[j]); v1[j] = gelu_tanh(v1[j]); } }
                    else if (act == 2) {
#pragma unroll
                        for (int j = 0; j < 4; ++j) { v0[j] = fast_sigmoid(v0[j]); v1[j] = fast_sigmoid(v1[j]); } }
                    *(u32x4*)(rowp + bj * HALF) = pack8(v0, v1); } }
    }
};
template <int ACT> struct EpiBf16 {
    static constexpr bool PERM = true;
    bf16_t* O; int ldc; float scale;
    __device__ __forceinline__ void operator()(const f32x4 (&acc)[2][2][4][2], const Unit& u, int wr, int wc, int fr, int fq) const {
        const int row0 = u.pm * BM + wr * 64 + fr, col0 = u.pn * BM + wc * 32 + 8 * fq;
#pragma unroll
        for (int ai = 0; ai < 2; ++ai)
#pragma unroll
            for (int m = 0; m < 4; ++m) { bf16_t* rowp = O + (size_t)(row0 + ai * HALF + m * 16) * ldc + col0;
#pragma unroll
                for (int bj = 0; bj < 2; ++bj) { f32x4 v0 = acc[ai][bj][m][0] * scale, v1 = acc[ai][bj][m][1] * scale;
                    if (ACT == 1) {
#pragma unroll
                        for (int j = 0; j < 4; ++j) { const float a = fmaxf(v0[j], 0.f), b = fmaxf(v1[j], 0.f); v0[j] = a * a; v1[j] = b * b; } }
                    *(u32x4*)(rowp + bj * HALF) = pack8(v0, v1); } }
    }
};
struct EpiLru {
    static constexpr bool PERM = true;
    bf16_t* G; const bf16_t* XC; const float* gbias; const float* sp8l2;
    f32x2* SUM; LAS f32x2* xch;
    template <int MB> static __device__ __forceinline__ void stage(float& A, float& H, bool mine_first) {
        const float pA = __builtin_bit_cast(float, __builtin_amdgcn_ds_swizzle(__builtin_bit_cast(int, A), (MB << 10) | 0x1f));
        const float pH = __builtin_bit_cast(float, __builtin_amdgcn_ds_swizzle(__builtin_bit_cast(int, H), (MB << 10) | 0x1f));
        H = mine_first ? __builtin_fmaf(pA, H, pH) : __builtin_fmaf(A, pH, H); A *= pA;
    }
    __device__ __forceinline__ void operator()(const f32x4 (&acc)[2][2][4][2], const Unit& u, int wr, int wc, int fr, int fq) const {
        const int hb = u.pn >> 2, dir = (u.pn >> 1) & 1, half = u.pn & 1, j0 = half * 128 + wc * 32 + 8 * fq, row0 = u.pm * BM + wr * 64 + 4 * fr;
        const float* bp = gbias + hb * 1024 + (2 * dir) * 256 + j0;
        const f32x4 br0 = *(const f32x4*)(bp), br1 = *(const f32x4*)(bp + 4), bi0 = *(const f32x4*)(bp + 256), bi1 = *(const f32x4*)(bp + 260);
        const f32x4 sp0 = *(const f32x4*)(sp8l2 + dir * 4096 + hb * 256 + j0), sp1 = *(const f32x4*)(sp8l2 + dir * 4096 + hb * 256 + j0 + 4);
        const bool fwd = dir == 0;
        const bool f1 = ((fr & 1) == 0) == fwd, f2 = ((fr & 2) == 0) == fwd, f4 = ((fr & 4) == 0) == fwd, f8 = ((fr & 8) == 0) == fwd;
        float Ar[2][8], Hr[2][8];
#pragma unroll
        for (int ai = 0; ai < 2; ++ai) {
#pragma unroll
            for (int m = 0; m < 4; ++m) { const size_t row = (size_t)(row0 + ai * HALF + m);
                f32x4 x0, x1; unpack8(*(const u32x4*)(XC + row * 4096 + hb * 256 + j0), x0, x1);
                f32x4 l0, l1, u0, u1; float As[8], Hs[8];
#pragma unroll
                for (int e = 0; e < 4; ++e) {
                    { const float r = fast_sigmoid(acc[ai][0][m][0][e] + br0[e]), i = fast_sigmoid(acc[ai][1][m][0][e] + bi0[e]); const float la = -r * sp0[e], a = __builtin_amdgcn_exp2f(la);
                      l0[e] = la; u0[e] = __builtin_amdgcn_sqrtf(__builtin_fmaf(-a, a, 1.0f)) * i * x0[e]; As[e] = a; Hs[e] = u0[e]; }
                    { const float r = fast_sigmoid(acc[ai][0][m][1][e] + br1[e]), i = fast_sigmoid(acc[ai][1][m][1][e] + bi1[e]); const float la = -r * sp1[e], a = __builtin_amdgcn_exp2f(la);
                      l1[e] = la; u1[e] = __builtin_amdgcn_sqrtf(__builtin_fmaf(-a, a, 1.0f)) * i * x1[e]; As[4 + e] = a; Hs[4 + e] = u1[e]; } }
                bf16_t* gp = G + row * 16384 + hb * 1024 + (2 * dir) * 256 + j0;
                *(u32x4*)(gp) = pack8(l0, l1); *(u32x4*)(gp + 256) = pack8(u0, u1);
#pragma unroll
                for (int e = 0; e < 8; ++e) {
                    if (m == 0) { Ar[ai][e] = As[e]; Hr[ai][e] = Hs[e]; }
                    else if (fwd) { Hr[ai][e] = __builtin_fmaf(As[e], Hr[ai][e], Hs[e]); Ar[ai][e] *= As[e]; }
                    else { Hr[ai][e] = __builtin_fmaf(Ar[ai][e], Hs[e], Hr[ai][e]); Ar[ai][e] *= As[e]; } } }
#pragma unroll
            for (int e = 0; e < 8; ++e) { stage<1>(Ar[ai][e], Hr[ai][e], f1); stage<2>(Ar[ai][e], Hr[ai][e], f2); stage<4>(Ar[ai][e], Hr[ai][e], f4); stage<8>(Ar[ai][e], Hr[ai][e], f8); }
        }
        if (fr == 0) {
#pragma unroll
            for (int ai = 0; ai < 2; ++ai)
#pragma unroll
                for (int e = 0; e < 8; ++e) xch[(wr * 2 + ai) * 128 + wc * 32 + 8 * fq + e] = (f32x2){Ar[ai][e], Hr[ai][e]}; }
        asm volatile("s_waitcnt lgkmcnt(0)" ::: "memory"); __builtin_amdgcn_s_barrier(); asm volatile("" ::: "memory");
        if (wr == 0 && fr == 0) {
#pragma unroll
            for (int ai = 0; ai < 2; ++ai)
#pragma unroll
                for (int e = 0; e < 8; ++e) { const f32x2 o_ = xch[(2 + ai) * 128 + wc * 32 + 8 * fq + e];
                    const float A0 = Ar[ai][e], H0 = Hr[ai][e];
                    const float Hh = fwd ? __builtin_fmaf(o_.x, H0, o_.y) : __builtin_fmaf(A0, o_.y, H0);
                    SUM[(size_t)((2 * u.pm + ai) * 2 + dir) * 4096 + hb * 256 + j0 + e] = (f32x2){A0 * o_.x, Hh}; } }
    }
};
struct EpiKV {
    static constexpr bool PERM = true;
    unsigned char* K8; unsigned char* V; float scale;
    __device__ __forceinline__ void operator()(const f32x4 (&acc)[2][2][4][2], const Unit& u, int wr, int wc, int fr, int fq) const {
        const int row0 = u.pm * BM + wr * 64 + fr, col = u.pn * 128 + wc * 32 + 8 * fq;
#pragma unroll
        for (int ai = 0; ai < 2; ++ai)
#pragma unroll
            for (int m = 0; m < 4; ++m) { const size_t row = (size_t)(row0 + ai * HALF + m * 16);
                { const f32x4 v0 = acc[ai][0][m][0] * scale, v1 = acc[ai][0][m][1] * scale;
                  *(u32x2*)(K8 + row * 4096 + col) = (u32x2){pk4_fp8(v0[0], v0[1], v0[2], v0[3]), pk4_fp8(v1[0], v1[1], v1[2], v1[3])}; }
                { const f32x4 v0 = acc[ai][1][m][0] * scale, v1 = acc[ai][1][m][1] * scale;
                  *(u32x2*)(V + row * 4096 + col) = (u32x2){pk4_fp8(v0[0], v0[1], v0[2], v0[3]), pk4_fp8(v1[0], v1[1], v1[2], v1[3])}; } }
    }
};
template <bool ADD, bool OUT_I8 = false> struct EpiGate {
    static constexpr bool PERM = true;
    bf16_t* O; int ldc; const bf16_t* gate; int ldg; const bf16_t* add; int ldadd; float scale; float qs; const float* rowscale;
    __device__ __forceinline__ void operator()(const f32x4 (&acc)[2][2][4][2], const Unit& u, int wr, int wc, int fr, int fq) const {
        const int row0 = u.pm * BM + wr * 64 + fr, col0 = u.pn * BM + wc * 32 + 8 * fq;
#pragma unroll
        for (int ai = 0; ai < 2; ++ai)
#pragma unroll
            for (int m = 0; m < 4; ++m) { const size_t row = (size_t)(row0 + ai * HALF + m * 16); const float sc_ = rowscale ? scale * rowscale[row] : scale;
#pragma unroll
                for (int bj = 0; bj < 2; ++bj) { const int col = col0 + bj * HALF;
                    f32x4 g0, g1; unpack8(*(const u32x4*)(gate + row * ldg + col), g0, g1);
                    f32x4 v0 = acc[ai][bj][m][0] * (g0 * sc_), v1 = acc[ai][bj][m][1] * (g1 * sc_);
                    if (ADD) { f32x4 a0, a1; unpack8(*(const u32x4*)(add + row * ldadd + col), a0, a1); v0 += a0; v1 += a1; }
                    if constexpr (OUT_I8) {
                        float h_[8] = {v0[0], v0[1], v0[2], v0[3], v1[0], v1[1], v1[2], v1[3]};
#pragma unroll
                        for (int s_ = 1; s_ < 8; s_ <<= 1)
#pragma unroll
                            for (int i = 0; i < 8; ++i) if ((i & s_) == 0) { const float a = h_[i], b = h_[i | s_]; h_[i] = a + b; h_[i | s_] = a - b; }
#pragma unroll
                        for (int i = 0; i < 8; ++i) { const float p = __builtin_bit_cast(float, __builtin_amdgcn_ds_swizzle(__builtin_bit_cast(int, h_[i]), (16 << 10) | 0x1f)); h_[i] = (fq & 1) ? p - h_[i] : h_[i] + p; }
#pragma unroll
                        for (int i = 0; i < 8; ++i) { const auto rr = __builtin_amdgcn_permlane32_swap(__float_as_uint(h_[i]), __float_as_uint(h_[i]), false, false);
                            const float p = __uint_as_float((fq & 2) ? rr[0] : rr[1]); h_[i] = (fq & 2) ? p - h_[i] : h_[i] + p; }
                        const float q_ = qs * 0.17677669529663689f;
                        *(u32x2*)((unsigned char*)O + row * ldc + col) = (u32x2){pk4_i8(h_[0], h_[1], h_[2], h_[3], q_), pk4_i8(h_[4], h_[5], h_[6], h_[7], q_)}; }
                    else *(u32x4*)(O + row * ldc + col) = pack8(v0, v1); } }
    }
};
template <bool BASE_BF> struct EpiResBf {
    static constexpr bool PERM = true;
    const void* base; int base_grp_rows; size_t base_grp_stride; bf16_t* out; int out_grp_rows; size_t out_grp_stride; int ldc; float scale;
    __device__ __forceinline__ void operator()(const f32x4 (&acc)[2][2][4][2], const Unit& u, int wr, int wc, int fr, int fq) const {
        const int row0 = u.pm * BM + wr * 64 + fr, col0 = u.pn * BM + wc * 32 + 8 * fq;
#pragma unroll
        for (int ai = 0; ai < 2; ++ai)
#pragma unroll
            for (int m = 0; m < 4; ++m) { const int row = row0 + ai * HALF + m * 16;
                const size_t bo = base_grp_rows ? (size_t)(row / base_grp_rows) * base_grp_stride + (size_t)(row % base_grp_rows) * ldc : (size_t)row * ldc;
                const size_t oo = out_grp_rows ? (size_t)(row / out_grp_rows) * out_grp_stride + (size_t)(row % out_grp_rows) * ldc : (size_t)row * ldc;
#pragma unroll
                for (int bj = 0; bj < 2; ++bj) { const int col = col0 + bj * HALF;
                    f32x4 b0, b1;
                    if constexpr (BASE_BF) unpack8(*(const u32x4*)((const bf16_t*)base + bo + col), b0, b1);
                    else { b0 = *(const f32x4*)((const float*)base + bo + col); b1 = *(const f32x4*)((const float*)base + bo + col + 4); }
                    *(u32x4*)(out + oo + col) = pack8(b0 + acc[ai][bj][m][0] * scale, b1 + acc[ai][bj][m][1] * scale); } }
    }
};
struct EpiResF32 {
    static constexpr bool PERM = false;
    const float* base; float* out; int ldc; float scale;
    __device__ __forceinline__ void operator()(const f32x4 (&acc)[2][2][4][2], const Unit& u, int wr, int wc, int fr, int fq) const {
        const int row0 = u.pm * BM + wr * 64 + fr, col0 = u.pn * BM + wc * 32 + 4 * fq;
#pragma unroll
        for (int ai = 0; ai < 2; ++ai)
#pragma unroll
            for (int m = 0; m < 4; ++m) { const size_t off = (size_t)(row0 + ai * HALF + m * 16) * ldc + col0;
#pragma unroll
                for (int bj = 0; bj < 2; ++bj)
#pragma unroll
                    for (int n = 0; n < 2; ++n) { const f32x4 bs = *(const f32x4*)(base + off + bj * HALF + n * 16); *(f32x4*)(out + off + bj * HALF + n * 16) = bs + acc[ai][bj][m][n] * scale; } }
    }
};

#if NAIVE_GEMM
template <class Epi, class Sched, bool ALIGN_EPI = false, bool SP2 = false>
__device__ __forceinline__ void gemm_phase(LAS unsigned char* lds, const Gemm g, const Sched& S, const Epi& E, int tid_in) {
    const int tid = tid_in, wid = __builtin_amdgcn_readfirstlane(tid >> 6), lane = tid & 63, wr = wid >> 2, wc = wid & 3, fr = lane & 15, fq = lane >> 4;
    Unit cur;
    for (int ui = 0; S.next(ui, cur); ++ui) {
        f32x4 acc[2][2][4][2];
#pragma unroll
        for (int a = 0; a < 2; ++a)
#pragma unroll
            for (int b = 0; b < 2; ++b)
#pragma unroll
                for (int m = 0; m < 4; ++m)
#pragma unroll
                    for (int n = 0; n < 2; ++n) acc[a][b][m][n] = (f32x4){0.f, 0.f, 0.f, 0.f};
        const bf16_t* Ab = g.A + (size_t)cur.pm * BM * g.lda + (size_t)(cur.pn >> g.a_pn_shift) * g.a_pn_stride;
        const bf16_t* Bb = g.Bt + (size_t)cur.pn * BM * g.ldb;
        for (int kk = 0; kk < g.K; kk += 32) {
#pragma unroll
            for (int ai = 0; ai < 2; ++ai)
#pragma unroll
                for (int bj = 0; bj < 2; ++bj)
#pragma unroll
                    for (int m = 0; m < 4; ++m)
#pragma unroll
                        for (int n = 0; n < 2; ++n) {
                            const int ar = ai * HALF + wr * 64 + m * 16 + fr;
                            const int slot = n * 16 + fr, bc = bj * HALF + wc * 32 + (Epi::PERM ? perm32(slot) : slot);
                            const bf16x8 af = *(const bf16x8*)(Ab + (size_t)ar * g.lda + kk + fq * 8);
                            const bf16x8 bf = *(const bf16x8*)(Bb + (size_t)bc * g.ldb + kk + fq * 8);
                            acc[ai][bj][m][n] = __builtin_amdgcn_mfma_f32_16x16x32_bf16(bf, af, acc[ai][bj][m][n], 0, 0, 0);
                        }
        }
        E(acc, cur, wr, wc, fr, fq);
    }
}
#else
template <class Epi, class Sched, bool ALIGN_EPI = false, bool SP2 = false, int LOWP = 0, bool APERM = false>
__device__ __forceinline__ void gemm_phase(LAS unsigned char* lds, const Gemm g, const Sched& S, const Epi& E, int tid_in) {
    constexpr bool F8 = (LOWP == 1), I8 = (LOWP == 2);
    int tid = tid_in; int lda = g.lda, ldb = g.ldb;
    asm volatile("" : "+v"(tid), "+s"(lda), "+s"(ldb));
    const int wid = __builtin_amdgcn_readfirstlane(tid >> 6), lane = tid & 63, wr = wid >> 2, wc = wid & 3, fr = lane & 15, fq = lane >> 4;
    const int K = g.K, nt = K / BK;
    unsigned voffA[2], voffB[2];
#pragma unroll
    for (int i = 0; i < 2; ++i) { int R, C; stage_rc(tid * 16 + i * 8192, R, C); const int Rb = Epi::PERM ? ((R & ~31) + perm32(R & 31)) : R;
        const int Ra = APERM ? ((R & ~63) + 4 * (R & 15) + ((R >> 4) & 3)) : R;
        voffA[i] = (unsigned)(Ra * lda + C) * 2u; voffB[i] = (unsigned)(Rb * ldb + C) * 2u; }
    const size_t kstep = (size_t)(BK * 2);
    const size_t hstepA = (size_t)HALF * lda * 2, hstepB = (size_t)HALF * ldb * 2;
    const size_t tstepA = 2 * hstepA, tstepB = 2 * hstepB;
    const unsigned ldsw = (unsigned)wid * 1024u;
    const int aoff = lds_byte(wr * 64 + fr, fq * 8), boff = lds_byte(wc * 32 + fr, fq * 8);
#define PG8_SA(b, h) (((b) * 2 + (h)) * HTB)
#define PG8_SB(b, h) ((4 + (b) * 2 + (h)) * HTB)
#define PG8_STAGE(bufoff, gbase, voff) do { _Pragma("unroll") for (int _i = 0; _i < 2; ++_i) \
        __builtin_amdgcn_global_load_lds((const unsigned*)((const char*)(gbase) + (voff)[_i]), (LAS unsigned*)(lds + (bufoff) + ldsw + _i * 8192), 16, 0, 0); } while (0)
#define PG8_LDA(dst, b, h) do { _Pragma("unroll") for (int m = 0; m < 4; ++m) _Pragma("unroll") for (int k = 0; k < 2; ++k) dst[m][k] = *(const LAS bf16x8*)(lds + PG8_SA(b, h) + aoff + m * 2048 + k * 1024); } while (0)
#define PG8_LDB(dst, b, h) do { _Pragma("unroll") for (int n = 0; n < 2; ++n) _Pragma("unroll") for (int k = 0; k < 2; ++k) dst[n][k] = *(const LAS bf16x8*)(lds + PG8_SB(b, h) + boff + n * 2048 + k * 1024); } while (0)
#define PG8_MMA(ai, bj, At, Bt) do { __builtin_amdgcn_s_setprio(1); _Pragma("unroll") for (int m = 0; m < 4; ++m) _Pragma("unroll") for (int n = 0; n < 2; ++n) { \
        if constexpr (F8) { typedef int v8i_ __attribute__((ext_vector_type(8))); typedef int v4i_ __attribute__((ext_vector_type(4))); \
            const v4i_ b0_ = __builtin_bit_cast(v4i_, Bt[n][0]), b1_ = __builtin_bit_cast(v4i_, Bt[n][1]), a0_ = __builtin_bit_cast(v4i_, At[m][0]), a1_ = __builtin_bit_cast(v4i_, At[m][1]); \
            const v8i_ bb_ = __builtin_shufflevector(b0_, b1_, 0, 1, 2, 3, 4, 5, 6, 7), aa_ = __builtin_shufflevector(a0_, a1_, 0, 1, 2, 3, 4, 5, 6, 7); \
            asm volatile("v_mfma_f32_16x16x128_f8f6f4 %0, %1, %2, %0" : "+v"(acc[ai][bj][m][n]) : "v"(bb_), "v"(aa_)); (void)f8scale_; } \
        else if constexpr (I8) { typedef int v4i_ __attribute__((ext_vector_type(4))); v4i_ c_ = __builtin_bit_cast(v4i_, acc[ai][bj][m][n]); \
            _Pragma("unroll") for (int k = 0; k < 2; ++k) c_ = __builtin_amdgcn_mfma_i32_16x16x64_i8(__builtin_bit_cast(v4i_, Bt[n][k]), __builtin_bit_cast(v4i_, At[m][k]), c_, 0, 0, 0); \
            acc[ai][bj][m][n] = __builtin_bit_cast(f32x4, c_); } \
        else { _Pragma("unroll") for (int k = 0; k < 2; ++k) acc[ai][bj][m][n] = __builtin_amdgcn_mfma_f32_16x16x32_bf16(Bt[n][k], At[m][k], acc[ai][bj][m][n], 0, 0, 0); } } \
        __builtin_amdgcn_s_setprio(0); } while (0)
#define PG8_WAIT_V(n) asm volatile("s_waitcnt vmcnt(" #n ")" ::: "memory")
#define PG8_WAIT_L(n) asm volatile("s_waitcnt lgkmcnt(" #n ")" ::: "memory")
#define PG8_BAR __builtin_amdgcn_s_barrier()
#define PG8_SCHED __builtin_amdgcn_sched_barrier(0)
#define PG8_ABASE(u) ((const char*)g.A + (size_t)(u).pm * tstepA + (size_t)((u).pn >> g.a_pn_shift) * (size_t)g.a_pn_stride * 2)
    Unit cur, nxt; int ui = 0;
    if (!S.next(0, cur)) return;
    int f8scale_ = 0x7f7f7f7f; asm volatile("" : "+v"(f8scale_));
    f32x4 acc[2][2][4][2];
#pragma unroll
    for (int a = 0; a < 2; ++a)
#pragma unroll
        for (int b = 0; b < 2; ++b)
#pragma unroll
            for (int m = 0; m < 4; ++m)
#pragma unroll
                for (int n = 0; n < 2; ++n) acc[a][b][m][n] = (f32x4){0.f, 0.f, 0.f, 0.f};
    bf16x8 At[4][2], B0[2][2], B1[2][2];
    const char* cA = PG8_ABASE(cur); const char* cB = (const char*)g.Bt + (size_t)cur.pn * tstepB;
    if constexpr (SP2) {
        PG8_STAGE(PG8_SB(0, 0), cB, voffB); PG8_STAGE(PG8_SB(0, 1), cB + hstepB, voffB); PG8_STAGE(PG8_SA(0, 0), cA, voffA); PG8_STAGE(PG8_SA(0, 1), cA + hstepA, voffA);
        if (wr == 1) PG8_BAR;
        PG8_WAIT_V(2); PG8_BAR;
        PG8_STAGE(PG8_SB(1, 0), cB + kstep, voffB); PG8_STAGE(PG8_SA(1, 0), cA + kstep, voffA); PG8_STAGE(PG8_SB(1, 1), cB + hstepB + kstep, voffB);
        PG8_WAIT_V(6); PG8_BAR;
    } else {
        PG8_STAGE(PG8_SB(0, 0), cB, voffB); PG8_STAGE(PG8_SA(0, 0), cA, voffA); PG8_STAGE(PG8_SB(0, 1), cB + hstepB, voffB); PG8_STAGE(PG8_SA(0, 1), cA + hstepA, voffA);
        if (wr == 1) PG8_BAR;
        PG8_WAIT_V(4); PG8_BAR;
        PG8_STAGE(PG8_SB(1, 0), cB + kstep, voffB); PG8_STAGE(PG8_SA(1, 0), cA + kstep, voffA); PG8_STAGE(PG8_SB(1, 1), cB + hstepB + kstep, voffB);
        PG8_WAIT_V(6); PG8_BAR;
    }
    for (;;) {
        const bool has_next = S.next(ui + 1, nxt);
        const char* nA = has_next ? PG8_ABASE(nxt) : cA; const char* nB = has_next ? (const char*)g.Bt + (size_t)nxt.pn * tstepB : cB;
#pragma unroll 1
        for (int t = 0; t < nt; t += 2) {
            const bool last = (t == nt - 2);
            const char* a1 = cA + (size_t)(t + 1) * kstep;
            const char* a2 = last ? nA : cA + (size_t)(t + 2) * kstep; const char* b2 = last ? nB : cB + (size_t)(t + 2) * kstep;
            const char* a3 = a2 + kstep; const char* b3 = b2 + kstep;
            if constexpr (SP2) {
            PG8_LDB(B0, 0, 0); PG8_LDB(B1, 0, 1); PG8_SCHED; PG8_LDA(At, 0, 0); PG8_STAGE(PG8_SA(1, 1), a1 + hstepA, voffA);
            PG8_WAIT_V(8); PG8_WAIT_L(0); PG8_BAR; PG8_MMA(0, 0, At, B0); PG8_MMA(0, 1, At, B1); PG8_BAR; PG8_SCHED;
            PG8_LDA(At, 0, 1); PG8_STAGE(PG8_SB(0, 0), b2, voffB); PG8_STAGE(PG8_SB(0, 1), b2 + hstepB, voffB); PG8_STAGE(PG8_SA(0, 0), a2, voffA);
            PG8_WAIT_V(8); PG8_WAIT_L(0); PG8_BAR; PG8_MMA(1, 0, At, B0); PG8_MMA(1, 1, At, B1); PG8_BAR; PG8_SCHED;
            PG8_LDB(B0, 1, 0); PG8_LDB(B1, 1, 1); PG8_SCHED; PG8_LDA(At, 1, 0); PG8_STAGE(PG8_SA(0, 1), a2 + hstepA, voffA);
            PG8_WAIT_V(8); PG8_WAIT_L(0); PG8_BAR; PG8_MMA(0, 0, At, B0); PG8_MMA(0, 1, At, B1); PG8_BAR; PG8_SCHED;
            PG8_LDA(At, 1, 1); PG8_STAGE(PG8_SB(1, 0), b3, voffB); PG8_STAGE(PG8_SB(1, 1), b3 + hstepB, voffB); PG8_STAGE(PG8_SA(1, 0), a3, voffA);
            PG8_WAIT_V(8); PG8_WAIT_L(0); PG8_BAR; PG8_MMA(1, 0, At, B0); PG8_MMA(1, 1, At, B1); PG8_BAR; PG8_SCHED;
            } else {
            PG8_LDB(B0, 0, 0); PG8_SCHED; PG8_LDA(At, 0, 0); PG8_STAGE(PG8_SA(1, 1), a1 + hstepA, voffA);
            PG8_WAIT_L(8); PG8_BAR; PG8_WAIT_L(0); PG8_MMA(0, 0, At, B0); PG8_BAR; PG8_SCHED;
            PG8_LDB(B1, 0, 1); PG8_STAGE(PG8_SB(0, 0), b2, voffB);
            PG8_BAR; PG8_WAIT_L(0); PG8_MMA(0, 1, At, B1); PG8_BAR;
            PG8_LDA(At, 0, 1); PG8_STAGE(PG8_SA(0, 0), a2, voffA);
            PG8_BAR; PG8_WAIT_L(0); PG8_MMA(1, 0, At, B0); PG8_BAR; PG8_SCHED;
            PG8_STAGE(PG8_SB(0, 1), b2 + hstepB, voffB);
            PG8_WAIT_V(6); PG8_BAR; PG8_MMA(1, 1, At, B1); PG8_BAR;
            PG8_LDB(B0, 1, 0); PG8_SCHED; PG8_LDA(At, 1, 0); PG8_STAGE(PG8_SA(0, 1), a2 + hstepA, voffA);
            PG8_WAIT_L(8); PG8_BAR; PG8_WAIT_L(0); PG8_MMA(0, 0, At, B0); PG8_BAR; PG8_SCHED;
            PG8_LDB(B1, 1, 1); PG8_STAGE(PG8_SB(1, 0), b3, voffB);
            PG8_BAR; PG8_WAIT_L(0); PG8_MMA(0, 1, At, B1); PG8_BAR;
            PG8_LDA(At, 1, 1); PG8_STAGE(PG8_SA(1, 0), a3, voffA);
            PG8_BAR; PG8_WAIT_L(0); PG8_MMA(1, 0, At, B0); PG8_BAR; PG8_SCHED;
            PG8_STAGE(PG8_SB(1, 1), b3 + hstepB, voffB);
            PG8_WAIT_V(6); PG8_BAR; PG8_MMA(1, 1, At, B1); PG8_BAR;
            }
        }
        if constexpr (ALIGN_EPI) { if (wr == 0) PG8_BAR; }
        if constexpr (I8) { typedef int v4i_ __attribute__((ext_vector_type(4)));
#pragma unroll
            for (int a = 0; a < 2; ++a)
#pragma unroll
                for (int b = 0; b < 2; ++b)
#pragma unroll
                    for (int m = 0; m < 4; ++m)
#pragma unroll
                        for (int n = 0; n < 2; ++n) { const v4i_ c_ = __builtin_bit_cast(v4i_, acc[a][b][m][n]); acc[a][b][m][n] = (f32x4){(float)c_[0], (float)c_[1], (float)c_[2], (float)c_[3]}; } }
        if constexpr (F8) asm volatile("s_nop 15\n\ts_nop 15" ::: "memory");
        E(acc, cur, wr, wc, fr, fq);
        if (!has_next) break;
#pragma unroll
        for (int a = 0; a < 2; ++a)
#pragma unroll
            for (int b = 0; b < 2; ++b)
#pragma unroll
                for (int m = 0; m < 4; ++m)
#pragma unroll
                    for (int n = 0; n < 2; ++n) acc[a][b][m][n] = (f32x4){0.f, 0.f, 0.f, 0.f};
        cur = nxt; cA = nA; cB = nB; ++ui;
        if constexpr (ALIGN_EPI) { if (wr == 1) PG8_BAR; }
    }
    PG8_WAIT_V(0);
    if constexpr (!ALIGN_EPI) { if (wr == 0) PG8_BAR; }
    PG8_BAR;
#undef PG8_SA
#undef PG8_SB
#undef PG8_STAGE
#undef PG8_LDA
#undef PG8_LDB
#undef PG8_MMA
#undef PG8_WAIT_V
#undef PG8_WAIT_L
#undef PG8_BAR
#undef PG8_SCHED
#undef PG8_ABASE
}
#endif
}

namespace att {
constexpr int NW = 8, QBLK = 32, KVBLK = 64;
constexpr int LDQ = NQ, LDKN8 = D, LDO = D, LDKP8 = 64;
constexpr float SCALE = 0.07216878364870322f;
constexpr float THR = 5.f;
constexpr float OSCALE = 32.f;
constexpr int SHM_V = KVBLK * 128, SHM_KN = KVBLK * 128, SHM_KR = KVBLK * 64, NSLOT = 6;
constexpr int OFF_V = 0, OFF_KN = NSLOT * SHM_V, OFF_KR = OFF_KN + NSLOT * SHM_KN, OFF_WS = OFF_KR + NSLOT * SHM_KR, LDS_BYTES = OFF_WS + NW * 64 * 4;
#define KN8SW(row, c) ((row) * 128 + ((((c) ^ (((row) >> 1) & 7))) << 4))
#define KR8SW(row, c) ((row) * 64 + ((((c) ^ (((row) >> 2) & 3))) << 4))
typedef int v8i __attribute__((ext_vector_type(8)));
typedef int v4i __attribute__((ext_vector_type(4)));
typedef int v6i __attribute__((ext_vector_type(6)));
typedef int v2i_ __attribute__((ext_vector_type(2)));
#define SBAR() __builtin_amdgcn_sched_barrier(0)
__device__ __forceinline__ int crow(int r, int hi) { return (r & 3) + 8 * (r >> 2) + 4 * hi; }

constexpr float QC = SCALE * 1.4426950408889634f;
constexpr float THR6 = 2.0f, SEED6 = 1.8073549220576042f, THRP = THR6 * 1.4426950408889634f + SEED6, VSC6 = 1.75f;
__device__ __forceinline__ void sm_raise(f32x16& p0, f32x16& p1, f32x16& nm, float delta) {
  const f32x2 d2 = {delta, delta};
#pragma unroll
  for (int r = 0; r < 16; r += 2) { const f32x2 t = (f32x2){p0[r], p0[r + 1]} - d2; p0[r] = t.x; p0[r + 1] = t.y; const f32x2 w = (f32x2){p1[r], p1[r + 1]} - d2; p1[r] = w.x; p1[r + 1] = w.y;
    const f32x2 n_ = (f32x2){nm[r], nm[r + 1]} - d2; nm[r] = n_.x; nm[r + 1] = n_.y; }
}
__device__ __forceinline__ void partialSM(f32x16& p0, f32x16& p1, f32x16& nm, float& alpha, bool first) {
  float pmax, pmb;
  asm("v_max3_f32 %0, %1, %2, %3" : "=v"(pmax) : "v"(p0[0]), "v"(p0[1]), "v"(p1[0]));
  asm("v_max3_f32 %0, %1, %2, %3" : "=v"(pmb) : "v"(p0[2]), "v"(p0[3]), "v"(p1[1]));
  asm("v_max3_f32 %0, %1, %2, %3" : "=v"(pmax) : "v"(pmax), "v"(p1[2]), "v"(p1[3]));
#pragma unroll
  for (int r = 4; r < 16; r += 4) {
    asm("v_max3_f32 %0, %1, %2, %3" : "=v"(pmax) : "v"(pmax), "v"(p0[r]), "v"(p0[r + 1]));
    asm("v_max3_f32 %0, %1, %2, %3" : "=v"(pmb) : "v"(pmb), "v"(p0[r + 2]), "v"(p0[r + 3]));
    asm("v_max3_f32 %0, %1, %2, %3" : "=v"(pmax) : "v"(pmax), "v"(p1[r]), "v"(p1[r + 1]));
    asm("v_max3_f32 %0, %1, %2, %3" : "=v"(pmb) : "v"(pmb), "v"(p1[r + 2]), "v"(p1[r + 3])); }
  pmax = fmaxf(pmax, pmb);
  { auto rr = __builtin_amdgcn_permlane32_swap(__float_as_uint(pmax), __float_as_uint(pmax), false, false);
    pmax = fmaxf(__uint_as_float(rr[0]), __uint_as_float(rr[1])); }
  if (first) { alpha = 1.f; sm_raise(p0, p1, nm, pmax - SEED6); }
  else if (__builtin_expect(__all(pmax <= THRP), 1)) alpha = 1.f;
  else { const float delta = fmaxf(pmax - SEED6, 0.f); alpha = __builtin_amdgcn_exp2f(-delta); sm_raise(p0, p1, nm, delta); }
}
__device__ __forceinline__ void p_pack6(const f32x16& p0, const f32x16& p1, v6i& pf) {
  asm("v_cvt_scalef32_2xpk16_bf6_f32 %0, %1, %2, 1.0" : "=&v"(pf) : "v"(p0), "v"(p1));
}
__device__ __forceinline__ void finishSM(f32x16& p0, f32x16& p1, float alpha, float& l_reg, v6i& pf) {
#pragma unroll
  for (int r = 0; r < 16; ++r) p0[r] = __builtin_amdgcn_exp2f(p0[r]);
#pragma unroll
  for (int r = 0; r < 16; ++r) p1[r] = __builtin_amdgcn_exp2f(p1[r]);
  f32x2 s2a = {p0[0], p0[1]}, s2b = {p1[0], p1[1]};
#pragma unroll
  for (int r = 2; r < 16; r += 2) { s2a += (f32x2){p0[r], p0[r + 1]}; s2b += (f32x2){p1[r], p1[r + 1]}; }
  s2a += s2b; float ps = s2a.x + s2a.y;
  { auto rr = __builtin_amdgcn_permlane32_swap(__float_as_uint(ps), __float_as_uint(ps), false, false);
    ps = __uint_as_float(rr[0]) + __uint_as_float(rr[1]); }
  l_reg = l_reg * alpha + ps;
  p_pack6(p0, p1, pf);
}
template <int C_> __device__ __forceinline__ void fin_chunk(f32x16& p0, f32x16& p1, f32x2& s2, v6i& pf) {
  f32x16& p = (C_ < 2) ? p0 : p1; constexpr int r0 = 8 * (C_ & 1), g0 = (C_ < 2 ? 0 : 4) + 2 * (C_ & 1);
#pragma unroll
  for (int r = r0; r < r0 + 8; ++r) p[r] = __builtin_amdgcn_exp2f(p[r]);
#pragma unroll
  for (int r = r0; r < r0 + 8; r += 2) s2 += (f32x2){p[r], p[r + 1]};
  (void)pf; (void)g0;
}
__device__ __forceinline__ void fin_tail(const f32x2& s2, float alpha, float& l_reg) {
  float ps = s2.x + s2.y;
  { auto rr = __builtin_amdgcn_permlane32_swap(__float_as_uint(ps), __float_as_uint(ps), false, false);
    ps = __uint_as_float(rr[0]) + __uint_as_float(rr[1]); }
  l_reg = l_reg * alpha + ps;
}
__device__ __forceinline__ void part_max(const f32x16& p, float& a, float& b, bool first) {
  if (first) { asm("v_max3_f32 %0, %1, %2, %3" : "=v"(a) : "v"(p[0]), "v"(p[1]), "v"(p[2])); asm("v_max3_f32 %0, %1, %2, %3" : "=v"(b) : "v"(p[3]), "v"(p[4]), "v"(p[5]));
    asm("v_max3_f32 %0, %1, %2, %3" : "=v"(a) : "v"(a), "v"(p[6]), "v"(p[7])); asm("v_max3_f32 %0, %1, %2, %3" : "=v"(b) : "v"(b), "v"(p[8]), "v"(p[9]));
    asm("v_max3_f32 %0, %1, %2, %3" : "=v"(a) : "v"(a), "v"(p[10]), "v"(p[11])); asm("v_max3_f32 %0, %1, %2, %3" : "=v"(b) : "v"(b), "v"(p[12]), "v"(p[13]));
    asm("v_max3_f32 %0, %1, %2, %3" : "=v"(a) : "v"(a), "v"(p[14]), "v"(p[15])); }
  else {
#pragma unroll
    for (int r = 0; r < 16; r += 4) { asm("v_max3_f32 %0, %1, %2, %3" : "=v"(a) : "v"(a), "v"(p[r]), "v"(p[r + 1])); asm("v_max3_f32 %0, %1, %2, %3" : "=v"(b) : "v"(b), "v"(p[r + 2]), "v"(p[r + 3])); } }
}
__device__ __forceinline__ void part_decide(float a, float b, f32x16& p0, f32x16& p1, f32x16& nm, float& alpha) {
  float pmax = fmaxf(a, b);
  { auto rr = __builtin_amdgcn_permlane32_swap(__float_as_uint(pmax), __float_as_uint(pmax), false, false);
    pmax = fmaxf(__uint_as_float(rr[0]), __uint_as_float(rr[1])); }
  if (__builtin_expect(__all(pmax <= THRP), 1)) alpha = 1.f;
  else { const float delta = fmaxf(pmax - SEED6, 0.f); alpha = __builtin_amdgcn_exp2f(-delta); sm_raise(p0, p1, nm, delta); }
}
#define ATT_MFMA8_FIRST(P, KF, QF) asm volatile("v_mfma_f32_32x32x64_f8f6f4 %0, %1, %2, %3" : "=&v"(P) : "v"(KF), "v"(QF), "v"(nm))
#define ATT_MFMA8(P, KF, QF) asm volatile("v_mfma_f32_32x32x64_f8f6f4 %0, %1, %2, %0" : "+v"(P) : "v"(KF), "v"(QF))
__device__ __forceinline__ void k_load_nope(v8i* k0, v8i* k1, const LAS char* Kn, int r32, int hi) {
#pragma unroll
  for (int s_ = 0; s_ < 2; ++s_) { const int c = 4 * s_ + 2 * hi;
    k0[s_] = __builtin_shufflevector(*(const LAS v4i*)(Kn + KN8SW(r32, c)), *(const LAS v4i*)(Kn + KN8SW(r32, c + 1)), 0, 1, 2, 3, 4, 5, 6, 7);
    k1[s_] = __builtin_shufflevector(*(const LAS v4i*)(Kn + KN8SW(32 + r32, c)), *(const LAS v4i*)(Kn + KN8SW(32 + r32, c + 1)), 0, 1, 2, 3, 4, 5, 6, 7); }
}
__device__ __forceinline__ void k_load_pe(v8i* k0, v8i* k1, const LAS char* Kr, int r32, int hi) {
  const int c = 2 * hi;
  k0[2] = __builtin_shufflevector(*(const LAS v4i*)(Kr + KR8SW(r32, c)), *(const LAS v4i*)(Kr + KR8SW(r32, c + 1)), 0, 1, 2, 3, 4, 5, 6, 7);
  k1[2] = __builtin_shufflevector(*(const LAS v4i*)(Kr + KR8SW(32 + r32, c)), *(const LAS v4i*)(Kr + KR8SW(32 + r32, c + 1)), 0, 1, 2, 3, 4, 5, 6, 7);
}
__device__ __forceinline__ void qk_mma(f32x16& p0, f32x16& p1, v8i* k0, v8i* k1, const LAS char* Kr, const v8i* qf, const f32x16& nm, int r32, int hi, int sc) {
  k_load_pe(k0, k1, Kr, r32, hi);
  asm volatile("s_waitcnt lgkmcnt(4)" ::: "memory");
  ATT_MFMA8_FIRST(p0, k0[0], qf[0]); ATT_MFMA8_FIRST(p1, k1[0], qf[0]);
  ATT_MFMA8(p0, k0[1], qf[1]); ATT_MFMA8(p1, k1[1], qf[1]);
  asm volatile("s_waitcnt lgkmcnt(0)" ::: "memory");
  ATT_MFMA8(p0, k0[2], qf[2]); ATT_MFMA8(p1, k1[2], qf[2]);
}
#define ATT_MFMA_SETTLE() asm volatile("s_nop 15\n\ts_nop 15" ::: "memory")
template <int D0> __device__ __forceinline__ v6i pv_ldv(const LAS char* va, const LAS char* vb) {
  const v4i a_ = *(const LAS v4i*)(va + D0 * 2048); const v2i_ b_ = *(const LAS v2i_*)(vb + D0 * 2048);
  return (v6i){a_[0], a_[1], a_[2], a_[3], b_[0], b_[1]};
}
#define ATT_PVMFMA(OD, VF) asm volatile("v_mfma_f32_32x32x64_f8f6f4 %0, %1, %2, %0 cbsz:3 blgp:2" : "+v"(OD) : "v"(pf), "v"(VF))
__device__ __forceinline__ void pv_loadv(v6i* vf, const LAS char* va, const LAS char* vb) { vf[0] = pv_ldv<0>(va, vb); vf[1] = pv_ldv<1>(va, vb); }
__device__ __forceinline__ void pv_mma(f32x16* o, const v6i* vf, const LAS char* va, const LAS char* vb, const v6i& pf, int sc) {
  asm volatile("s_nop 4\n\ts_waitcnt lgkmcnt(0)" ::: "memory");
  ATT_PVMFMA(o[0], vf[0]); ATT_PVMFMA(o[1], vf[1]);
  { const v6i v2 = pv_ldv<2>(va, vb), v3 = pv_ldv<3>(va, vb);
    asm volatile("s_waitcnt lgkmcnt(0)" ::: "memory");
    ATT_PVMFMA(o[2], v2); ATT_PVMFMA(o[3], v3); }
}

#define ATT_GLDS(g, l) __builtin_amdgcn_global_load_lds((const unsigned*)(g), (LAS unsigned*)(l), 16, 0, 0)
#define ATT_BAR() asm volatile("s_waitcnt lgkmcnt(0)\n\ts_barrier" ::: "memory")
#define ATT_WAITV(n) asm volatile("s_waitcnt vmcnt(" #n ")" ::: "memory")
__device__ __forceinline__ void attn_unit(const bf16_t* __restrict__ Qb, const unsigned char* __restrict__ Kn, const unsigned char* __restrict__ Vp, const unsigned char* __restrict__ Kp,
                                          unsigned char* __restrict__ Ob, const f32x2* __restrict__ rope, int pos0, int seq, LAS char* lds, int tid_in) {
  int tid = tid_in; asm volatile("" : "+v"(tid));
  const int wid = __builtin_amdgcn_readfirstlane(tid >> 6), lane = tid & 63, r32 = lane & 31, hi = lane >> 5;
  LAS char* V_lds = lds + OFF_V; LAS char* KN_lds = lds + OFF_KN; LAS char* KR_lds = lds + OFF_KR;
  LAS float* ws = (LAS float*)(lds + OFF_WS) + wid * 64; LAS float* li_l = ws; LAS float* al_l = ws + 32;
  float l_reg = 0; f32x16 o[4] = {}; f32x16 nm = {SEED6, SEED6, SEED6, SEED6, SEED6, SEED6, SEED6, SEED6, SEED6, SEED6, SEED6, SEED6, SEED6, SEED6, SEED6, SEED6}; v8i qf[3];
  int sc = 0x7f7f7f7f; asm volatile("" : "+v"(sc));
  {
    const bf16_t* Qw = Qb + (long)(wid * QBLK + r32) * LDQ;
#pragma unroll
    for (int s_ = 0; s_ < 2; ++s_) {
      u32x4 w[4];
#pragma unroll
      for (int j = 0; j < 4; ++j) w[j] = *(const u32x4*)(Qw + 64 * s_ + 32 * hi + 8 * j);
      v8i f;
#pragma unroll
      for (int j = 0; j < 4; ++j) { f[2 * j] = (int)pk4_fp8(QC * bf_lo(w[j].x), QC * bf_hi(w[j].x), QC * bf_lo(w[j].y), QC * bf_hi(w[j].y)); f[2 * j + 1] = (int)pk4_fp8(QC * bf_lo(w[j].z), QC * bf_hi(w[j].z), QC * bf_lo(w[j].w), QC * bf_hi(w[j].w)); }
      qf[s_] = f;
    }
    const f32x2* rp = rope + (size_t)(pos0 + wid * QBLK + r32) * 32;
    v8i f;
#pragma unroll
    for (int j = 0; j < 4; ++j) {
      const u32x4 xa = *(const u32x4*)(Qw + 128 + 8 * j), xb = *(const u32x4*)(Qw + 160 + 8 * j);
      float r_[8];
#pragma unroll
      for (int e = 0; e < 8; ++e) { const f32x2 cs = rp[8 * j + e];
        const unsigned wa = e < 2 ? xa.x : e < 4 ? xa.y : e < 6 ? xa.z : xa.w, wb = e < 2 ? xb.x : e < 4 ? xb.y : e < 6 ? xb.z : xb.w;
        const float x1 = (e & 1) ? bf_hi(wa) : bf_lo(wa), x2 = (e & 1) ? bf_hi(wb) : bf_lo(wb);
        r_[e] = QC * (hi ? (x1 * cs.y + x2 * cs.x) : (x1 * cs.x - x2 * cs.y)); }
      f[2 * j] = (int)pk4_fp8(r_[0], r_[1], r_[2], r_[3]); f[2 * j + 1] = (int)pk4_fp8(r_[4], r_[5], r_[6], r_[7]);
    }
    qf[2] = f;
  }
  unsigned oK, oP; const unsigned oV = (unsigned)(wid * 1024 + lane * 16);
  { const int row = 8 * wid + (lane >> 3), c = (lane & 7) ^ ((row >> 1) & 7); oK = (unsigned)(row * LDKN8 + c * 16); }
  { const int row = 16 * (wid & 3) + (lane >> 2), c = (lane & 3) ^ ((row >> 2) & 3); oP = (unsigned)(row * LDKP8 + c * 16); }
#define ISSUE(b, k0) do { const char* vsrc_ = (const char*)Vp + (size_t)(k0) * 128; const char* ksrc_ = (const char*)Kn + (size_t)(k0) * LDKN8; const char* psrc_ = (const char*)Kp + (size_t)(k0) * LDKP8; \
    ATT_GLDS(vsrc_ + oV, V_lds + (b) * SHM_V + wid * 1024); \
    ATT_GLDS(ksrc_ + oK, KN_lds + (b) * SHM_KN + wid * 1024); \
    if (wid < 4) ATT_GLDS(psrc_ + oP, KR_lds + (b) * SHM_KR + wid * 1024); } while (0)
  const LAS char* vla0 = V_lds + r32 * 64 + (((2 * hi) ^ ((r32 >> 2) & 3)) << 4);
  const LAS char* vlb0 = V_lds + r32 * 64 + (((2 * hi + 1) ^ ((r32 >> 2) & 3)) << 4);
#define RESC(a) do { if (__any((a) < 1.f)) { if (hi == 0) al_l[r32] = (a); asm volatile("s_nop 15\n\ts_nop 15\n\ts_waitcnt lgkmcnt(0)" ::: "memory");   \
    _Pragma("unroll") for (int d = 0; d < 4; ++d) _Pragma("unroll") for (int r = 0; r < 16; ++r) o[d][r] *= al_l[crow(r, hi)]; asm volatile("s_nop 4" ::: "memory"); } } while (0)
  f32x16 pA0, pA1, pB0, pB1; float alA, alB; v6i pf; const int NT = seq / KVBLK;
  v8i k0[3], k1[3]; v6i vf[2];
#define SLOT_NEXT(x) ((x) == NSLOT - 1 ? 0 : (x) + 1)
#define SLOT_PREV(x) ((x) == 0 ? NSLOT - 1 : (x) - 1)
#define KLOAD(sl_) k_load_nope(k0, k1, KN_lds + (sl_) * SHM_KN, r32, hi)
#define VLOAD(sl_) pv_loadv(vf, vla0 + (sl_) * SHM_V, vlb0 + (sl_) * SHM_V)
#define WAIT_TILES2() do { if (wid < 4) { ATT_WAITV(6); } else { ATT_WAITV(4); } } while (0)
#define STEP(j_, Pn0, Pn1, alN, Po0, Po1, alO) do { const int sm1_ = SLOT_PREV(s0), sp1_ = SLOT_NEXT(s0); f32x2 s2_ = {0.f, 0.f}; float ma_, mb_; v6i v2_, v3_; \
    const LAS char* va_ = vla0 + sm1_ * SHM_V; const LAS char* vb_ = vlb0 + sm1_ * SHM_V; \
    SBAR(); k_load_pe(k0, k1, KR_lds + s0 * SHM_KR, r32, hi); SBAR(); \
    ATT_MFMA8_FIRST(Pn0, k0[0], qf[0]); SBAR(); fin_chunk<0>(Po0, Po1, s2_, pf); SBAR(); \
    ATT_MFMA8_FIRST(Pn1, k1[0], qf[0]); SBAR(); fin_chunk<1>(Po0, Po1, s2_, pf); SBAR(); \
    ATT_MFMA8(Pn0, k0[1], qf[1]); SBAR(); fin_chunk<2>(Po0, Po1, s2_, pf); SBAR(); \
    ATT_MFMA8(Pn1, k1[1], qf[1]); SBAR(); VLOAD(sm1_); fin_chunk<3>(Po0, Po1, s2_, pf); SBAR(); p_pack6(Po0, Po1, pf); SBAR();     \
    ATT_MFMA8(Pn0, k0[2], qf[2]); SBAR(); fin_tail(s2_, alO, l_reg); SBAR(); \
    ATT_MFMA8(Pn1, k1[2], qf[2]); SBAR(); \
    ATT_PVMFMA(o[0], vf[0]); SBAR(); v2_ = pv_ldv<2>(va_, vb_); v3_ = pv_ldv<3>(va_, vb_); part_max(Pn0, ma_, mb_, true); SBAR(); \
    ATT_PVMFMA(o[1], vf[1]); SBAR(); part_max(Pn1, ma_, mb_, false); KLOAD(sp1_); SBAR(); \
    ATT_PVMFMA(o[2], v2_); SBAR(); part_decide(ma_, mb_, Pn0, Pn1, nm, alN); SBAR(); \
    ATT_PVMFMA(o[3], v3_); SBAR(); \
    RESC(alN); \
    if ((j_) + 4 < NT) { WAIT_TILES2(); } else { ATT_WAITV(0); }        \
    ATT_BAR();                                                           \
    if ((j_) + 5 < NT) { ISSUE(sm1_, ((j_) + 5) * KVBLK); } \
    s0 = sp1_; } while (0)
  ISSUE(0, 0); ISSUE(1, KVBLK); ISSUE(2, 2 * KVBLK); ISSUE(3, 3 * KVBLK); ISSUE(4, 4 * KVBLK);
  if (wid < 4) { ATT_WAITV(9); } else { ATT_WAITV(6); }
  ATT_BAR();
  KLOAD(0); qk_mma(pA0, pA1, k0, k1, KR_lds, qf, nm, r32, hi, sc); ATT_MFMA_SETTLE(); SBAR(); KLOAD(1); partialSM(pA0, pA1, nm, alA, true);
  WAIT_TILES2(); ATT_BAR();
  ISSUE(5, 5 * KVBLK);
  int s0 = 1;
  for (int j = 1; j + 1 < NT; j += 2) {
    STEP(j, pB0, pB1, alB, pA0, pA1, alA);
    STEP(j + 1, pA0, pA1, alA, pB0, pB1, alB);
  }
  { const int sm1_ = SLOT_PREV(s0);
    SBAR(); qk_mma(pB0, pB1, k0, k1, KR_lds + s0 * SHM_KR, qf, nm, r32, hi, sc); VLOAD(sm1_); SBAR();
    finishSM(pA0, pA1, alA, l_reg, pf); SBAR();
    pv_mma(o, vf, vla0 + sm1_ * SHM_V, vlb0 + sm1_ * SHM_V, pf, sc); SBAR(); VLOAD(s0); partialSM(pB0, pB1, nm, alB, false);
    RESC(alB);
    finishSM(pB0, pB1, alB, l_reg, pf); SBAR();
    pv_mma(o, vf, vla0 + s0 * SHM_V, vlb0 + s0 * SHM_V, pf, sc); }
  asm volatile("s_nop 15\n\ts_nop 15" ::: "memory");
  if (hi == 0) li_l[r32] = l_reg; asm volatile("s_waitcnt lgkmcnt(0)" ::: "memory");
  float rli[16];
#pragma unroll
  for (int r = 0; r < 16; ++r) rli[r] = (OSCALE / VSC6) * __builtin_amdgcn_rcpf(li_l[crow(r, hi)]);
  unsigned char* Ow = Ob + (long)(wid * QBLK) * LDO;
#pragma unroll
  for (int r = 0; r < 16; ++r) { const int orow = crow(r, hi);
#pragma unroll
    for (int d0 = 0; d0 < 4; ++d0) Ow[(long)orow * LDO + d0 * 32 + r32] = (unsigned char)(__builtin_amdgcn_cvt_pk_fp8_f32(o[d0][r] * rli[r], 0.f, 0, false) & 0xff); }
  ATT_BAR();
#undef ISSUE
#undef STEP
#undef RESC
}
}

constexpr int RING_OFF = 0, RING_BYTES = 131072;
constexpr int LDSCTL_OFF = RING_BYTES, MISC_OFF = LDSCTL_OFF + 320;
constexpr int LDS_BYTES = 147456;
constexpr int NWAVES = 8;
static_assert(att::LDS_BYTES <= RING_BYTES, "attention LDS");

typedef GAS unsigned gu32;
#define RLX_AGENT __ATOMIC_RELAXED, __HIP_MEMORY_SCOPE_AGENT
#define LDS_WAIT() asm volatile("s_waitcnt lgkmcnt(0)" ::: "memory")
#define VM_WAIT() asm volatile("s_waitcnt vmcnt(0)" ::: "memory")

#define XB_TMO      128
#define XB_XCNT(j)  (256  + 64 * (j))
#define XB_XSUB(j)  (1280 + 64 * (j))
#define XB_XGEN(j)  (2304 + 64 * (j))
#define XB_TOP      3328
#define XB_TOPGEN   3392
#define XCD_BAR_WORDS 3456
#define XB_SPIN_CAP (1u << 22)

__device__ __forceinline__ unsigned xb_ld(unsigned* p)              { return __hip_atomic_load(p, __ATOMIC_RELAXED, __HIP_MEMORY_SCOPE_AGENT); }
__device__ __forceinline__ unsigned xb_add(unsigned* p, unsigned v) { return __hip_atomic_fetch_add(p, v, __ATOMIC_RELAXED, __HIP_MEMORY_SCOPE_AGENT); }
__device__ __forceinline__ unsigned xb_xcc_id() { return (unsigned)__builtin_amdgcn_s_getreg((3 << 11) | 20) & 0xFu; }
#define XB_SPIN(cond, bar) do { unsigned _sp = 0; while (cond) { __builtin_amdgcn_s_sleep(1); \
    if ((++_sp & 255u) == 0u) { if (xb_ld(&(bar)[XB_TMO])) break; if (_sp > XB_SPIN_CAP) { atomicAdd(&(bar)[XB_TMO], 1u); break; } } } } while (0)

struct XcdBarrier { unsigned* bar; unsigned x; volatile LAS unsigned* st; };

__device__ __forceinline__ XcdBarrier xcd_barrier_post(unsigned* bar, volatile LAS unsigned* st) {
    XcdBarrier b; b.bar = bar; b.x = xb_xcc_id(); b.st = st;
    if (threadIdx.x == 0) (void)xb_add(&bar[XB_XCNT(b.x)], 1u);
    return b;
}
__device__ __forceinline__ void xcd_barrier_complete(unsigned* bar, unsigned x, unsigned& nloc, unsigned& nx) {
    const unsigned G = gridDim.x * gridDim.y * gridDim.z;
    unsigned sum, cnt, mine, sp = 0u;
    for (;;) {
        sum = 0u; cnt = 0u; mine = 0u;
#pragma unroll
        for (unsigned j = 0; j < 16; ++j) { const unsigned c = xb_ld(&bar[XB_XCNT(j)]); sum += c; cnt += (c > 0u) ? 1u : 0u; mine = (j == x) ? c : mine; }
        if (sum == G) break;
        __builtin_amdgcn_s_sleep(1);
        if ((++sp & 255u) == 0u) { if (xb_ld(&bar[XB_TMO])) break; if (sp > XB_SPIN_CAP) { atomicAdd(&bar[XB_TMO], 1u); break; } }
    }
    nloc = mine > 0u ? mine : 1u; nx = cnt > 0u ? cnt : 1u;
}
__device__ __forceinline__ void xcd_barrier(const XcdBarrier& b, int tid) {
    asm volatile("s_waitcnt vmcnt(0)" ::: "memory");
    __syncthreads();
    if (tid == 0) {
        unsigned* bar = b.bar;
        __builtin_amdgcn_s_waitcnt(0);
        unsigned nloc = b.st[0], nx = b.st[1];
        if (nloc == 0u) { xcd_barrier_complete(bar, b.x, nloc, nx); b.st[0] = nloc; b.st[1] = nx; }
        const unsigned old = xb_add(&bar[XB_XSUB(b.x)], 1u);
        const unsigned gen = old / nloc;
        if (old + 1u == (gen + 1u) * nloc) {
            __builtin_amdgcn_fence(__ATOMIC_RELEASE, "agent");
            asm volatile("s_waitcnt vmcnt(0)" ::: "memory");
            const unsigned og = xb_add(&bar[XB_TOP], 1u);
            const unsigned tg = og / nx;
            if (og + 1u == (tg + 1u) * nx) xb_add(&bar[XB_TOPGEN], 1u);
            else XB_SPIN(xb_ld(&bar[XB_TOPGEN]) == tg, bar);
            __builtin_amdgcn_fence(__ATOMIC_ACQUIRE, "agent");
            xb_add(&bar[XB_XGEN(b.x)], 1u);
            asm volatile("s_waitcnt vmcnt(0)" ::: "memory");
        } else {
            XB_SPIN(xb_ld(&bar[XB_XGEN(b.x)]) == gen, bar);
            __builtin_amdgcn_fence(__ATOMIC_ACQUIRE, "agent");
            asm volatile("s_waitcnt vmcnt(0)" ::: "memory");
        }
    }
    __syncthreads();
}

struct Args {
    const float* x_prompt; const float* x_sample; const float* norm1; const float* w_in; const float* conv_w; const float* conv_b;
    const float* lru_wa; const float* lru_ba; const float* lru_wx; const float* lru_bx; const float* lru_lam;
    const float* q_norm; const float* w_q_up; const float* kv_norm; const float* w_kv_up; const float* w_lru_proj; const float* w_mla_proj; const float* w_out;
    const float* norm2; const float* w_up; const float* w_down; const float* norm_f;
    float* out; unsigned char* ws; int ph_lo, ph_hi, li, pad;
};

__device__ __forceinline__ float wave_sum(float v) {
    v += __builtin_bit_cast(float, __builtin_amdgcn_ds_swizzle(__builtin_bit_cast(int, v), (1 << 10) | 0x1f));
    v += __builtin_bit_cast(float, __builtin_amdgcn_ds_swizzle(__builtin_bit_cast(int, v), (2 << 10) | 0x1f));
    v += __builtin_bit_cast(float, __builtin_amdgcn_ds_swizzle(__builtin_bit_cast(int, v), (4 << 10) | 0x1f));
    v += __builtin_bit_cast(float, __builtin_amdgcn_ds_swizzle(__builtin_bit_cast(int, v), (8 << 10) | 0x1f));
    v += __builtin_bit_cast(float, __builtin_amdgcn_ds_swizzle(__builtin_bit_cast(int, v), (16 << 10) | 0x1f));
    { const auto rr = __builtin_amdgcn_permlane32_swap(__float_as_uint(v), __float_as_uint(v), false, false); v = __uint_as_float(rr[0]) + __uint_as_float(rr[1]); }
    return v;
}
__device__ __forceinline__ float wave_max(float v) {
    v = fmaxf(v, __builtin_bit_cast(float, __builtin_amdgcn_ds_swizzle(__builtin_bit_cast(int, v), (1 << 10) | 0x1f)));
    v = fmaxf(v, __builtin_bit_cast(float, __builtin_amdgcn_ds_swizzle(__builtin_bit_cast(int, v), (2 << 10) | 0x1f)));
    v = fmaxf(v, __builtin_bit_cast(float, __builtin_amdgcn_ds_swizzle(__builtin_bit_cast(int, v), (4 << 10) | 0x1f)));
    v = fmaxf(v, __builtin_bit_cast(float, __builtin_amdgcn_ds_swizzle(__builtin_bit_cast(int, v), (8 << 10) | 0x1f)));
    v = fmaxf(v, __builtin_bit_cast(float, __builtin_amdgcn_ds_swizzle(__builtin_bit_cast(int, v), (16 << 10) | 0x1f)));
    { const auto rr = __builtin_amdgcn_permlane32_swap(__float_as_uint(v), __float_as_uint(v), false, false); v = fmaxf(__uint_as_float(rr[0]), __uint_as_float(rr[1])); }
    return v;
}
__device__ __forceinline__ void transpose_item(const float* W, int ldw, int k0, int n0, bf16_t* WT, int ldt, int drow0, LAS float* scr, int lane) {
#pragma unroll 8
    for (int i = 0; i < 32; ++i) { const int kk = 2 * i + (lane >> 5); scr[kk * 33 + (lane & 31)] = W[(size_t)(k0 + kk) * ldw + n0 + (lane & 31)]; }
    LDS_WAIT(); asm volatile("" ::: "memory");
    const int c = lane & 7;
#pragma unroll
    for (int j = 0; j < 4; ++j) { const int n = (lane >> 3) + 8 * j; const LAS float* s = scr + (8 * c) * 33 + n;
        u32x4 o; o.x = cvt_pk_bf16(s[0 * 33], s[1 * 33]); o.y = cvt_pk_bf16(s[2 * 33], s[3 * 33]); o.z = cvt_pk_bf16(s[4 * 33], s[5 * 33]); o.w = cvt_pk_bf16(s[6 * 33], s[7 * 33]);
        *(u32x4*)(WT + (size_t)(drow0 + n) * ldt + k0 + 8 * c) = o; }
    LDS_WAIT(); asm volatile("" ::: "memory");
}
template <bool I8 = false> __device__ __forceinline__ void transpose_item_f8(const float* W, int ldw, int k0, int n0, unsigned char* WT, int ldt, int drow0, float mul, LAS float* scr, int lane) {
    float v_[32];
#pragma unroll
    for (int i = 0; i < 32; ++i) { const int kk = 2 * i + (lane >> 5); v_[i] = W[(size_t)(k0 + kk) * ldw + n0 + (lane & 31)]; }
#pragma unroll
    for (int i = 0; i < 32; ++i) { const int kk = 2 * i + (lane >> 5); scr[kk * 33 + (lane & 31)] = v_[i]; }
    LDS_WAIT(); asm volatile("" ::: "memory");
    const int c = lane & 7;
#pragma unroll
    for (int j = 0; j < 4; ++j) { const int n = (lane >> 3) + 8 * j; const LAS float* s = scr + (8 * c) * 33 + n;
        u32x2 o; if constexpr (I8) { o.x = pk4_i8(s[0 * 33], s[1 * 33], s[2 * 33], s[3 * 33], mul); o.y = pk4_i8(s[4 * 33], s[5 * 33], s[6 * 33], s[7 * 33], mul); }
        else { o.x = pk4_fp8(s[0 * 33] * mul, s[1 * 33] * mul, s[2 * 33] * mul, s[3 * 33] * mul); o.y = pk4_fp8(s[4 * 33] * mul, s[5 * 33] * mul, s[6 * 33] * mul, s[7 * 33] * mul); }
        *(u32x2*)(WT + (size_t)(drow0 + n) * ldt + k0 + 8 * c) = o; }
    LDS_WAIT(); asm volatile("" ::: "memory");
}
__device__ __forceinline__ void fwht64(float (&v)[64]) {
#pragma unroll
    for (int s_ = 1; s_ < 64; s_ <<= 1)
#pragma unroll
        for (int i = 0; i < 64; ++i) if ((i & s_) == 0) { const float a = v[i], b = v[i | s_]; v[i] = a + b; v[i | s_] = a - b; }
#pragma unroll
    for (int i = 0; i < 64; ++i) v[i] *= 0.125f;
}
__device__ __forceinline__ void transpose_item_h64_i8(const float* W, int ldw, int k0, int n0, unsigned char* WT, int ldt, int drow0, float qs, LAS float* scr, int lane) {
    float v_[32];
#pragma unroll
    for (int i = 0; i < 32; ++i) { const int kk = 2 * i + (lane >> 5); v_[i] = W[(size_t)(k0 + kk) * ldw + n0 + (lane & 31)]; }
#pragma unroll
    for (int i = 0; i < 32; ++i) { const int kk = 2 * i + (lane >> 5); scr[kk * 33 + (lane & 31)] = v_[i]; }
    LDS_WAIT(); asm volatile("" ::: "memory");
    if (lane < 32) {
        float c_[64];
#pragma unroll
        for (int k = 0; k < 64; ++k) c_[k] = scr[k * 33 + lane];
        fwht64(c_);
#pragma unroll
        for (int k = 0; k < 64; ++k) scr[k * 33 + lane] = c_[k];
    }
    LDS_WAIT(); asm volatile("" ::: "memory");
    const int c = lane & 7;
#pragma unroll
    for (int j = 0; j < 4; ++j) { const int n = (lane >> 3) + 8 * j; const LAS float* s = scr + (8 * c) * 33 + n;
        u32x2 o; o.x = pk4_i8(s[0 * 33], s[1 * 33], s[2 * 33], s[3 * 33], qs); o.y = pk4_i8(s[4 * 33], s[5 * 33], s[6 * 33], s[7 * 33], qs);
        *(u32x2*)(WT + (size_t)(drow0 + n) * ldt + k0 + 8 * c) = o; }
    LDS_WAIT(); asm volatile("" ::: "memory");
}
__device__ __forceinline__ void transpose_item_h32_i8(const float* W, int ldw, int k0, int n0, unsigned char* WT, int ldt, int drow0, float qs, LAS float* scr, int lane) {
    float v_[32];
#pragma unroll
    for (int i = 0; i < 32; ++i) { const int kk = 2 * i + (lane >> 5); v_[i] = W[(size_t)(k0 + kk) * ldw + n0 + (lane & 31)]; }
#pragma unroll
    for (int i = 0; i < 32; ++i) { const int kk = 2 * i + (lane >> 5); scr[kk * 33 + (lane & 31)] = v_[i]; }
    LDS_WAIT(); asm volatile("" ::: "memory");
    { const int n = lane & 31, kb = (lane >> 5) * 32;
      float c_[32];
#pragma unroll
      for (int k = 0; k < 32; ++k) c_[k] = scr[(kb + k) * 33 + n];
#pragma unroll
      for (int s_ = 1; s_ < 32; s_ <<= 1)
#pragma unroll
          for (int i = 0; i < 32; ++i) if ((i & s_) == 0) { const float a = c_[i], b = c_[i | s_]; c_[i] = a + b; c_[i | s_] = a - b; }
#pragma unroll
      for (int k = 0; k < 32; ++k) scr[(kb + k) * 33 + n] = c_[k] * 0.17677669529663689f; }
    LDS_WAIT(); asm volatile("" ::: "memory");
    const int c = lane & 7;
#pragma unroll
    for (int j = 0; j < 4; ++j) { const int n = (lane >> 3) + 8 * j; const LAS float* s = scr + (8 * c) * 33 + n;
        u32x2 o; o.x = pk4_i8(s[0 * 33], s[1 * 33], s[2 * 33], s[3 * 33], qs); o.y = pk4_i8(s[4 * 33], s[5 * 33], s[6 * 33], s[7 * 33], qs);
        *(u32x2*)(WT + (size_t)(drow0 + n) * ldt + k0 + 8 * c) = o; }
    LDS_WAIT(); asm volatile("" ::: "memory");
}
__device__ __forceinline__ void transpose_job(const float* W, int K, int N, bf16_t* WT, int r, LAS float* scr, int lane) {
    const int nblk = N / 32, kb = r / nblk, nb = r % nblk;
    transpose_item(W, N, 64 * kb, 32 * nb, WT, K, 32 * nb, scr, lane);
}

__device__ __forceinline__ void rms_row_to_bf16(const float* xrow, const float* g, bf16_t* orow, int lane, unsigned char* o8row = nullptr) {
    const f32x4* xr = (const f32x4*)xrow + lane; const f32x4* gr = (const f32x4*)g + lane;
    f32x4 v[16]; float s = 0.f;
#pragma unroll
    for (int j = 0; j < 16; ++j) { v[j] = xr[64 * j]; s += (v[j].x * v[j].x + v[j].y * v[j].y) + (v[j].z * v[j].z + v[j].w * v[j].w); }
    const float rstd = 1.0f / sqrtf(wave_sum(s) * (1.f / D) + EPS);
    u32x2* o8 = (u32x2*)orow + lane;
#pragma unroll
    for (int j = 0; j < 16; ++j) { const f32x4 gg = gr[64 * j]; const f32x4 y = v[j] * rstd * gg;
        if (orow) { u32x2 w; w.x = cvt_pk_bf16(y.x, y.y); w.y = cvt_pk_bf16(y.z, y.w); o8[64 * j] = w; }
        if (o8row) ((unsigned*)o8row)[lane + 64 * j] = pk4_i8(y.x, y.y, y.z, y.w, XN_QS); }
}
__device__ __forceinline__ void rms_row_inplace_f32(float* xrow, const float* g, int lane) {
    f32x4* xr = (f32x4*)xrow + lane; const f32x4* gr = (const f32x4*)g + lane;
    f32x4 v[16]; float s = 0.f;
#pragma unroll
    for (int j = 0; j < 16; ++j) { v[j] = xr[64 * j]; s += (v[j].x * v[j].x + v[j].y * v[j].y) + (v[j].z * v[j].z + v[j].w * v[j].w); }
    const float rstd = 1.0f / sqrtf(wave_sum(s) * (1.f / D) + EPS);
#pragma unroll
    for (int j = 0; j < 16; ++j) { const f32x4 gg = gr[64 * j]; xr[64 * j] = v[j] * rstd * gg; }
}

__device__ __forceinline__ void rms_row_from_bf16(const bf16_t* xrow, const float* g, bf16_t* obf, unsigned char* o8, float* of32, int lane) {
    f32x4 v[16]; float s = 0.f;
#pragma unroll
    for (int j = 0; j < 8; ++j) { pg8::unpack8(*(const u32x4*)(xrow + (lane + 64 * j) * 8), v[2 * j], v[2 * j + 1]); }
#pragma unroll
    for (int j = 0; j < 16; ++j) s += (v[j].x * v[j].x + v[j].y * v[j].y) + (v[j].z * v[j].z + v[j].w * v[j].w);
    const float rstd = 1.0f / sqrtf(wave_sum(s) * (1.f / D) + EPS);
#pragma unroll
    for (int j = 0; j < 8; ++j) { const int c = (lane + 64 * j) * 8; const f32x4 y0 = v[2 * j] * rstd * *(const f32x4*)(g + c), y1 = v[2 * j + 1] * rstd * *(const f32x4*)(g + c + 4);
        if (obf) *(u32x4*)(obf + c) = pg8::pack8(y0, y1);
        if (o8) *(u32x2*)(o8 + c) = (u32x2){pk4_i8(y0.x, y0.y, y0.z, y0.w, XN_QS), pk4_i8(y1.x, y1.y, y1.z, y1.w, XN_QS)};
        if (of32) { *(f32x4*)(of32 + c) = y0; *(f32x4*)(of32 + c + 4) = y1; } }
}
__device__ __forceinline__ void lru_gate(float lr, float li, float x, float sp8l2, float& la2, float& u) {
    const float r = fast_sigmoid(lr), i = fast_sigmoid(li);
    la2 = -r * sp8l2;
    const float a = __builtin_amdgcn_exp2f(la2);
    const float m = sqrtf(fmaxf(1.0f - a * a, 0.f));
    u = m * i * x;
}
constexpr int TB_SP8 = 0, TB_GBIAS = 2 * D, TB_NORM1 = TB_GBIAS + NG, TB_NORM2 = TB_NORM1 + D, TB_NORMF = TB_NORM2 + D, TB_CONVW = TB_NORMF + D, TB_CONVB = TB_CONVW + 4 * D,
              TB_QNORM = TB_CONVB + D, TB_KVNORM = TB_QNORM + 1024, TB_END = TB_KVNORM + 512;
static_assert(TB_END * 4 <= (int)MiB, "TAB region");
#ifndef PHMASK
#define PHMASK 0xffffu
#endif
#define EN(b) ((PHMASK >> (b)) & 1u)
#define CAS __attribute__((address_space(4)))
#define PHASE_BEGIN() int tid; asm volatile("v_mbcnt_lo_u32_b32 %0, -1, 0\n\tv_mbcnt_hi_u32_b32 %0, -1, %0" : "=v"(tid)); tid += wave0 * 64;     \
    const CAS Args* kp = (const CAS Args*)__builtin_amdgcn_kernarg_segment_ptr(); int G = G0, bx = bx0, vcu = vcu0; \
    asm volatile("" : "+v"(tid), "+s"(kp), "+s"(G), "+s"(bx), "+s"(vcu)); unsigned char* ws = kp->ws; const int NGW = G * NWAVES; (void)NGW; (void)bx; \
    const int lane = tid & 63, wave = __builtin_amdgcn_readfirstlane(tid >> 6), gw = vcu * NWAVES + wave; (void)lane; (void)wave; (void)gw; \
    float* TAB = (float*)(ws + WS_TAB); (void)TAB

__global__ void __launch_bounds__(NWAVES * 64, 2) fwd(Args args) {
    extern __shared__ __attribute__((aligned(16))) unsigned char lds_raw[];
    LAS unsigned char* lds = (LAS unsigned char*)lds_raw;
    volatile LAS unsigned* MISC = (volatile LAS unsigned*)(lds + MISC_OFF);
    const int wave0 = __builtin_amdgcn_readfirstlane((int)threadIdx.x >> 6);
    const int G0 = gridDim.x, bx0 = blockIdx.x;
    const int vcu0 = (G0 % 8 == 0) ? (bx0 % 8) * (G0 / 8) + bx0 / 8 : bx0;
    gu32* ctl = (gu32*)(args.ws + WS_CTL);
    for (int u = threadIdx.x; u < (LDS_BYTES - LDSCTL_OFF) / 4; u += NWAVES * 64) ((LAS unsigned*)(lds + LDSCTL_OFF))[u] = 0u;
    __syncthreads();
    XcdBarrier bar; bar.bar = (unsigned*)(ctl + CW_BAR) + args.li * XCD_BAR_WORDS; bar.x = 0; bar.st = nullptr;
    if (MK_N_LAUNCHES == 0) bar = xcd_barrier_post((unsigned*)(ctl + CW_BAR) + args.li * XCD_BAR_WORDS, MISC + 8);
    const int lo = args.ph_lo, hi = args.ph_hi;
#define IN(k) (lo <= (k) && (k) < hi)
#define SEAM(k) do { if ((k) + 1 < hi) { if (MK_N_LAUNCHES == 0) xcd_barrier(bar, tid); } } while (0)

    if (EN(0) && IN(0)) {
        PHASE_BEGIN();
        bf16_t* WIN_T = (bf16_t*)(ws + WS_WIN); bf16_t* WG_T = (bf16_t*)(ws + WS_WG);
        LAS float* scr = (LAS float*)(lds + RING_OFF + wave * 16384);
        constexpr int I_IN = (D / 64) * (IN_COLS / 32);
        constexpr int I_G = 64 * 32;
        constexpr int I_Q = (1024 / 64) * (NQ / 32);
        constexpr int I_KV = (512 / 64) * (NKV / 32);
        constexpr int I_SQ = (D / 64) * (D / 32);
        constexpr int I_UP = (D / 64) * (DFF / 32);
        constexpr int I_DN = (DFF / 64) * (D / 32);
        constexpr int NITEMS = I_IN + I_G + I_Q + I_KV + 3 * I_SQ + I_UP + I_DN;
        for (int it = gw; it < NITEMS; it += NGW) {
            int r = it;
            if (r < I_IN) { const int nblk = IN_COLS / 32, kb = r / nblk, nb = r % nblk, n0 = 32 * nb;
                transpose_item_f8<true>(kp->w_in, IN_COLS, 64 * kb, n0, (unsigned char*)WIN_T, D, n0 < SRC_GATE ? n0 : n0 + 192, WIN_QS, scr, lane);
                continue; } r -= I_IN;
            if (r < I_G) { const int mat = r >> 5, sub = r & 31, kb = sub >> 3, nb = sub & 7;
                const int isx = mat & 1, hb = (mat >> 1) & 15, dir = mat >> 5; const float* W = (isx ? kp->lru_wx : kp->lru_wa) + (size_t)(dir * 16 + hb) * 65536;
                transpose_item(W, 256, 64 * kb, 32 * nb, WG_T, 256, (hb * 4 + dir * 2 + (nb >> 2)) * 256 + isx * 128 + (nb & 3) * 32, scr, lane); continue; } r -= I_G;
            if (r < I_Q) { const int nblk = NQ / 32, kb = r / nblk, nb = r % nblk; transpose_item_f8(kp->w_q_up, NQ, 64 * kb, 32 * nb, (unsigned char*)(ws + WS_WQ), 1024, 32 * nb, 64.0f, scr, lane); continue; } r -= I_Q;
            if (r < I_KV) { const int nblk = NKV / 32, kb = r / nblk, nb = r % nblk; transpose_item_f8(kp->w_kv_up, NKV, 64 * kb, 32 * nb, (unsigned char*)(ws + WS_WKV), 512, 32 * nb, 64.0f, scr, lane); continue; } r -= I_KV;
            if (r < I_SQ) { const int nblk = D / 32, kb = r / nblk, nb = r % nblk; transpose_item_h64_i8(kp->w_lru_proj, D, 64 * kb, 32 * nb, (unsigned char*)(ws + WS_WLP), D, 32 * nb, WSQ_QS, scr, lane); continue; } r -= I_SQ;
            if (r < I_SQ) { const int nblk = D / 32, kb = r / nblk, nb = r % nblk; transpose_item_f8(kp->w_mla_proj, D, 64 * kb, 32 * nb, (unsigned char*)(ws + WS_WMP), D, 32 * nb, 64.0f, scr, lane); continue; } r -= I_SQ;
            if (r < I_SQ) { const int nblk = D / 32, kb = r / nblk, nb = r % nblk; transpose_item_h32_i8(kp->w_out, D, 64 * kb, 32 * nb, (unsigned char*)(ws + WS_WO), D, 32 * nb, WSQ_QS, scr, lane); continue; } r -= I_SQ;
            if (r < I_UP) { const int nblk = DFF / 32, kb = r / nblk, nb = r % nblk, n0 = 32 * nb;
                if (n0 < NUP8) transpose_item_f8<true>(kp->w_up, DFF, 64 * kb, n0, (unsigned char*)(ws + WS_WUP), D, n0, WSQ_QS, scr, lane);
                else transpose_item(kp->w_up, DFF, 64 * kb, n0, (bf16_t*)(ws + WS_WUPB), D, n0 - NUP8, scr, lane);
                continue; } r -= I_UP;
            transpose_job(kp->w_down, DFF, D, (bf16_t*)(ws + WS_WDN), r, scr, lane);
        }
        const int gt = vcu * (NWAVES * 64) + tid, NGT = G * NWAVES * 64;
        for (int i = gt; i < 192 * D / 16; i += NGT) *(u32x4*)(ws + WS_WIN + (size_t)SRC_GATE * D + (size_t)i * 16) = (u32x4){0u, 0u, 0u, 0u};
        f32x2* ROPE = (f32x2*)(ws + WS_ROPE);
        for (int i = gt; i < SEQ_P * 32; i += NGT) { const int pos = i >> 5, k = i & 31;
            const float inv = 1.0f / powf(10000.0f, (float)k * (1.0f / 32.0f)); const float ang = (float)pos * inv;
            const double rev = (double)ang * 0.15915494309189535; const float fr = (float)(rev - __builtin_rint(rev));
            ROPE[i] = (f32x2){__builtin_amdgcn_cosf(fr), __builtin_amdgcn_sinf(fr)}; }
        for (int i = gt; i < 2 * D; i += NGT) { const float lam = kp->lru_lam[i]; TAB[TB_SP8 + i] = 8.0f * 1.4426950408889634f * log1pf(expf(-lam)); }
        for (int i = gt; i < NG; i += NGT) { const int hb = i >> 10, gate = (i >> 8) & 3, j = i & 255, dir = gate >> 1, isx = gate & 1;
            TAB[TB_GBIAS + i] = (isx ? kp->lru_bx : kp->lru_ba)[(dir * 16 + hb) * 256 + j]; }
        for (int i = gt; i < D; i += NGT) { TAB[TB_NORM1 + i] = kp->norm1[i]; TAB[TB_NORM2 + i] = kp->norm2[i]; TAB[TB_NORMF + i] = kp->norm_f[i]; TAB[TB_CONVB + i] = kp->conv_b[i]; }
        for (int i = gt; i < 4 * D; i += NGT) TAB[TB_CONVW + i] = kp->conv_w[i];
        for (int i = gt; i < 1024; i += NGT) TAB[TB_QNORM + i] = kp->q_norm[i];
        for (int i = gt; i < 512; i += NGT) TAB[TB_KVNORM + i] = kp->kv_norm[i];
        { bf16_t* XN = (bf16_t*)(ws + WS_XN);
          for (int m = gw; m < MG; m += NGW) rms_row_to_bf16(kp->x_prompt + (size_t)m * D, kp->norm1, nullptr, lane, ws + WS_XN8 + (size_t)m * D); }
        SEAM(0);
    }

    for (int grp = 0; grp < NGROUP; ++grp) {
        const int pb = 1 + grp * 7;
        if (hi <= pb || lo >= pb + 7) continue;
        const int L = grp == 0 ? SEQ_P : SEQ_S;
#define XG() (grp == 0 ? kp->x_prompt : kp->x_sample + (size_t)(grp - 1) * MG * D)
#define OUTG() (kp->out + (size_t)grp * MG * D)
#define KVB() ((bf16_t*)OUTG())

        if (EN(2) && IN(pb + 0)) {
            PHASE_BEGIN();
            {
              pg8::Gemm g{(bf16_t*)(ws + WS_XN8), (bf16_t*)(ws + WS_WIN), MG, NZ, D / 2, D / 2, D / 2, 0, 0}; pg8::StaticOrder S; S.init(MG, NZ, G, bx);
              pg8::EpiZ E{(bf16_t*)(ws + WS_Z), NZ, 0, 1.0f / (XN_QS * WIN_QS)};
              pg8::gemm_phase<pg8::EpiZ, pg8::StaticOrder, true, true, 2>(lds + RING_OFF, g, S, E, tid); }
            SEAM(pb + 0);
        }
        if (EN(3) && IN(pb + 1)) {
            PHASE_BEGIN();
            const bf16_t* Z = (const bf16_t*)(ws + WS_Z); bf16_t* XC = (bf16_t*)(ws + WS_XC); bf16_t* CQN = (bf16_t*)(ws + WS_CQN); bf16_t* CKVN = (bf16_t*)(ws + WS_CKVN); bf16_t* KPE = (bf16_t*)(ws + WS_KPE);
            const f32x2* ROPE = (const f32x2*)(ws + WS_ROPE);
            for (int mb = gw; mb < MG / 4; mb += NGW) {
              const int m0 = mb * 4, pos0 = m0 % L;
#pragma unroll 1
              for (int j = 0; j < 8; ++j) { const int ch = lane * 8 + 512 * j;
                  float wgt[4][8], bia[8];
                  { const f32x4 b0 = *(const f32x4*)(TAB + TB_CONVB + ch), b1 = *(const f32x4*)(TAB + TB_CONVB + ch + 4);
                    bia[0] = b0.x; bia[1] = b0.y; bia[2] = b0.z; bia[3] = b0.w; bia[4] = b1.x; bia[5] = b1.y; bia[6] = b1.z; bia[7] = b1.w; }
#pragma unroll
                  for (int k = 0; k < 4; ++k) { const f32x4 w0 = *(const f32x4*)(TAB + TB_CONVW + k * D + ch), w1 = *(const f32x4*)(TAB + TB_CONVW + k * D + ch + 4);
                      wgt[k][0] = w0.x; wgt[k][1] = w0.y; wgt[k][2] = w0.z; wgt[k][3] = w0.w; wgt[k][4] = w1.x; wgt[k][5] = w1.y; wgt[k][6] = w1.z; wgt[k][7] = w1.w; }
                  u32x4 xr[7];
#pragma unroll
                  for (int i = 0; i < 7; ++i) { const int pp = pos0 + i - 2, pc = pp < 0 ? 0 : (pp >= L ? L - 1 : pp);
                      const u32x4 t_ = *(const u32x4*)(Z + (size_t)(m0 - pos0 + pc) * NZ + ch); const unsigned k_ = (pp >= 0 && pp < L) ? 0xffffffffu : 0u;
                      xr[i] = (u32x4){t_.x & k_, t_.y & k_, t_.z & k_, t_.w & k_}; }
#pragma unroll
                  for (int r = 0; r < 4; ++r) { float a[8];
#pragma unroll
                      for (int e = 0; e < 8; ++e) a[e] = bia[e];
#pragma unroll
                      for (int k = 0; k < 4; ++k) { const u32x4 xv = xr[r + k];
                          a[0] += wgt[k][0] * bf_lo(xv.x); a[1] += wgt[k][1] * bf_hi(xv.x); a[2] += wgt[k][2] * bf_lo(xv.y); a[3] += wgt[k][3] * bf_hi(xv.y);
                          a[4] += wgt[k][4] * bf_lo(xv.z); a[5] += wgt[k][5] * bf_hi(xv.z); a[6] += wgt[k][6] * bf_lo(xv.w); a[7] += wgt[k][7] * bf_hi(xv.w); }
                      u32x4 o; o.x = cvt_pk_bf16(a[0], a[1]); o.y = cvt_pk_bf16(a[2], a[3]); o.z = cvt_pk_bf16(a[4], a[5]); o.w = cvt_pk_bf16(a[6], a[7]);
                      *(u32x4*)(XC + (size_t)(m0 + r) * D + ch) = o; } }
#pragma unroll 1
              for (int r4 = 0; r4 < 4; ++r4) { const int m = m0 + r4, pos = pos0 + r4;
                const bf16_t* zr = Z + (size_t)m * NZ;
                {
                    f32x4 v[4]; float s = 0.f;
#pragma unroll
                    for (int j = 0; j < 2; ++j) { pg8::unpack8(*(const u32x4*)(zr + ZC_CQ + lane * 8 + 512 * j), v[2 * j], v[2 * j + 1]); }
#pragma unroll
                    for (int j = 0; j < 4; ++j) s += (v[j].x * v[j].x + v[j].y * v[j].y) + (v[j].z * v[j].z + v[j].w * v[j].w);
                    const float rstd = 1.0f / sqrtf(wave_sum(s) * (1.f / 1024.f) + EPS);
#pragma unroll
                    for (int j = 0; j < 2; ++j) { const int c = lane * 8 + 512 * j; const f32x4 g0 = *(const f32x4*)(TAB + TB_QNORM + c), g1 = *(const f32x4*)(TAB + TB_QNORM + c + 4);
                        const f32x4 y0 = v[2 * j] * rstd * g0, y1 = v[2 * j + 1] * rstd * g1;
                        *(u32x2*)((unsigned char*)CQN + (size_t)m * 1024 + c) = (u32x2){pk4_fp8(y0.x, y0.y, y0.z, y0.w), pk4_fp8(y1.x, y1.y, y1.z, y1.w)}; }
                }
                {
                    f32x4 v0, v1; pg8::unpack8(*(const u32x4*)(zr + ZC_CKV + lane * 8), v0, v1);
                    float s = (v0.x * v0.x + v0.y * v0.y) + (v0.z * v0.z + v0.w * v0.w) + (v1.x * v1.x + v1.y * v1.y) + (v1.z * v1.z + v1.w * v1.w);
                    const float rstd = 1.0f / sqrtf(wave_sum(s) * (1.f / 512.f) + EPS);
                    const int c = lane * 8; const f32x4 g0 = *(const f32x4*)(TAB + TB_KVNORM + c), g1 = *(const f32x4*)(TAB + TB_KVNORM + c + 4);
                    const f32x4 y0 = v0 * rstd * g0, y1 = v1 * rstd * g1;
                    *(u32x2*)((unsigned char*)CKVN + (size_t)m * 512 + c) = (u32x2){pk4_fp8(y0.x, y0.y, y0.z, y0.w), pk4_fp8(y1.x, y1.y, y1.z, y1.w)};
                }
                if (lane < 32) {
                    const float x1 = __uint_as_float(((unsigned)zr[ZC_KR + lane]) << 16), x2 = __uint_as_float(((unsigned)zr[ZC_KR + 32 + lane]) << 16);
                    const f32x2 cs = ROPE[(size_t)pos * 32 + lane];
                    ((unsigned char*)KPE)[(size_t)m * 64 + lane] = (unsigned char)(__builtin_amdgcn_cvt_pk_fp8_f32(x1 * cs.x - x2 * cs.y, 0.f, 0, false) & 0xff);
                    ((unsigned char*)KPE)[(size_t)m * 64 + 32 + lane] = (unsigned char)(__builtin_amdgcn_cvt_pk_fp8_f32(x1 * cs.y + x2 * cs.x, 0.f, 0, false) & 0xff);
                }
              }
            }
            SEAM(pb + 1);
        }
        if (EN(4) && IN(pb + 2)) {
            PHASE_BEGIN();
            { pg8::Gemm g{(bf16_t*)(ws + WS_XC), (bf16_t*)(ws + WS_WG), MG, NG, 256, D, 256, 2, 256}; pg8::StaticOrder S; S.init(MG, NG, G, bx);
              pg8::EpiLru E{(bf16_t*)(ws + WS_G), (const bf16_t*)(ws + WS_XC), TAB + TB_GBIAS, TAB + TB_SP8, (f32x2*)(ws + WS_SUM), (LAS f32x2*)(lds + LDSCTL_OFF + 2048)};
              pg8::gemm_phase<pg8::EpiLru, pg8::StaticOrder, true, false, 0, true>(lds + RING_OFF, g, S, E, tid); }
            { pg8::Gemm g{(bf16_t*)(ws + WS_CQN), (bf16_t*)(ws + WS_WQ), MG, NQ, 512, 512, 512, 0, 0}; pg8::StaticOrder S; S.init(MG, NQ, G, bx);
              pg8::EpiBf16<0> E{(bf16_t*)(ws + WS_Q), NQ, 1.0f / 64.0f};
              pg8::gemm_phase<pg8::EpiBf16<0>, pg8::StaticOrder, true, true, 1>(lds + RING_OFF, g, S, E, tid); }
            { pg8::Gemm g{(bf16_t*)(ws + WS_CKVN), (bf16_t*)(ws + WS_WKV), MG, NKV, 256, 256, 256, 0, 0}; pg8::StaticOrder S; S.init(MG, NKV, G, bx);
              pg8::EpiKV E{(unsigned char*)KVB(), (unsigned char*)KVB() + (size_t)MG * 4096, 1.0f / 64.0f};
              pg8::gemm_phase<pg8::EpiKV, pg8::StaticOrder, true, false, 1>(lds + RING_OFF, g, S, E, tid); }
            SEAM(pb + 2);
        }
        if (EN(6) && IN(pb + 3)) {
            PHASE_BEGIN();
            const bf16_t* GB = (const bf16_t*)(ws + WS_G); const f32x2* SUM = (const f32x2*)(ws + WS_SUM);
            const bf16_t* Z = (const bf16_t*)(ws + WS_Z); bf16_t* ALRU = (bf16_t*)(ws + WS_XN);
            const int ncs = L / CHUNK;
            for (int u = vcu; u < NCHUNK * 4; u += G) {
                const int c = u >> 2, cb = u & 3, ch = cb * 1024 + tid * 2, hb = ch >> 8, jj = ch & 255, t0 = c * CHUNK;
                const int c_lo = (c / ncs) * ncs, c_hi = c_lo + ncs;
                const bf16_t* gp = GB + (size_t)hb * 1024 + jj; const bf16_t* yp = Z + ZC_Y + ch; bf16_t* ap = ALRU + ch;
                float hf0 = 0.f, hf1 = 0.f, hr0 = 0.f, hr1 = 0.f;
#pragma unroll 4
                for (int cc = c_lo; cc < c; ++cc) { const f32x4 s = *(const f32x4*)(SUM + ((size_t)(cc * 2 + 0) * D + ch)); hf0 = s.x * hf0 + s.y; hf1 = s.z * hf1 + s.w; }
#pragma unroll 4
                for (int cc = c_hi - 1; cc > c; --cc) { const f32x4 s = *(const f32x4*)(SUM + ((size_t)(cc * 2 + 1) * D + ch)); hr0 = s.x * hr0 + s.y; hr1 = s.z * hr1 + s.w; }
                { unsigned wn[8][2], wc_[8][2];
#define P6F_LOAD(W, g_) _Pragma("unroll") for (int s_ = 0; s_ < 8; ++s_) { const size_t tf_ = (size_t)(t0 + 8 * (g_) + s_); W[s_][0] = *(const unsigned*)(gp + tf_ * NG); W[s_][1] = *(const unsigned*)(gp + tf_ * NG + 256); }
                  P6F_LOAD(wn, 0);
#pragma unroll 1
                  for (int g8 = 0; g8 < CHUNK / 8; ++g8) {
#pragma unroll
                    for (int s_ = 0; s_ < 8; ++s_) { wc_[s_][0] = wn[s_][0]; wc_[s_][1] = wn[s_][1]; }
                    if (g8 + 1 < CHUNK / 8) { P6F_LOAD(wn, g8 + 1); }
#pragma unroll
                    for (int s_ = 0; s_ < 8; ++s_) { const size_t tf = (size_t)(t0 + 8 * g8 + s_);
                        hf0 = __builtin_amdgcn_exp2f(bf_lo(wc_[s_][0])) * hf0 + bf_lo(wc_[s_][1]); hf1 = __builtin_amdgcn_exp2f(bf_hi(wc_[s_][0])) * hf1 + bf_hi(wc_[s_][1]);
                        *(unsigned*)(ap + tf * D) = cvt_pk_bf16(hf0, hf1); }
                  }
#undef P6F_LOAD
                }
                { unsigned wn[4][4], wc_[4][4];
#define P6R_LOAD(W, g_) _Pragma("unroll") for (int s_ = 0; s_ < 4; ++s_) { const size_t tr_ = (size_t)(t0 + CHUNK - 1 - 4 * (g_) - s_); W[s_][0] = *(const unsigned*)(gp + tr_ * NG + 512); W[s_][1] = *(const unsigned*)(gp + tr_ * NG + 768); \
                    W[s_][2] = *(const unsigned*)(yp + tr_ * NZ); W[s_][3] = *(const unsigned*)(ap + tr_ * D); }
                  P6R_LOAD(wn, 0);
#pragma unroll 1
                  for (int g4 = 0; g4 < CHUNK / 4; ++g4) {
#pragma unroll
                    for (int s_ = 0; s_ < 4; ++s_)
#pragma unroll
                        for (int q_ = 0; q_ < 4; ++q_) wc_[s_][q_] = wn[s_][q_];
                    if (g4 + 1 < CHUNK / 4) { P6R_LOAD(wn, g4 + 1); }
#pragma unroll
                    for (int s_ = 0; s_ < 4; ++s_) { const size_t tr = (size_t)(t0 + CHUNK - 1 - 4 * g4 - s_);
                        hr0 = __builtin_amdgcn_exp2f(bf_lo(wc_[s_][0])) * hr0 + bf_lo(wc_[s_][1]); hr1 = __builtin_amdgcn_exp2f(bf_hi(wc_[s_][0])) * hr1 + bf_hi(wc_[s_][1]);
                        *(unsigned*)(ap + tr * D) = cvt_pk_bf16((bf_lo(wc_[s_][3]) + hr0) * bf_lo(wc_[s_][2]), (bf_hi(wc_[s_][3]) + hr1) * bf_hi(wc_[s_][2])); }
                  }
#undef P6R_LOAD
                }
            }
            {
                const unsigned char* V8 = (const unsigned char*)KVB() + (size_t)MG * 4096; unsigned char* VP = (unsigned char*)KVB() + (size_t)MG * 8192;
                for (int idx = vcu * (NWAVES * 64) + tid; idx < (MG / 64) * 2048; idx += G * NWAVES * 64) {
                    const int T = idx >> 11, hi_ = (idx >> 10) & 1, cg = idx & 1023, h = cg >> 5, cl = (cg & 31) * 4;
                    const unsigned char* src = V8 + (size_t)(T * 64 + 4 * hi_) * 4096 + 4 * cg;
                    int wa[16], wb[16];
#pragma unroll
                    for (int r = 0; r < 16; ++r) { const int k_ = (r & 3) + 8 * (r >> 2); wa[r] = *(const int*)(src + (size_t)k_ * 4096); wb[r] = *(const int*)(src + (size_t)(32 + k_) * 4096); }
                    unsigned char* dst = VP + ((size_t)h * (MG / 64) + T) * 8192;
#define V6_COL(i) { f32x16 va_, vb_; \
                        _Pragma("unroll") for (int r = 0; r < 16; ++r) { va_[r] = att::VSC6 * __builtin_amdgcn_cvt_f32_fp8(wa[r], i); vb_[r] = att::VSC6 * __builtin_amdgcn_cvt_f32_fp8(wb[r], i); } \
                        att::v6i w6; asm("v_cvt_scalef32_2xpk16_fp6_f32 %0, %1, %2, 1.0" : "=&v"(w6) : "v"(va_), "v"(vb_)); const int c = cl + i, sw_ = (c >> 2) & 3; \
                        *(u32x4*)(dst + c * 64 + (((2 * hi_) ^ sw_) << 4)) = (u32x4){(unsigned)w6[0], (unsigned)w6[1], (unsigned)w6[2], (unsigned)w6[3]}; \
                        *(u32x4*)(dst + c * 64 + (((2 * hi_ + 1) ^ sw_) << 4)) = (u32x4){(unsigned)w6[4], (unsigned)w6[5], 0u, 0u}; }
                    V6_COL(0) V6_COL(1) V6_COL(2) V6_COL(3)
#undef V6_COL
                }
            }
            SEAM(pb + 3);
        }
        if (EN(7) && IN(pb + 4)) {
            PHASE_BEGIN();
            const bf16_t* QB = (const bf16_t*)(ws + WS_Q); const unsigned char* KPE = (const unsigned char*)(ws + WS_KPE); unsigned char* OB = (unsigned char*)(ws + WS_O);
            const unsigned char* KN8 = (const unsigned char*)KVB(); const unsigned char* VP = (const unsigned char*)KVB() + (size_t)MG * 8192;
            const f32x2* ROPE = (const f32x2*)(ws + WS_ROPE);
            const int nqb = L / 256;
            for (int u = vcu; u < (MG / 256) * 32; u += G) {
                const int sh = u / nqb, qb = u % nqb, sq = sh >> 5, h = sh & 31;
                const size_t row_s = (size_t)sq * L, row_q = row_s + (size_t)qb * 256;
                att::attn_unit(QB + row_q * NQ + h * 192, KN8 + row_s * 4096 + h * 128, VP + ((size_t)h * (MG / 4) + row_s / 4) * 512, KPE + row_s * 64,
                               OB + row_q * D + h * 128, ROPE, qb * 256, L, (LAS char*)(lds + RING_OFF), tid);
            }
            { const bf16_t* AL = (const bf16_t*)(ws + WS_XN); unsigned char* A8 = ws + WS_O + 32 * MiB; float* ROWS = (float*)(ws + WS_SUM);
              for (int m = gw; m < MG; m += NGW) {
                  float v_[64];
#pragma unroll
                  for (int j = 0; j < 8; ++j) { const u32x4 w = *(const u32x4*)(AL + (size_t)m * D + lane * 64 + j * 8);
                      v_[8 * j] = bf_lo(w.x); v_[8 * j + 1] = bf_hi(w.x); v_[8 * j + 2] = bf_lo(w.y); v_[8 * j + 3] = bf_hi(w.y); v_[8 * j + 4] = bf_lo(w.z); v_[8 * j + 5] = bf_hi(w.z); v_[8 * j + 6] = bf_lo(w.w); v_[8 * j + 7] = bf_hi(w.w); }
                  fwht64(v_);
                  float mx = 0.f;
#pragma unroll
                  for (int i = 0; i < 64; ++i) mx = fmaxf(mx, fabsf(v_[i]));
                  mx = wave_max(mx);
                  const float qs = mx > 0.f ? 127.0f / mx : 1.0f;
#pragma unroll
                  for (int j = 0; j < 4; ++j) *(u32x4*)(A8 + (size_t)m * D + lane * 64 + j * 16) =
                      (u32x4){pk4_i8(v_[16 * j], v_[16 * j + 1], v_[16 * j + 2], v_[16 * j + 3], qs), pk4_i8(v_[16 * j + 4], v_[16 * j + 5], v_[16 * j + 6], v_[16 * j + 7], qs),
                              pk4_i8(v_[16 * j + 8], v_[16 * j + 9], v_[16 * j + 10], v_[16 * j + 11], qs), pk4_i8(v_[16 * j + 12], v_[16 * j + 13], v_[16 * j + 14], v_[16 * j + 15], qs)};
                  if (lane == 0) ROWS[m] = 1.0f / qs;
              } }
            SEAM(pb + 4);
        }
        if (EN(9) && IN(pb + 5)) {
            PHASE_BEGIN();
            {
              pg8::Gemm g{(bf16_t*)(ws + WS_O + 32 * MiB), (bf16_t*)(ws + WS_WLP), MG, D, D / 2, D / 2, D / 2, 0, 0}; pg8::StaticOrder S; S.init(MG, D, G, bx, 1);
              pg8::EpiGate<false> E{(bf16_t*)(ws + WS_XC), D, (const bf16_t*)(ws + WS_Z) + ZC_GATE, NZ, nullptr, 0, 1.0f / WSQ_QS, 0.f, (const float*)(ws + WS_SUM)};
              pg8::gemm_phase<pg8::EpiGate<false>, pg8::StaticOrder, true, true, 2>(lds + RING_OFF, g, S, E, tid); }
            pg8::Gemm g{(bf16_t*)(ws + WS_O), (bf16_t*)(ws + WS_WMP), MG, D, D / 2, D / 2, D / 2, 0, 0}; pg8::StaticOrder S; S.init(MG, D, G, bx, 1);
            pg8::EpiGate<true, true> E{(bf16_t*)(ws + WS_XN), D, (const bf16_t*)(ws + WS_Z) + ZC_GATE + D, NZ, (const bf16_t*)(ws + WS_XC), D, 1.0f / (64.0f * att::OSCALE), MERGED_QS, nullptr};
            pg8::gemm_phase<pg8::EpiGate<true, true>, pg8::StaticOrder, true, true, 1>(lds + RING_OFF, g, S, E, tid);
            SEAM(pb + 5);
        }
        if (EN(10) && IN(pb + 6)) {
            PHASE_BEGIN();
            pg8::Gemm g{(bf16_t*)(ws + WS_XN), (bf16_t*)(ws + WS_WO), MG, D, D / 2, D / 2, D / 2, 0, 0}; pg8::StaticOrder S; S.init(MG, D, G, bx, 1);
            pg8::EpiResBf<false> E{XG(), 0, 0, (bf16_t*)OUTG(), 0, 0, D, 1.0f / (MERGED_QS * WSQ_QS)};
            pg8::gemm_phase<pg8::EpiResBf<false>, pg8::StaticOrder, true, true, 2>(lds + RING_OFF, g, S, E, tid);
            if (grp + 1 < NGROUP) {
                const float* xn_src = kp->x_sample + (size_t)grp * MG * D; bf16_t* XN = (bf16_t*)(ws + WS_XN);
                for (int m = gw; m < MG; m += NGW) rms_row_to_bf16(xn_src + (size_t)m * D, TAB + TB_NORM1, nullptr, lane, ws + WS_XN8 + (size_t)m * D);
            }
            SEAM(pb + 6);
        }
    }
    {
        constexpr int pm_ = 1 + NGROUP * 7;
        if (EN(11) && IN(pm_ + 0)) {
            PHASE_BEGIN();
            const bf16_t* hb = (const bf16_t*)kp->out; bf16_t* N2 = (bf16_t*)(ws + WS_N2ALL);
            for (int m = gw; m < MTOT; m += NGW) rms_row_from_bf16(hb + (size_t)(m >> 13) * ((size_t)MG * D * 2) + (size_t)(m & (MG - 1)) * D, TAB + TB_NORM2, N2 + (size_t)m * D, ws + WS_N2I8 + (size_t)m * D, nullptr, lane);
            SEAM(pm_ + 0);
        }
        if (EN(12) && IN(pm_ + 1)) {
            PHASE_BEGIN();
            {
              pg8::Gemm g{(bf16_t*)(ws + WS_N2I8), (bf16_t*)(ws + WS_WUP), MTOT, NUP8, D / 2, D / 2, D / 2, 0, 0}; pg8::StaticOrder S; S.init(MTOT, NUP8, G, bx);
              pg8::EpiBf16<1> E{(bf16_t*)(ws + WS_HALL), DFF, 1.0f / (XN_QS * WSQ_QS)};
              pg8::gemm_phase<pg8::EpiBf16<1>, pg8::StaticOrder, true, true, 2>(lds + RING_OFF, g, S, E, tid); }
            {
              pg8::Gemm g{(bf16_t*)(ws + WS_N2ALL), (bf16_t*)(ws + WS_WUPB), MTOT, DFF - NUP8, D, D, D, 0, 0}; pg8::StaticOrder S; S.init(MTOT, DFF - NUP8, G, bx);
              pg8::EpiBf16<1> E{(bf16_t*)(ws + WS_HALL) + NUP8, DFF, 1.0f};
              pg8::gemm_phase<pg8::EpiBf16<1>, pg8::StaticOrder, true, true>(lds + RING_OFF, g, S, E, tid); }
            SEAM(pm_ + 1);
        }
        if (EN(13) && IN(pm_ + 2)) {
            PHASE_BEGIN();
            pg8::Gemm g{(bf16_t*)(ws + WS_HALL), (bf16_t*)(ws + WS_WDN), MTOT, D, DFF, DFF, DFF, 0, 0}; pg8::StaticOrder S; S.init(MTOT, D, G, bx, 1);
            pg8::EpiResBf<true> E{kp->out, MG, (size_t)MG * D * 2, (bf16_t*)(ws + WS_N2ALL), 0, 0, D, 1.0f};
            pg8::gemm_phase<pg8::EpiResBf<true>, pg8::StaticOrder, true, true>(lds + RING_OFF, g, S, E, tid);
            SEAM(pm_ + 2);
        }
        if (EN(14) && IN(pm_ + 3)) {
            PHASE_BEGIN();
            float* og = kp->out; const bf16_t* X2 = (const bf16_t*)(ws + WS_N2ALL);
            for (int m = gw; m < MTOT; m += NGW) rms_row_from_bf16(X2 + (size_t)m * D, TAB + TB_NORMF, nullptr, nullptr, og + (size_t)m * D, lane);
            SEAM(pm_ + 3);
        }
    }
#undef IN
#undef SEAM
}

constexpr int NPHASES = 1 + NGROUP * 7 + 4;
extern "C" void kernel_launch(void* const* d_in, const int* in_sizes, int n_in, void* d_out, int out_size, void* d_ws, size_t ws_size, hipStream_t stream) {
    static int grid = 0;
    if (grid == 0) {
        if (n_in != 22 || out_size != MTOT * D || ws_size < WS_END) { fprintf(stderr, "kernel_launch: shape/workspace mismatch (n_in %d out %d ws %zu need %zu)\n", n_in, out_size, ws_size, (size_t)WS_END); grid = -1; return; }
        int dev = 0, cus = 0;
        if (hipGetDevice(&dev) != hipSuccess || hipDeviceGetAttribute(&cus, hipDeviceAttributeMultiprocessorCount, dev) != hipSuccess) { grid = -1; return; }
        if (hipFuncSetAttribute((const void*)fwd, hipFuncAttributeMaxDynamicSharedMemorySize, LDS_BYTES) != hipSuccess) { fprintf(stderr, "kernel_launch: hipFuncSetAttribute failed\n"); grid = -1; return; }
        int per_cu = 0;
        if (hipOccupancyMaxActiveBlocksPerMultiprocessor(&per_cu, (const void*)fwd, NWAVES * 64, LDS_BYTES) != hipSuccess || per_cu < 1) fprintf(stderr, "kernel_launch: occupancy query says %d\n", per_cu);
        (void)hipGetLastError();
        grid = cus;
    }
    if (grid < 0) return;
    (void)hipMemsetAsync((char*)d_ws + WS_CTL, 0, CTL_ZERO_BYTES, stream);
    Args a{};
    a.x_prompt = (const float*)d_in[0]; a.x_sample = (const float*)d_in[1]; a.norm1 = (const float*)d_in[2]; a.w_in = (const float*)d_in[3]; a.conv_w = (const float*)d_in[4]; a.conv_b = (const float*)d_in[5];
    a.lru_wa = (const float*)d_in[6]; a.lru_ba = (const float*)d_in[7]; a.lru_wx = (const float*)d_in[8]; a.lru_bx = (const float*)d_in[9]; a.lru_lam = (const float*)d_in[10];
    a.q_norm = (const float*)d_in[11]; a.w_q_up = (const float*)d_in[12]; a.kv_norm = (const float*)d_in[13]; a.w_kv_up = (const float*)d_in[14]; a.w_lru_proj = (const float*)d_in[15];
    a.w_mla_proj = (const float*)d_in[16]; a.w_out = (const float*)d_in[17]; a.norm2 = (const float*)d_in[18]; a.w_up = (const float*)d_in[19]; a.w_down = (const float*)d_in[20]; a.norm_f = (const float*)d_in[21];
    a.out = (float*)d_out; a.ws = (unsigned char*)d_ws;
#if MK_N_LAUNCHES == 0
#ifdef PROBE_PHASE
    { int lo_[16], hi_[16], n = 0, start = 0;
      if (PROBE_PHASE == 0) { lo_[n] = 0; hi_[n++] = 1; lo_[n] = 0; hi_[n++] = 1; start = 1; }
      else if (PROBE_PHASE <= 7) for (int g = 0; g < NGROUP; ++g) { const int k = 1 + g * 7 + (PROBE_PHASE - 1); lo_[n] = start; hi_[n++] = k + PROBE_LEN; lo_[n] = k; hi_[n++] = k + PROBE_LEN; start = k + PROBE_LEN; }
      else { const int k = 1 + NGROUP * 7 + (PROBE_PHASE - 8); lo_[n] = start; hi_[n++] = k + PROBE_LEN; lo_[n] = k; hi_[n++] = k + PROBE_LEN; start = k + PROBE_LEN; }
      if (start < NPHASES) { lo_[n] = start; hi_[n++] = NPHASES; }
      for (int i = 0; i < n; ++i) { a.ph_lo = lo_[i]; a.ph_hi = hi_[i]; a.li = i; hipLaunchKernelGGL(fwd, dim3(grid), dim3(NWAVES * 64), LDS_BYTES, stream, a); } }
#else
    a.ph_lo = 0; a.ph_hi = NPHASES; a.li = 0;
    hipLaunchKernelGGL(fwd, dim3(grid), dim3(NWAVES * 64), LDS_BYTES, stream, a);
#endif
#else
    for (int p = 0; p < NPHASES; ++p) { a.ph_lo = p; a.ph_hi = p + 1; hipLaunchKernelGGL(fwd, dim3(grid), dim3(NWAVES * 64), LDS_BYTES, stream, a); }
#endif
    const hipError_t le = hipPeekAtLastError();
    if (le != hipSuccess) fprintf(stderr, "kernel_launch: launch failed: %s\n", hipGetErrorName(le));
}
```
